# Optimizing an MI355X kernel written in HIP

```python
import jax, jax.numpy as jnp
from jax import lax
import numpy as np


D_MODEL = 1024
BATCH = 32
SEQ = 2048
DEPTH = 2

N_A_LAYERS = DEPTH // 2
N_B_LAYERS = DEPTH - N_A_LAYERS
HEAD_DIM = 64
MIX_WIDTH = D_MODEL
MEM_TOKENS = 256
MEM_HEADS = 4
MEM_WIDTH = MEM_HEADS * HEAD_DIM
POOL_WIDTH = MIX_WIDTH - MEM_WIDTH
POOL_WINDOWS = (2, 4, 8, 16)
POOL_GROUPS = len(POOL_WINDOWS)
POOL_GROUP_DIM = POOL_WIDTH // POOL_GROUPS
FOX_WIDTH = MIX_WIDTH - MEM_WIDTH
FOX_HEADS = FOX_WIDTH // HEAD_DIM
KV_SHARED_WIDTH = 2 * FOX_WIDTH + FOX_HEADS
Q_BLOCK = 128
N_EXPERTS = 32
TOP_K = 4
D_FF = D_MODEL
SWIGLU_ALPHA = 1.702
SWIGLU_LIMIT = 7.0
MOE_BLOCK = 512
DN_ALPHA = float((2 * DEPTH) ** 0.25)
DN_BETA = float((8 * DEPTH) ** -0.25)
LN_EPS = 1e-5
ATTN_SCALE = HEAD_DIM ** -0.5

kernel_name = 'hybrid_pool_fox_moe_deepnorm'


def layer_norm(x, g, b):
    xf = x.astype(jnp.float32)
    mu = jnp.mean(xf, axis=-1, keepdims=True)
    var = jnp.mean(jnp.square(xf - mu), axis=-1, keepdims=True)
    y = (xf - mu) * lax.rsqrt(var + LN_EPS) * g.astype(jnp.float32) + b.astype(jnp.float32)
    return y.astype(x.dtype)


def multi_scale_pool(u, pool_w, pool_scale):
    B, S, _ = u.shape
    ug = u.reshape(B, S, POOL_GROUPS, POOL_GROUP_DIM).astype(jnp.float32)
    cs = jnp.cumsum(ug, axis=1)
    t = jnp.arange(S)
    outs = []
    for g, w in enumerate(POOL_WINDOWS):
        c = cs[:, :, g]
        prev = jnp.pad(c, ((0, 0), (w, 0), (0, 0)))[:, :S]
        cnt = jnp.minimum(t + 1, w).astype(jnp.float32)[None, :, None]
        outs.append((c - prev) / cnt - ug[:, :, g])
    d = jnp.stack(outs, axis=2).astype(u.dtype)
    y = jnp.einsum('bsgc,gcd->bsgd', d, pool_w).reshape(B, S, POOL_WIDTH)
    return y * pool_scale


def memory_attention(q_flat, mem, w_mem_kv):
    B, S, _ = q_flat.shape
    M = mem.shape[1]
    q = q_flat.reshape(B, S, MEM_HEADS, HEAD_DIM)
    kv = mem @ w_mem_kv
    mk = kv[..., :MEM_WIDTH].reshape(B, M, MEM_HEADS, HEAD_DIM)
    mv = kv[..., MEM_WIDTH:].reshape(B, M, MEM_HEADS, HEAD_DIM)
    s = jnp.einsum('bshd,bmhd->bhsm', q, mk).astype(jnp.float32) * ATTN_SCALE
    p = jax.nn.softmax(s, axis=-1).astype(mv.dtype)
    o = jnp.einsum('bhsm,bmhd->bshd', p, mv)
    return o.reshape(B, S, MEM_WIDTH)


def shared_kv(h, kv_w, fgate_b):
    B, S, _ = h.shape
    proj = h @ kv_w
    k = proj[..., :FOX_WIDTH].reshape(B, S, FOX_HEADS, HEAD_DIM).transpose(0, 2, 1, 3)
    v = proj[..., FOX_WIDTH:2 * FOX_WIDTH].reshape(B, S, FOX_HEADS, HEAD_DIM).transpose(0, 2, 1, 3)
    logf = jax.nn.log_sigmoid((proj[..., 2 * FOX_WIDTH:] + fgate_b).astype(jnp.float32))
    c = jnp.cumsum(logf, axis=1).transpose(0, 2, 1)
    return k, v, c


def forgetting_attention(q_flat, k, v, c):
    B, S, _ = q_flat.shape
    q = q_flat.reshape(B, S, FOX_HEADS, HEAD_DIM).transpose(0, 2, 1, 3)
    outs = []
    for i in range(S // Q_BLOCK):
        q0 = i * Q_BLOCK
        q1 = q0 + Q_BLOCK
        s = jnp.einsum('bhqd,bhkd->bhqk', q[:, :, q0:q1], k[:, :, :q1]).astype(jnp.float32) * ATTN_SCALE
        s = s + c[:, :, q0:q1, None] - c[:, :, None, :q1]
        causal = jnp.arange(q1)[None, :] <= jnp.arange(q0, q1)[:, None]
        s = jnp.where(causal, s, -jnp.inf)
        p = jax.nn.softmax(s, axis=-1).astype(v.dtype)
        outs.append(jnp.einsum('bhqk,bhkd->bhqd', p, v[:, :, :q1]))
    o = jnp.concatenate(outs, axis=2)
    return o.transpose(0, 2, 1, 3).reshape(B, S, FOX_WIDTH)


def clamped_swiglu(hdn):
    x_glu = jnp.minimum(hdn[..., ::2], SWIGLU_LIMIT)
    x_lin = jnp.clip(hdn[..., 1::2], -SWIGLU_LIMIT, SWIGLU_LIMIT)
    return x_glu * jax.nn.sigmoid(SWIGLU_ALPHA * x_glu) * (x_lin + 1.0)


def moe(x, router_w, router_b, w1, b1, w2, b2):
    B, S, D = x.shape
    T = B * S
    xt = x.reshape(T, D)
    logits = (xt @ router_w + router_b).astype(jnp.float32)
    top_vals, top_idx = lax.top_k(logits, TOP_K)
    gates = jax.nn.softmax(top_vals, axis=-1).astype(x.dtype)
    n_assign = T * TOP_K
    e_flat = top_idx.reshape(-1).astype(jnp.int32)
    tok_flat = jnp.arange(n_assign, dtype=jnp.int32) // TOP_K
    g_flat = gates.reshape(-1)
    order = jnp.argsort(e_flat)
    e_sorted = e_flat[order]
    tok_sorted = tok_flat[order]
    g_sorted = g_flat[order]
    counts = jnp.bincount(e_flat, length=N_EXPERTS)
    padded = ((counts + MOE_BLOCK - 1) // MOE_BLOCK) * MOE_BLOCK
    start = jnp.cumsum(counts) - counts
    pad_end = jnp.cumsum(padded)
    pad_start = pad_end - padded
    dest = pad_start[e_sorted] + (jnp.arange(n_assign, dtype=jnp.int32) - start[e_sorted])
    n_blocks = -(-n_assign // MOE_BLOCK) + N_EXPERTS
    n_slots = n_blocks * MOE_BLOCK
    slot_tok = jnp.full((n_slots,), T, dtype=jnp.int32).at[dest].set(tok_sorted)
    slot_gate = jnp.zeros((n_slots,), x.dtype).at[dest].set(g_sorted)
    block_expert = jnp.clip(jnp.searchsorted(pad_end, jnp.arange(n_blocks) * MOE_BLOCK, side='right'),
                            0, N_EXPERTS - 1)
    xpad = jnp.concatenate([xt, jnp.zeros((1, D), x.dtype)], axis=0)

    def step(acc, blk):
        e, tok, g = blk
        hdn = xpad[tok] @ w1[e] + b1[e]
        y = (clamped_swiglu(hdn) @ w2[e] + b2[e]) * g[:, None]
        return acc.at[tok].add(y), None

    acc0 = jnp.zeros((T + 1, D), x.dtype)
    acc, _ = lax.scan(step, acc0, (block_expert, slot_tok.reshape(n_blocks, MOE_BLOCK),
                                   slot_gate.reshape(n_blocks, MOE_BLOCK)))
    return acc[:T].reshape(B, S, D)


def setup_inputs(seed: int = 0) -> dict:
    key = jax.random.key(seed)
    ks = jax.random.split(key, 24)

    def nrm(k, shape, scale):
        return jax.random.normal(k, shape, jnp.float32) * scale

    D, E, F = D_MODEL, N_EXPERTS, D_FF
    kv_cols = jnp.concatenate([jnp.ones((FOX_WIDTH,)), jnp.full((FOX_WIDTH,), DN_BETA),
                               jnp.ones((FOX_HEADS,))]).astype(jnp.float32)
    mem_cols = jnp.concatenate([jnp.ones((MEM_WIDTH,)), jnp.full((MEM_WIDTH,), DN_BETA)]).astype(jnp.float32)
    return {
        'x': nrm(ks[0], (BATCH, SEQ, D), 1.0),
        'mem': nrm(ks[1], (BATCH, MEM_TOKENS, D), 1.0),
        'ln1_g': 1.0 + nrm(ks[2], (DEPTH, D), 0.02),
        'ln1_b': nrm(ks[3], (DEPTH, D), 0.02),
        'ln2_g': 1.0 + nrm(ks[4], (DEPTH, D), 0.02),
        'ln2_b': nrm(ks[5], (DEPTH, D), 0.02),
        'a_w_in': nrm(ks[6], (N_A_LAYERS, D, MIX_WIDTH), D ** -0.5),
        'pool_w': nrm(ks[7], (N_A_LAYERS, POOL_GROUPS, POOL_GROUP_DIM, POOL_GROUP_DIM), POOL_GROUP_DIM ** -0.5),
        'pool_scale': 1.0 + nrm(ks[8], (N_A_LAYERS, POOL_WIDTH), 0.1),
        'a_mem_kv': nrm(ks[9], (N_A_LAYERS, D, 2 * MEM_WIDTH), D ** -0.5) * mem_cols,
        'a_w_out': nrm(ks[10], (N_A_LAYERS, MIX_WIDTH, D), MIX_WIDTH ** -0.5 * DN_BETA),
        'kv_w': nrm(ks[11], (D, KV_SHARED_WIDTH), D ** -0.5) * kv_cols,
        'fgate_b': jax.random.uniform(ks[12], (FOX_HEADS,), jnp.float32, 1.0, 4.0),
        'b_w_in': nrm(ks[13], (N_B_LAYERS, D, MIX_WIDTH), D ** -0.5),
        'b_mem_kv': nrm(ks[14], (N_B_LAYERS, D, 2 * MEM_WIDTH), D ** -0.5) * mem_cols,
        'b_w_out': nrm(ks[15], (N_B_LAYERS, MIX_WIDTH, D), MIX_WIDTH ** -0.5 * DN_BETA),
        'router_w': nrm(ks[16], (DEPTH, D, E), D ** -0.5),
        'router_b': nrm(ks[17], (DEPTH, E), 0.01),
        'moe_w1': nrm(ks[18], (DEPTH, E, D, 2 * F), D ** -0.5 * DN_BETA),
        'moe_b1': nrm(ks[19], (DEPTH, E, 2 * F), 0.01),
        'moe_w2': nrm(ks[20], (DEPTH, E, F, D), F ** -0.5 * DN_BETA),
        'moe_b2': nrm(ks[21], (DEPTH, E, D), 0.01),
    }


def reference(x, mem, ln1_g, ln1_b, ln2_g, ln2_b, a_w_in, pool_w, pool_scale, a_mem_kv, a_w_out,
              kv_w, fgate_b, b_w_in, b_mem_kv, b_w_out, router_w, router_b, moe_w1, moe_b1, moe_w2, moe_b2):
    h = x
    k_sh = v_sh = c_sh = None
    for l in range(DEPTH):
        if l < N_A_LAYERS:
            proj = h @ a_w_in[l]
            pooled = multi_scale_pool(proj[..., :POOL_WIDTH], pool_w[l], pool_scale[l])
            memo = memory_attention(proj[..., POOL_WIDTH:], mem, a_mem_kv[l])
            mix = jnp.concatenate([pooled, memo], axis=-1) @ a_w_out[l]
        else:
            j = l - N_A_LAYERS
            if j == 0:
                k_sh, v_sh, c_sh = shared_kv(h, kv_w, fgate_b)
            proj = h @ b_w_in[j]
            fox = forgetting_attention(proj[..., :FOX_WIDTH], k_sh, v_sh, c_sh)
            memo = memory_attention(proj[..., FOX_WIDTH:], mem, b_mem_kv[j])
            mix = jnp.concatenate([fox, memo], axis=-1) @ b_w_out[j]
        h = layer_norm(DN_ALPHA * h + mix, ln1_g[l], ln1_b[l])
        ffn = moe(h, router_w[l], router_b[l], moe_w1[l], moe_b1[l], moe_w2[l], moe_b2[l])
        h = layer_norm(DN_ALPHA * h + ffn, ln2_g[l], ln2_b[l])
    return h
```

```cpp
#include <hip/hip_runtime.h>
#include <cstdio>
#include <cstdint>

#ifndef MK_PER_PHASE
#define MK_PER_PHASE 0
#endif

#define LAS __attribute__((address_space(3)))
#define GAS __attribute__((address_space(1)))
typedef unsigned short bf16_t;
typedef short bf16x8 __attribute__((ext_vector_type(8)));
typedef float f32x4 __attribute__((ext_vector_type(4)));
typedef float f32x2 __attribute__((ext_vector_type(2)));
typedef unsigned u32x4 __attribute__((ext_vector_type(4)));
typedef unsigned u32x2 __attribute__((ext_vector_type(2)));

__device__ __forceinline__ unsigned cvt_pk_bf16(float lo, float hi) { unsigned r; asm volatile("v_cvt_pk_bf16_f32 %0, %1, %2" : "=v"(r) : "v"(lo), "v"(hi)); return r; }
__device__ __forceinline__ float bf_lo(unsigned w) { return __uint_as_float(w << 16); }
__device__ __forceinline__ float bf_hi(unsigned w) { return __uint_as_float(w & 0xffff0000u); }

namespace pg8 {
constexpr int BM = 256, BK = 64, HALF = 128, HTB = HALF * BK * 2, STAGE_BYTES = 8 * HTB, NXCD = 8, WGM = 8;
__host__ __device__ __forceinline__ int lds_byte(int r, int c) { const int st = (r >> 4) * 2 + (c >> 5), rr = r & 15, cc = c & 31, ob = rr * 64 + cc * 2; return st * 1024 + (ob ^ (((ob >> 9) & 1) << 5)); }
__host__ __device__ __forceinline__ void stage_rc(int b, int& R, int& C) { const int st = b / 1024, sb = b % 1024, swz = sb ^ (((sb >> 9) & 1) << 5); R = (st >> 1) * 16 + swz / 64; C = (st & 1) * 32 + (swz % 64) / 2; }
__host__ __device__ __forceinline__ int perm32(int rho) { const int n = rho >> 4, i = rho & 15; return 8 * (i >> 2) + 4 * n + (i & 3); }

struct Unit { int pm, pn, e; };
struct Gemm { const void* A; const void* Bt; int M, N, Kb; };

struct StaticOrder {
    int nM, nN, nwg, G, c;
    __device__ void init(int M, int N, int G_, int c_) { nM = M / BM; nN = N / BM; nwg = nM * nN; G = G_; c = c_; }
    __device__ bool next(int i, Unit& u) const {
        const long L = (long)i * G + c; if (L >= nwg) return false;
        int wgid = (int)L; { const int q = nwg / NXCD, r = nwg % NXCD, xcd = wgid % NXCD, off = wgid / NXCD; wgid = (xcd < r ? xcd * (q + 1) : r * (q + 1) + (xcd - r) * q) + off; }
        const int nig = WGM * nN, gid = wgid / nig, fm = gid * WGM, gsz = (nM - fm) < WGM ? (nM - fm) : WGM;
        u.pm = fm + ((wgid % nig) % gsz); u.pn = (wgid % nig) / gsz; u.e = 0; return true;
    }
};
struct MoeOrder {
    int n_tiles, nN, G, c; const LAS int* tab;
    __device__ bool next(int i, Unit& u) const {
        int rt, pn;
        if (G == 256) { const int x = c & 7, r = c >> 3, rpi = 32 / nN, tpx = (n_tiles + 7) >> 3, lt = rpi * i + r / nN;
            if (lt >= tpx) return false; rt = x * tpx + lt; pn = r % nN; }

        else { const long L = (long)i * G + c; rt = (int)(L / nN); pn = (int)(L % nN); }
        if (rt >= n_tiles) return false;
        u.pm = rt; u.pn = pn; u.e = __builtin_amdgcn_readfirstlane(tab[rt]); return true;
    }
};

struct EpiBf16 {
    static constexpr bool PERM = true, AFTER = false, ALIGN = false; static constexpr bool SKIP_B1 = false;
    struct Pre {}; __device__ __forceinline__ Pre preload(const Unit&, int, int, int, int) const { return Pre{}; } static constexpr int NPRE = 0; static constexpr bool HOISTOK = false; static __device__ __forceinline__ void touch(Pre&) {}
    __device__ __forceinline__ const float* stash_ptr(const Unit&, int) const { return nullptr; } __device__ __forceinline__ Pre from_stash(const LAS float*, int, int, int, int) const { return Pre{}; }
    bf16_t* O; int ldc; const float* colscale; int split_cols; size_t split_stride; float scale;
    __device__ __forceinline__ void operator()(const f32x4 (&acc)[2][2][4][2], const Unit& u, int wr, int wc, int fr, int fq, const Pre&) const {
        const int row0 = u.pm * BM + wr * 64 + fr; int colt = u.pn * BM; bf16_t* base = O;
        if (split_cols) { const int t = colt / split_cols; base += (size_t)t * split_stride; colt -= t * split_cols; }
        const int col0 = colt + wc * 32 + 8 * fq, scol0 = u.pn * BM + wc * 32 + 8 * fq;
        f32x4 sv[2][2];
#pragma unroll
        for (int bj = 0; bj < 2; ++bj)
#pragma unroll
            for (int n = 0; n < 2; ++n) sv[bj][n] = colscale ? *(const f32x4*)(colscale + scol0 + bj * HALF + 4 * n) * scale : (f32x4){scale, scale, scale, scale};
#pragma unroll
        for (int ai = 0; ai < 2; ++ai)
#pragma unroll
            for (int m = 0; m < 4; ++m) { bf16_t* rowp = base + (size_t)(row0 + ai * HALF + m * 16) * ldc + col0;
#pragma unroll
                for (int bj = 0; bj < 2; ++bj) { const f32x4 v0 = acc[ai][bj][m][0] * sv[bj][0], v1 = acc[ai][bj][m][1] * sv[bj][1];
                    u32x4 w; w.x = cvt_pk_bf16(v0[0], v0[1]); w.y = cvt_pk_bf16(v0[2], v0[3]); w.z = cvt_pk_bf16(v1[0], v1[1]); w.w = cvt_pk_bf16(v1[2], v1[3]);
                    *(u32x4*)(rowp + bj * HALF) = w; } }
    }
};
__device__ __forceinline__ unsigned pk_fp8x4(float a, float b, float c, float d) { int w = 0; w = __builtin_amdgcn_cvt_pk_fp8_f32(a, b, w, false); w = __builtin_amdgcn_cvt_pk_fp8_f32(c, d, w, true); return (unsigned)w; }
constexpr float W8_SCALE = 64.0f, ACT8_SCALE = 4.0f;
struct EpiMixed8 {
    static constexpr bool PERM = true, AFTER = false, ALIGN = false; static constexpr bool SKIP_B1 = false;
    struct Pre {}; __device__ __forceinline__ Pre preload(const Unit&, int, int, int, int) const { return Pre{}; } static constexpr int NPRE = 0; static constexpr bool HOISTOK = false; static __device__ __forceinline__ void touch(Pre&) {}
    __device__ __forceinline__ const float* stash_ptr(const Unit&, int) const { return nullptr; } __device__ __forceinline__ Pre from_stash(const LAS float*, int, int, int, int) const { return Pre{}; }
    unsigned char* O8; int ld8; float scale8; int ncut8; bf16_t* O16; int ld16; int rebase16; float scale16;
    __device__ __forceinline__ void operator()(const f32x4 (&acc)[2][2][4][2], const Unit& u, int wr, int wc, int fr, int fq, const Pre&) const {
        const int row0 = u.pm * BM + wr * 64 + fr;
        if (u.pn < ncut8) {
            const int col0 = u.pn * BM + wc * 32 + 8 * fq;
#pragma unroll
            for (int ai = 0; ai < 2; ++ai)
#pragma unroll
                for (int m = 0; m < 4; ++m) { unsigned char* rowp = O8 + (size_t)(row0 + ai * HALF + m * 16) * ld8 + col0;
#pragma unroll
                    for (int bj = 0; bj < 2; ++bj) { const f32x4 v0 = acc[ai][bj][m][0] * scale8, v1 = acc[ai][bj][m][1] * scale8;
                        u32x2 w; w.x = pk_fp8x4(v0[0], v0[1], v0[2], v0[3]); w.y = pk_fp8x4(v1[0], v1[1], v1[2], v1[3]); *(u32x2*)(rowp + bj * HALF) = w; } }
        } else {
            const int col0 = (u.pn - (rebase16 ? ncut8 : 0)) * BM + wc * 32 + 8 * fq;
#pragma unroll
            for (int ai = 0; ai < 2; ++ai)
#pragma unroll
                for (int m = 0; m < 4; ++m) { bf16_t* rowp = O16 + (size_t)(row0 + ai * HALF + m * 16) * ld16 + col0;
#pragma unroll
                    for (int bj = 0; bj < 2; ++bj) { const f32x4 v0 = acc[ai][bj][m][0] * scale16, v1 = acc[ai][bj][m][1] * scale16;
                        u32x4 w; w.x = cvt_pk_bf16(v0[0], v0[1]); w.y = cvt_pk_bf16(v0[2], v0[3]); w.z = cvt_pk_bf16(v1[0], v1[1]); w.w = cvt_pk_bf16(v1[2], v1[3]); *(u32x4*)(rowp + bj * HALF) = w; } }
        }
    }
};
struct EpiLogits {
    static constexpr bool PERM = false, AFTER = false, ALIGN = true; static constexpr bool SKIP_B1 = true;
    struct Pre {}; __device__ __forceinline__ Pre preload(const Unit&, int, int, int, int) const { return Pre{}; } static constexpr int NPRE = 0; static constexpr bool HOISTOK = false; static __device__ __forceinline__ void touch(Pre&) {}
    __device__ __forceinline__ const float* stash_ptr(const Unit&, int) const { return nullptr; } __device__ __forceinline__ Pre from_stash(const LAS float*, int, int, int, int) const { return Pre{}; }
    float* L;
    __device__ __forceinline__ void operator()(const f32x4 (&acc)[2][2][4][2], const Unit& u, int wr, int wc, int fr, int fq, const Pre&) const {
        if (wc > 1) return;
        const int row0 = u.pm * BM + wr * 64 + fr;
#pragma unroll
        for (int ai = 0; ai < 2; ++ai)
#pragma unroll
            for (int m = 0; m < 4; ++m) { float* rowp = L + (size_t)wc * 65536 * 32 + (size_t)(row0 + ai * HALF + m * 16) * 32 + 4 * fq;
#pragma unroll
                for (int n = 0; n < 2; ++n) *(f32x4*)(rowp + n * 16) = acc[ai][0][m][n]; }
    }
};
struct EpiRouter {
    static constexpr bool PERM = false, AFTER = true, ALIGN = true; static constexpr bool SKIP_B1 = true;
    struct Pre {}; __device__ __forceinline__ Pre preload(const Unit&, int, int, int, int) const { return Pre{}; } static constexpr int NPRE = 0; static constexpr bool HOISTOK = false; static __device__ __forceinline__ void touch(Pre&) {}
    __device__ __forceinline__ const float* stash_ptr(const Unit&, int) const { return nullptr; } __device__ __forceinline__ Pre from_stash(const LAS float*, int, int, int, int) const { return Pre{}; }
    const float* rb; int* tok_e; float* tok_g; int* tok_r; unsigned* wg_hist;
    __device__ __forceinline__ void operator()(const f32x4 (&)[2][2][4][2], const Unit&, int, int, int, int, const Pre&) const {}
    __device__ __forceinline__ void after(const f32x4 (&acc)[2][2][4][2], const Unit& u, int wr, int wc, int fr, int fq, LAS unsigned char* lds) const {
        LAS float* Lg = (LAS float*)lds;
        LAS unsigned* hist = (LAS unsigned*)(lds + 2 * 256 * 33 * 4);
        const int tid = threadIdx.x;
        if (wc < 2) {
#pragma unroll
            for (int ai = 0; ai < 2; ++ai)
#pragma unroll
                for (int m = 0; m < 4; ++m) { LAS float* rowp = Lg + wc * (256 * 33) + (ai * HALF + wr * 64 + m * 16 + fr) * 33 + 4 * fq;
#pragma unroll
                    for (int n = 0; n < 2; ++n) { const f32x4 v = acc[ai][0][m][n]; rowp[n * 16 + 0] = v[0]; rowp[n * 16 + 1] = v[1]; rowp[n * 16 + 2] = v[2]; rowp[n * 16 + 3] = v[3]; } }
        }
        if (tid < 32) hist[tid] = 0u;
        __syncthreads();
        if (tid < 256) {
            const int t = u.pm * BM + tid; const LAS float* lp = Lg + tid * 33;
            float lg[32];
#pragma unroll
            for (int e = 0; e < 32; ++e) lg[e] = (lp[e] + lp[256 * 33 + e]) + rb[e];
            unsigned used = 0u; int sel[4]; float val[4];
#pragma unroll
            for (int k = 0; k < 4; ++k) { float best = -INFINITY; int bi = 0;
#pragma unroll
                for (int e = 0; e < 32; ++e) { const float c = ((used >> e) & 1u) ? -INFINITY : lg[e]; if (c > best) { best = c; bi = e; } }
                sel[k] = bi; val[k] = best; used |= 1u << bi; }
            const float e1 = __expf(val[1] - val[0]), e2 = __expf(val[2] - val[0]), e3 = __expf(val[3] - val[0]); const float inv = 1.0f / (1.0f + e1 + e2 + e3);
            int rk[4];
#pragma unroll
            for (int k = 0; k < 4; ++k) rk[k] = (int)atomicAdd((unsigned*)(hist + sel[k]), 1u);
            *(int4*)(tok_e + (size_t)t * 4) = make_int4(sel[0], sel[1], sel[2], sel[3]);
            *(f32x4*)(tok_g + (size_t)t * 4) = (f32x4){inv, e1 * inv, e2 * inv, e3 * inv};
            *(int4*)(tok_r + (size_t)t * 4) = make_int4(rk[0], rk[1], rk[2], rk[3]);
        }
        __syncthreads();
        if (tid < 32) wg_hist[u.pm * 32 + tid] = hist[tid];
    }
};
struct EpiSwiglu {
    static constexpr bool PERM = true, AFTER = false, ALIGN = true; static constexpr bool SKIP_B1 = false;
    unsigned char* O; const float* b1p;
    struct Pre { f32x4 bg[2], bl[2]; }; static constexpr bool HOISTOK = true; static constexpr int NPRE = 4;
    __device__ __forceinline__ const float* stash_ptr(const Unit& u, int tid) const { return b1p + (size_t)u.e * 2048 + u.pn * BM + (tid & 255); }
    __device__ __forceinline__ Pre from_stash(const LAS float* st, int wr, int wc, int fr, int fq) const { Pre p; const LAS float* bp = st + wc * 32 + 8 * fq;
        p.bg[0] = *(const LAS f32x4*)bp; p.bg[1] = *(const LAS f32x4*)(bp + 4); p.bl[0] = *(const LAS f32x4*)(bp + HALF); p.bl[1] = *(const LAS f32x4*)(bp + HALF + 4); return p; }
    static __device__ __forceinline__ void touch(Pre& p) { asm volatile("" : "+v"(p.bg[0]), "+v"(p.bg[1]), "+v"(p.bl[0]), "+v"(p.bl[1])); }
    __device__ __forceinline__ Pre preload(const Unit& u, int wr, int wc, int fr, int fq) const {
        Pre p; const float* bp = b1p + (size_t)u.e * 2048 + u.pn * BM + wc * 32 + 8 * fq;
#pragma unroll
        for (int n = 0; n < 2; ++n) { p.bg[n] = *(const f32x4*)(bp + 4 * n); p.bl[n] = *(const f32x4*)(bp + HALF + 4 * n); }
        return p; }
    __device__ __forceinline__ void operator()(const f32x4 (&acc)[2][2][4][2], const Unit& u, int wr, int wc, int fr, int fq, const Pre& pre) const {
        const int row0 = u.pm * BM + wr * 64 + fr, ocol0 = u.pn * HALF + wc * 32 + 8 * fq;
#pragma unroll
        for (int ai = 0; ai < 2; ++ai)
#pragma unroll
            for (int m = 0; m < 4; ++m) { unsigned char* rowp = O + (size_t)(row0 + ai * HALF + m * 16) * 1024 + ocol0; float r[8];
#pragma unroll
                for (int n = 0; n < 2; ++n) { const f32x4 g = acc[ai][0][m][n] * (1.0f / W8_SCALE) + pre.bg[n], l = acc[ai][1][m][n] * (1.0f / W8_SCALE) + pre.bl[n];
#pragma unroll
                    for (int j = 0; j < 4; j += 2) {
                        const f32x2 xg = {fminf(g[j], 7.0f), fminf(g[j + 1], 7.0f)}, xl = {__builtin_amdgcn_fmed3f(l[j], -7.0f, 7.0f), __builtin_amdgcn_fmed3f(l[j + 1], -7.0f, 7.0f)};
                        const f32x2 t = xg * (-1.702f * 1.4426950408889634f);
                        const f32x2 d = (f32x2){__builtin_amdgcn_exp2f(t[0]), __builtin_amdgcn_exp2f(t[1])} + 1.0f;
                        const f32x2 sg = {__builtin_amdgcn_rcpf(d[0]), __builtin_amdgcn_rcpf(d[1])};
                        const f32x2 o = (xg * sg) * (xl * ACT8_SCALE + ACT8_SCALE);
                        r[4 * n + j] = o[0]; r[4 * n + j + 1] = o[1]; } }
                u32x2 w; w.x = pk_fp8x4(r[0], r[1], r[2], r[3]); w.y = pk_fp8x4(r[4], r[5], r[6], r[7]);
                *(u32x2*)rowp = w; }
    }
};
struct EpiMoe2 {
    static constexpr bool PERM = true, AFTER = false, ALIGN = true; static constexpr bool SKIP_B1 = false;
    unsigned char* O; const float* b2; const float* gate; float yscale;
    struct Pre { f32x4 bv[2][2]; float gts[2][4]; }; static constexpr bool HOISTOK = true; static constexpr int NPRE = 12;
    __device__ __forceinline__ const float* stash_ptr(const Unit& u, int tid) const { return tid < 256 ? gate + u.pm * BM + tid : b2 + (size_t)u.e * 1024 + u.pn * BM + (tid - 256); }
    __device__ __forceinline__ Pre from_stash(const LAS float* st, int wr, int wc, int fr, int fq) const { Pre p; const LAS float* bp = st + 256 + wc * 32 + 8 * fq;
#pragma unroll
        for (int bj = 0; bj < 2; ++bj) { p.bv[bj][0] = *(const LAS f32x4*)(bp + bj * HALF); p.bv[bj][1] = *(const LAS f32x4*)(bp + bj * HALF + 4); }
#pragma unroll
        for (int ai = 0; ai < 2; ++ai)
#pragma unroll
            for (int m = 0; m < 4; ++m) p.gts[ai][m] = st[ai * HALF + wr * 64 + m * 16 + fr];
        return p; }

    static __device__ __forceinline__ void touch(Pre& p) { asm volatile("" : "+v"(p.bv[0][0]), "+v"(p.bv[0][1]), "+v"(p.bv[1][0]), "+v"(p.bv[1][1]));
        asm volatile("" : "+v"(p.gts[0][0]), "+v"(p.gts[0][1]), "+v"(p.gts[0][2]), "+v"(p.gts[0][3]), "+v"(p.gts[1][0]), "+v"(p.gts[1][1]), "+v"(p.gts[1][2]), "+v"(p.gts[1][3])); }
    __device__ __forceinline__ Pre preload(const Unit& u, int wr, int wc, int fr, int fq) const {
        Pre p; const int row0 = u.pm * BM + wr * 64 + fr; const float* bp = b2 + (size_t)u.e * 1024 + u.pn * BM + wc * 32 + 8 * fq;
#pragma unroll
        for (int bj = 0; bj < 2; ++bj)
#pragma unroll
            for (int n = 0; n < 2; ++n) p.bv[bj][n] = *(const f32x4*)(bp + bj * HALF + 4 * n);
#pragma unroll
        for (int ai = 0; ai < 2; ++ai)
#pragma unroll
            for (int m = 0; m < 4; ++m) p.gts[ai][m] = gate[row0 + ai * HALF + m * 16];
        return p; }
    __device__ __forceinline__ void operator()(const f32x4 (&acc)[2][2][4][2], const Unit& u, int wr, int wc, int fr, int fq, const Pre& pre) const {
        const int row0 = u.pm * BM + wr * 64 + fr, col0 = u.pn * BM + wc * 32 + 8 * fq;
#pragma unroll
        for (int ai = 0; ai < 2; ++ai)
#pragma unroll
            for (int m = 0; m < 4; ++m) { const int row = row0 + ai * HALF + m * 16; const float gt = pre.gts[ai][m] * yscale; unsigned char* rowp = O + (size_t)row * 1024 + col0;
#pragma unroll
                for (int bj = 0; bj < 2; ++bj) { const f32x4 v0 = (acc[ai][bj][m][0] * (1.0f / (W8_SCALE * ACT8_SCALE)) + pre.bv[bj][0]) * gt, v1 = (acc[ai][bj][m][1] * (1.0f / (W8_SCALE * ACT8_SCALE)) + pre.bv[bj][1]) * gt;
#define Y8C(x) __builtin_amdgcn_fmed3f((x), -448.0f, 448.0f)
                    u32x2 w; w.x = pk_fp8x4(Y8C(v0[0]), Y8C(v0[1]), Y8C(v0[2]), Y8C(v0[3])); w.y = pk_fp8x4(Y8C(v1[0]), Y8C(v1[1]), Y8C(v1[2]), Y8C(v1[3]));
#undef Y8C
                    *(u32x2*)(rowp + bj * HALF) = w; } }
    }
};

#ifndef F8_SCALE
#define F8_SCALE 0
#endif
constexpr int STASH_OFF = 8 * HTB + 4608 + 128;
typedef int i32x8 __attribute__((ext_vector_type(8)));
typedef int i32x4 __attribute__((ext_vector_type(4)));
__device__ __forceinline__ i32x8 cat8(bf16x8 a, bf16x8 b) { const i32x4 x = __builtin_bit_cast(i32x4, a), y = __builtin_bit_cast(i32x4, b); return __builtin_shufflevector(x, y, 0, 1, 2, 3, 4, 5, 6, 7); }
template <class Epi, class Sched, bool F8 = false, bool GATHER = false>
__device__ __forceinline__ void gemm_phase(LAS unsigned char* lds, const Gemm g, const Sched& S, const Epi& E, const int* rowidx = nullptr) {
    const int tid = threadIdx.x, wid = __builtin_amdgcn_readfirstlane(tid >> 6), lane = tid & 63, wr = wid >> 2, wc = wid & 3, fr = lane & 15, fq = lane >> 4;
    const int Kb = g.Kb, nt = Kb / (BK * 2);
    int Ri[2], Ci2[2]; unsigned voffB[2];
#pragma unroll
    for (int i = 0; i < 2; ++i) { int R, C; stage_rc(tid * 16 + i * 8192, R, C); const int Rb = Epi::PERM ? ((R & ~31) + perm32(R & 31)) : R;
        Ri[i] = R; Ci2[i] = C * 2; voffB[i] = (unsigned)(Rb * Kb + C * 2); }
    const size_t kstep = (size_t)(BK * 2);
    const size_t hstep = (size_t)HALF * Kb;
    const size_t tstep = 2 * hstep;
    const size_t estep = (size_t)g.N * Kb;
    const unsigned ldsw = (unsigned)wid * 1024u;
    const int aoff = lds_byte(wr * 64 + fr, fq * 8), boff = lds_byte(wc * 32 + fr, fq * 8);
#define PG8_SA(b, h) (((b) * 2 + (h)) * HTB)
#define PG8_SB(b, h) ((4 + (b) * 2 + (h)) * HTB)
#define PG8_STAGE(bufoff, gbase, voff) do { _Pragma("unroll") for (int _i = 0; _i < 2; ++_i) \
        __builtin_amdgcn_global_load_lds((const unsigned*)((const char*)(gbase) + (voff)[_i]), (LAS unsigned*)(lds + (bufoff) + ldsw + _i * 8192), 16, 0, 0); } while (0)
#define PG8_LDA(dst, b, h) do { _Pragma("unroll") for (int m = 0; m < 4; ++m) _Pragma("unroll") for (int k = 0; k < 2; ++k) dst[m][k] = *(const LAS bf16x8*)(lds + PG8_SA(b, h) + aoff + m * 2048 + k * 1024); } while (0)
#define PG8_LDB(dst, b, h) do { _Pragma("unroll") for (int n = 0; n < 2; ++n) _Pragma("unroll") for (int k = 0; k < 2; ++k) dst[n][k] = *(const LAS bf16x8*)(lds + PG8_SB(b, h) + boff + n * 2048 + k * 1024); } while (0)
#define PG8_MMA(ai, bj, At, Bt) do { __builtin_amdgcn_s_setprio(1); _Pragma("unroll") for (int m = 0; m < 4; ++m) _Pragma("unroll") for (int n = 0; n < 2; ++n) { \
        if constexpr (F8) { const i32x8 b8_ = cat8(Bt[n][0], Bt[n][1]), a8_ = cat8(At[m][0], At[m][1]); \
            asm volatile("v_mfma_f32_16x16x128_f8f6f4 %0, %1, %2, %0" : "+v"(acc[ai][bj][m][n]) : "v"(b8_), "v"(a8_)); }   \
        else { _Pragma("unroll") for (int k = 0; k < 2; ++k) acc[ai][bj][m][n] = __builtin_amdgcn_mfma_f32_16x16x32_bf16(Bt[n][k], At[m][k], acc[ai][bj][m][n], 0, 0, 0); } } \
        __builtin_amdgcn_s_setprio(0); } while (0)
#define PG8_WAIT_V_(n) asm volatile("s_waitcnt vmcnt(" #n ")" ::: "memory")
#define PG8_WAIT_V(n) PG8_WAIT_V_(n)
#define PG8_WAIT_L(n) asm volatile("s_waitcnt lgkmcnt(" #n ")" ::: "memory")
#define PG8_BAR __builtin_amdgcn_s_barrier()
#define PG8_SCHED __builtin_amdgcn_sched_barrier(0)
#define PG8_AOFF(dst, u) do { _Pragma("unroll") for (int h_ = 0; h_ < 2; ++h_) _Pragma("unroll") for (int i_ = 0; i_ < 2; ++i_) { const int r_ = (u).pm * BM + h_ * HALF + Ri[i_]; \
        dst[h_][i_] = (unsigned)(GATHER ? rowidx[r_] : r_) * (unsigned)Kb + (unsigned)Ci2[i_]; } } while (0)
    Unit cur, nxt, nn; int ui = 0; bool has_nn = false;
    typename Epi::Pre pre{}; unsigned offNN[2][2] = {{0u, 0u}, {0u, 0u}}; float stash_v = 0.f;
    if (!S.next(0, cur)) return;
    bool has_next = S.next(1, nxt);
    unsigned offC[2][2], offN[2][2];
    PG8_AOFF(offC, cur);
    if (has_next) PG8_AOFF(offN, nxt); else PG8_AOFF(offN, cur);
    f32x4 acc[2][2][4][2];
#pragma unroll
    for (int a = 0; a < 2; ++a)
#pragma unroll
        for (int b = 0; b < 2; ++b)
#pragma unroll
            for (int m = 0; m < 4; ++m)
#pragma unroll
                for (int n = 0; n < 2; ++n) acc[a][b][m][n] = (f32x4){0.f, 0.f, 0.f, 0.f};
    bf16x8 At[4][2], B0[2][2], B1[2][2];
    const char* const gA = (const char*)g.A;
    const char* cB = (const char*)g.Bt + (size_t)cur.e * estep + (size_t)cur.pn * tstep;
    PG8_STAGE(PG8_SB(0, 0), cB, voffB); PG8_STAGE(PG8_SB(0, 1), cB + hstep, voffB); PG8_STAGE(PG8_SA(0, 0), gA, offC[0]); PG8_STAGE(PG8_SA(0, 1), gA, offC[1]);
    if (wr == 1) PG8_BAR;
    PG8_WAIT_V(2); PG8_BAR;
    PG8_STAGE(PG8_SB(1, 0), cB + kstep, voffB); PG8_STAGE(PG8_SA(1, 0), gA + kstep, offC[0]); PG8_STAGE(PG8_SB(1, 1), cB + hstep + kstep, voffB);
    PG8_WAIT_V(6); PG8_BAR;
    for (;;) {
        const char* nB = has_next ? (const char*)g.Bt + (size_t)nxt.e * estep + (size_t)nxt.pn * tstep : cB;
#pragma nounroll
        for (int t = 0; t < nt; t += 2) {
            const bool last = (t == nt - 2);
            const char* a1 = gA + (size_t)(t + 1) * kstep;
            const char* a2 = last ? gA : gA + (size_t)(t + 2) * kstep; const char* b2 = last ? nB : cB + (size_t)(t + 2) * kstep;
            const char* a3 = a2 + kstep; const char* b3 = b2 + kstep;
            unsigned o2[2][2];
#pragma unroll
            for (int h = 0; h < 2; ++h)
#pragma unroll
                for (int i = 0; i < 2; ++i) o2[h][i] = last ? offN[h][i] : offC[h][i];
            constexpr int HOIST = Epi::HOISTOK ? 1 + (GATHER ? 4 : 0) : 0;
#define PG8_WAIT_H() do { if (HOIST > 0 && last) { if constexpr (HOIST == 5) PG8_WAIT_V(13); else if constexpr (HOIST == 1) PG8_WAIT_V(9); else PG8_WAIT_V(8); } else PG8_WAIT_V(8); } while (0)
            static_assert(HOIST == 0 || HOIST == 1 || HOIST == 5, "add the matching wait count");
            PG8_LDB(B0, 0, 0); if constexpr (!Epi::SKIP_B1) PG8_LDB(B1, 0, 1); PG8_SCHED; PG8_LDA(At, 0, 0); PG8_STAGE(PG8_SA(1, 1), a1, offC[1]);
            if (HOIST > 0 && last) { PG8_SCHED;
                { const float* sp_ = E.stash_ptr(cur, tid); asm volatile("global_load_dword %0, %1, off" : "=v"(stash_v) : "v"(sp_) : "memory"); }
                has_nn = has_next && S.next(ui + 2, nn);
                if constexpr (GATHER) { const int pmn = has_nn ? nn.pm : cur.pm;
#pragma unroll
                    for (int h_ = 0; h_ < 2; ++h_)
#pragma unroll
                        for (int i_ = 0; i_ < 2; ++i_) { const int* ip_ = rowidx + (pmn * BM + h_ * HALF + Ri[i_]); asm volatile("global_load_dword %0, %1, off" : "=v"(offNN[h_][i_]) : "v"(ip_) : "memory"); } }
                else { if (has_nn) PG8_AOFF(offNN, nn); else PG8_AOFF(offNN, cur); }
                PG8_SCHED; }
            PG8_WAIT_H(); PG8_WAIT_L(0); PG8_BAR; PG8_MMA(0, 0, At, B0); if constexpr (!Epi::SKIP_B1) PG8_MMA(0, 1, At, B1); PG8_BAR; PG8_SCHED;
            PG8_LDA(At, 0, 1); PG8_STAGE(PG8_SB(0, 0), b2, voffB); PG8_STAGE(PG8_SB(0, 1), b2 + hstep, voffB); PG8_STAGE(PG8_SA(0, 0), a2, o2[0]);
            PG8_WAIT_H(); PG8_WAIT_L(0); PG8_BAR; PG8_MMA(1, 0, At, B0); if constexpr (!Epi::SKIP_B1) PG8_MMA(1, 1, At, B1); PG8_BAR; PG8_SCHED;
            PG8_LDB(B0, 1, 0); if constexpr (!Epi::SKIP_B1) PG8_LDB(B1, 1, 1); PG8_SCHED; PG8_LDA(At, 1, 0); PG8_STAGE(PG8_SA(0, 1), a2, o2[1]);
            PG8_WAIT_V(8);
            if (HOIST > 0 && last) { ((LAS float*)(lds + STASH_OFF))[tid] = stash_v;
                if constexpr (GATHER) {
#pragma unroll
                    for (int h_ = 0; h_ < 2; ++h_)
#pragma unroll
                        for (int i_ = 0; i_ < 2; ++i_) offNN[h_][i_] = offNN[h_][i_] * (unsigned)Kb + (unsigned)Ci2[i_]; } }
            PG8_WAIT_L(0); PG8_BAR; PG8_MMA(0, 0, At, B0); if constexpr (!Epi::SKIP_B1) PG8_MMA(0, 1, At, B1); PG8_BAR; PG8_SCHED;
            PG8_LDA(At, 1, 1); PG8_STAGE(PG8_SB(1, 0), b3, voffB); PG8_STAGE(PG8_SB(1, 1), b3 + hstep, voffB); PG8_STAGE(PG8_SA(1, 0), a3, o2[0]);
            PG8_WAIT_V(8); PG8_WAIT_L(0); PG8_BAR; PG8_MMA(1, 0, At, B0); if constexpr (!Epi::SKIP_B1) PG8_MMA(1, 1, At, B1); PG8_BAR; PG8_SCHED;
#undef PG8_WAIT_H
        }
        if constexpr (Epi::ALIGN) { if (wr == 0) PG8_BAR; }
        if constexpr (F8) asm volatile("s_nop 7\n\ts_nop 7\n\ts_nop 7" ::: "memory");
        if constexpr (!Epi::HOISTOK) {
            has_nn = has_next && S.next(ui + 2, nn);
            pre = E.preload(cur, wr, wc, fr, fq);
            if (has_nn) PG8_AOFF(offNN, nn); else PG8_AOFF(offNN, cur);
            if constexpr (GATHER) asm volatile("" : "+v"(offNN[0][0]), "+v"(offNN[0][1]), "+v"(offNN[1][0]), "+v"(offNN[1][1])); }
        if constexpr (Epi::HOISTOK) pre = E.from_stash((const LAS float*)(lds + STASH_OFF), wr, wc, fr, fq);
        E(acc, cur, wr, wc, fr, fq, pre);
        if (!has_next) break;
#pragma unroll
        for (int a = 0; a < 2; ++a)
#pragma unroll
            for (int b = 0; b < 2; ++b)
#pragma unroll
                for (int m = 0; m < 4; ++m)
#pragma unroll
                    for (int n = 0; n < 2; ++n) acc[a][b][m][n] = (f32x4){0.f, 0.f, 0.f, 0.f};
#pragma unroll
        for (int h = 0; h < 2; ++h)
#pragma unroll
            for (int i = 0; i < 2; ++i) { offC[h][i] = offN[h][i]; if (has_nn) offN[h][i] = offNN[h][i]; }
        cur = nxt; cB = nB; nxt = nn; has_next = has_nn; ++ui;
        if constexpr (Epi::ALIGN) { if (wr == 1) PG8_BAR; }
    }
    PG8_WAIT_V(0);
    if constexpr (!Epi::ALIGN) { if (wr == 0) PG8_BAR; }
    PG8_BAR;
    if constexpr (Epi::AFTER) E.after(acc, cur, wr, wc, fr, fq, lds);
#undef PG8_SA
#undef PG8_SB
#undef PG8_STAGE
#undef PG8_LDA
#undef PG8_LDB
#undef PG8_MMA
#undef PG8_WAIT_V
#undef PG8_WAIT_V_
#undef PG8_WAIT_L
#undef PG8_BAR
#undef PG8_SCHED
#undef PG8_AOFF
}
}

constexpr int NWAVES = 8, NTHR = 512;
constexpr int T = 65536, D = 1024, NB = 32, S = 2048, MEMT = 256;
constexpr int NE = 32, TOPK = 4;
constexpr int NSLOT_MAX = T * TOPK + NE * 256;
constexpr int NTILE_MAX = NSLOT_MAX / 256;
constexpr int NCHUNK = T / 256;
constexpr float LN_EPS = 1e-5f;
constexpr float DN_ALPHA = 1.4142135623730951f;
constexpr int NPH = 22;

constexpr size_t MiB = 1u << 20;
constexpr size_t WS_CTL = 0, CTL_ZERO_BYTES = 1 * MiB;
constexpr size_t WS_WGHIST = 1 * MiB;
constexpr size_t WS_TILETAB = 1 * MiB + 256 * 1024;
constexpr size_t WS_B1P = 1 * MiB + 512 * 1024;
constexpr size_t WS_GWT = 2 * MiB;
constexpr size_t WS_TOKE = 3 * MiB, WS_TOKG = 4 * MiB, WS_TOKR = 5 * MiB, WS_TOKS = 6 * MiB;
constexpr size_t WS_SLOTG = 7 * MiB, WS_SLOTT = 9 * MiB;
constexpr size_t WS_GLOG = 11 * MiB;
constexpr size_t WS_LOGITS = 16 * MiB;
constexpr size_t WS_WINA = 32 * MiB, WS_WOUTA = 34 * MiB, WS_WINB = 36 * MiB, WS_WOUTB = 38 * MiB, WS_WMKV = 40 * MiB, WS_WKV = 42 * MiB, WS_WPOOL = 45 * MiB, WS_WR = 47 * MiB;
constexpr size_t WS_MEMB = 48 * MiB, WS_KVMEM = 64 * MiB;
constexpr size_t WS_W1 = 80 * MiB, WS_W2 = 336 * MiB;
constexpr size_t WS_R1 = 464 * MiB, WS_R2 = 592 * MiB;
constexpr size_t WS_ACT = 720 * MiB, WS_Y = 1248 * MiB, WS_H1Q = 1776 * MiB, WS_END = 1840 * MiB;
constexpr size_t WS_PROJ = 720 * MiB, WS_CAT = 848 * MiB, WS_MIX = 976 * MiB, WS_DBUF = 1104 * MiB, WS_KF = 1200 * MiB  , WS_Q8 = 1248 * MiB  , WS_VF = 1296 * MiB;
static_assert(WS_ACT + (size_t)NSLOT_MAX * 2048 <= WS_Y && WS_Y + (size_t)NSLOT_MAX * 2048 <= WS_END, "ws map");
constexpr int CW_BAR = 4096;

constexpr int RING_BYTES = 131072;
constexpr int TAB_OFF = RING_BYTES;
constexpr int MISC_OFF = TAB_OFF + 4608;
constexpr int LDS_BYTES = 147456;
static_assert(MISC_OFF + 128 == pg8::STASH_OFF && pg8::STASH_OFF + 2048 <= LDS_BYTES, "LDS map");

#define RLX_AGENT __ATOMIC_RELAXED, __HIP_MEMORY_SCOPE_AGENT
#define LDS_WAIT() asm volatile("s_waitcnt lgkmcnt(0)" ::: "memory")
#define VM_WAIT() asm volatile("s_waitcnt vmcnt(0)" ::: "memory")

#define XB_TMO      128
#define XB_XCNT(j)  (256  + 64 * (j))
#define XB_XSUB(j)  (1280 + 64 * (j))
#define XB_XGEN(j)  (2304 + 64 * (j))
#define XB_TOP      3328
#define XB_TOPGEN   3392
#define XCD_BAR_WORDS 3456
#define XB_SPIN_CAP (1u << 18)
__device__ __forceinline__ unsigned xb_ld(unsigned* p)              { return __hip_atomic_load(p, __ATOMIC_RELAXED, __HIP_MEMORY_SCOPE_AGENT); }
__device__ __forceinline__ unsigned xb_add(unsigned* p, unsigned v) { return __hip_atomic_fetch_add(p, v, __ATOMIC_RELAXED, __HIP_MEMORY_SCOPE_AGENT); }
__device__ __forceinline__ unsigned xb_xcc_id() { return (unsigned)__builtin_amdgcn_s_getreg((3 << 11) | 20) & 0xFu; }
#define XB_SPIN(cond, bar) do { unsigned _sp = 0; while (cond) { __builtin_amdgcn_s_sleep(1); \
    if ((++_sp & 255u) == 0u) { if (xb_ld(&(bar)[XB_TMO])) break; if (_sp > XB_SPIN_CAP) { atomicAdd(&(bar)[XB_TMO], 1u); break; } } } } while (0)
struct XcdBarrier { unsigned* bar; unsigned x; volatile LAS unsigned* st; };
__device__ __forceinline__ XcdBarrier xcd_barrier_post(unsigned* bar, volatile LAS unsigned* st) {
    XcdBarrier b; b.bar = bar; b.x = xb_xcc_id(); b.st = st;
    if (threadIdx.x == 0) (void)xb_add(&bar[XB_XCNT(b.x)], 1u);
    return b;
}
__device__ __forceinline__ void xcd_barrier_complete(unsigned* bar, unsigned x, unsigned& nloc, unsigned& nx) {
    const unsigned G = gridDim.x * gridDim.y * gridDim.z;
    unsigned sum, cnt, mine, sp = 0u;
    for (;;) {
        sum = 0u; cnt = 0u; mine = 0u;
#pragma unroll
        for (unsigned j = 0; j < 16; ++j) { const unsigned c = xb_ld(&bar[XB_XCNT(j)]); sum += c; cnt += (c > 0u) ? 1u : 0u; mine = (j == x) ? c : mine; }
        if (sum == G) break;
        __builtin_amdgcn_s_sleep(1);
        if ((++sp & 255u) == 0u) { if (xb_ld(&bar[XB_TMO])) break; if (sp > XB_SPIN_CAP) { atomicAdd(&bar[XB_TMO], 1u); break; } }
    }
    nloc = mine > 0u ? mine : 1u; nx = cnt > 0u ? cnt : 1u;
}
__device__ __forceinline__ void xcd_barrier(const XcdBarrier& b) {
    asm volatile("s_waitcnt vmcnt(0)" ::: "memory");
    __syncthreads();
    if (threadIdx.x == 0) {
        unsigned* bar = b.bar;
        __builtin_amdgcn_s_waitcnt(0);
        unsigned nloc = b.st[0], nx = b.st[1];
        if (nloc == 0u) { xcd_barrier_complete(bar, b.x, nloc, nx); b.st[0] = nloc; b.st[1] = nx; }
        const unsigned old = xb_add(&bar[XB_XSUB(b.x)], 1u);
        const unsigned gen = old / nloc;
        if (old + 1u == (gen + 1u) * nloc) {
            __builtin_amdgcn_fence(__ATOMIC_RELEASE, "agent");
            asm volatile("s_waitcnt vmcnt(0)" ::: "memory");
            const unsigned og = xb_add(&bar[XB_TOP], 1u);
            const unsigned tg = og / nx;
            if (og + 1u == (tg + 1u) * nx) xb_add(&bar[XB_TOPGEN], 1u);
            else XB_SPIN(xb_ld(&bar[XB_TOPGEN]) == tg, bar);
            __builtin_amdgcn_fence(__ATOMIC_ACQUIRE, "agent");
            xb_add(&bar[XB_XGEN(b.x)], 1u);
            asm volatile("s_waitcnt vmcnt(0)" ::: "memory");
        } else {
            XB_SPIN(xb_ld(&bar[XB_XGEN(b.x)]) == gen, bar);
            __builtin_amdgcn_fence(__ATOMIC_ACQUIRE, "agent");
            asm volatile("s_waitcnt vmcnt(0)" ::: "memory");
        }
    }
    __syncthreads();
}

__device__ __forceinline__ float wave_sum(float v) {
#pragma unroll
    for (int o = 1; o < 64; o <<= 1) v += __shfl_xor(v, o);
    return v;
}

template <int MODE>
__device__ __forceinline__ void tr_item(const float* W, int ldn, bf16_t* WT, int dld, int row_off, int col_off, LAS float* scr, int k0, int n0, int lane) {
    {
        f32x4 t[8];
#pragma unroll
        for (int i = 0; i < 8; ++i) t[i] = *(const f32x4*)(W + (size_t)(k0 + 8 * i + (lane >> 3)) * ldn + n0 + 4 * (lane & 7));
#pragma unroll
        for (int i = 0; i < 8; ++i) { LAS float* d = scr + (8 * i + (lane >> 3)) * 33 + 4 * (lane & 7); d[0] = t[i][0]; d[1] = t[i][1]; d[2] = t[i][2]; d[3] = t[i][3]; }
    }
    LDS_WAIT(); asm volatile("" ::: "memory");
    const int c = lane & 7;
#pragma unroll
    for (int j = 0; j < 4; ++j) { const int n = (lane >> 3) + 8 * j; const LAS float* s = scr + (8 * c) * 33 + n;
        float f[8];
#pragma unroll
        for (int q = 0; q < 8; ++q) f[q] = s[q * 33];
        u32x4 o; o.x = cvt_pk_bf16(f[0], f[1]); o.y = cvt_pk_bf16(f[2], f[3]); o.z = cvt_pk_bf16(f[4], f[5]); o.w = cvt_pk_bf16(f[6], f[7]);
        const int nn = n0 + n;
        const int drow = (MODE == 1) ? ((nn & ~255) + 128 * (nn & 1) + ((nn & 255) >> 1)) : (row_off + nn);
        *(u32x4*)(WT + (size_t)drow * dld + col_off + k0 + 8 * c) = o;
        if (MODE == 2) {
            u32x4 l; l.x = cvt_pk_bf16(f[0] - bf_lo(o.x), f[1] - bf_hi(o.x)); l.y = cvt_pk_bf16(f[2] - bf_lo(o.y), f[3] - bf_hi(o.y));
            l.z = cvt_pk_bf16(f[4] - bf_lo(o.z), f[5] - bf_hi(o.z)); l.w = cvt_pk_bf16(f[6] - bf_lo(o.w), f[7] - bf_hi(o.w));
            *(u32x4*)(WT + (size_t)(drow + 32) * dld + col_off + k0 + 8 * c) = l;
        }
    }
    LDS_WAIT(); asm volatile("" ::: "memory");
}

template <bool PERMW>
__device__ __forceinline__ void tr_item8(const float* W, int ldn, unsigned char* WT, int dld, LAS float* scr, int k0, int n0, int lane) {
    {
        f32x4 t[8];
#pragma unroll
        for (int i = 0; i < 8; ++i) t[i] = *(const f32x4*)(W + (size_t)(k0 + 8 * i + (lane >> 3)) * ldn + n0 + 4 * (lane & 7));
#pragma unroll
        for (int i = 0; i < 8; ++i) { LAS float* d = scr + (8 * i + (lane >> 3)) * 33 + 4 * (lane & 7); d[0] = t[i][0]; d[1] = t[i][1]; d[2] = t[i][2]; d[3] = t[i][3]; }
    }
    LDS_WAIT(); asm volatile("" ::: "memory");
    const int c = lane & 3;
#pragma unroll
    for (int j = 0; j < 2; ++j) { const int n = (lane >> 2) + 16 * j; const LAS float* s = scr + (16 * c) * 33 + n;
        float f[16];
#pragma unroll
        for (int q = 0; q < 16; ++q) f[q] = s[q * 33] * pg8::W8_SCALE;
        u32x4 o; o.x = pg8::pk_fp8x4(f[0], f[1], f[2], f[3]); o.y = pg8::pk_fp8x4(f[4], f[5], f[6], f[7]); o.z = pg8::pk_fp8x4(f[8], f[9], f[10], f[11]); o.w = pg8::pk_fp8x4(f[12], f[13], f[14], f[15]);
        const int nn = n0 + n;
        const int drow = PERMW ? ((nn & ~255) + 128 * (nn & 1) + ((nn & 255) >> 1)) : nn;
        *(u32x4*)(WT + (size_t)drow * dld + k0 + 16 * c) = o;
    }
    LDS_WAIT(); asm volatile("" ::: "memory");
}

struct Args {
    const float* in[22]; float* out; unsigned char* ws; int ph_lo, ph_hi;
};

__device__ __forceinline__ void f32_to_bf16_rows(const float* __restrict__ src, bf16_t* __restrict__ dst, size_t n4, size_t gt, size_t ngt) {
    size_t i = gt;
    for (; i + 7 * ngt < n4; i += 8 * ngt) { f32x4 a[8];
#pragma unroll
        for (int u = 0; u < 8; ++u) a[u] = *(const f32x4*)(src + (i + u * ngt) * 4);
#pragma unroll
        for (int u = 0; u < 8; ++u) { u32x2 o; o.x = cvt_pk_bf16(a[u][0], a[u][1]); o.y = cvt_pk_bf16(a[u][2], a[u][3]); *(u32x2*)(dst + (i + u * ngt) * 4) = o; } }
    for (; i < n4; i += ngt) { const f32x4 a = *(const f32x4*)(src + i * 4); u32x2 o; o.x = cvt_pk_bf16(a[0], a[1]); o.y = cvt_pk_bf16(a[2], a[3]); *(u32x2*)(dst + i * 4) = o; }
}

__device__ __forceinline__ void p0_prologue(const Args& a, LAS unsigned char* lds, int wave, int lane) {
    unsigned char* ws = a.ws;
    LAS float* scr = (LAS float*)(lds + wave * 16384);
    const int G = gridDim.x, gw = blockIdx.x * NWAVES + wave, NGW = G * NWAVES;
    const size_t gt = (size_t)blockIdx.x * NTHR + threadIdx.x, ngt = (size_t)G * NTHR;
    constexpr int I_SQ = 16 * 32, I_MKV = 16 * 16, I_KV = 16 * 48, I_R = 16, I_POOL = 3 * 6, I_W1 = 16 * 64, I_W2 = 16 * 32;
    constexpr int NIT = 4 * I_SQ + 2 * I_MKV + I_KV + 2 * I_R + 4 * I_POOL + 64 * I_W1 + 64 * I_W2;
    for (int it = gw; it < NIT; it += NGW) {
        int r = it;
        if (r < 4 * I_SQ) { const int w = r / I_SQ; r -= w * I_SQ; const float* src = a.in[w == 0 ? 6 : (w == 1 ? 10 : (w == 2 ? 13 : 15))];
            bf16_t* dst = (bf16_t*)(ws + (w == 0 ? WS_WINA : (w == 1 ? WS_WOUTA : (w == 2 ? WS_WINB : WS_WOUTB))));
            if (w == 1 && r < 12 * 32) continue;
            if (w == 2) { tr_item8<false>(src, 1024, (unsigned char*)dst, 1024, scr, 64 * (r / 32), 32 * (r % 32), lane); continue; }
            tr_item<0>(src, 1024, dst, 1024, 0, 0, scr, 64 * (r / 32), 32 * (r % 32), lane); continue; }
        r -= 4 * I_SQ;
        if (r < 2 * I_MKV) { const int w = r / I_MKV; r -= w * I_MKV;
            tr_item8<false>(a.in[w == 0 ? 9 : 14], 512, ws + WS_WMKV + (size_t)512 * w * 1024, 1024, scr, 64 * (r / 16), 32 * (r % 16), lane); continue; }
        r -= 2 * I_MKV;
        if (r < I_KV) { tr_item8<false>(a.in[11], 1548, ws + WS_WKV, 1024, scr, 64 * (r / 48), 32 * (r % 48), lane); continue; }
        r -= I_KV;
        if (r < 2 * I_R) { const int l = r / I_R; r -= l * I_R;
            tr_item<2>(a.in[16] + (size_t)l * 1024 * 32, 32, (bf16_t*)(ws + WS_WR) + (size_t)l * 256 * 1024, 1024, 0, 0, scr, 64 * r, 0, lane); continue; }
        r -= 2 * I_R;
        if (r < 4 * I_POOL) continue;
        r -= 4 * I_POOL;
        if (r < 64 * I_W1) { const int le = r / I_W1; r -= le * I_W1;
            tr_item8<true>(a.in[18] + (size_t)le * 1024 * 2048, 2048, ws + WS_W1 + (size_t)le * 2048 * 1024, 1024, scr, 64 * (r / 64), 32 * (r % 64), lane); continue; }
        r -= 64 * I_W1;
        { const int le = r / I_W2; r -= le * I_W2;
            tr_item8<false>(a.in[20] + (size_t)le * 1024 * 1024, 1024, ws + WS_W2 + (size_t)le * 1024 * 1024, 1024, scr, 64 * (r / 32), 32 * (r % 32), lane); }
    }
    f32_to_bf16_rows(a.in[0], (bf16_t*)(ws + WS_R1), (size_t)T * D / 4, gt, ngt);
    for (size_t i = gt; i < (size_t)NB * MEMT * D / 4; i += ngt) { const f32x4 v = *(const f32x4*)(a.in[1] + i * 4); *(unsigned*)(ws + WS_MEMB + i * 4) = pg8::pk_fp8x4(v[0], v[1], v[2], v[3]); }
    {
      bf16_t* wo = (bf16_t*)(ws + WS_WOUTA); const float* pw = a.in[7]; const float* psc = a.in[8]; const float* wout = a.in[10];
      for (size_t i = gt; i < (size_t)4 * 96 * 256; i += ngt) { const int n4 = (int)(i & 255), kk = (int)(i >> 8), g = kk / 96, c2 = kk % 96;
          const float* p0 = pw + ((size_t)g * 192 + 2 * c2) * 192; const float* p1 = p0 + 192; const float* sr = psc + g * 192; const float* wc = wout + (size_t)g * 192 * 1024 + 4 * n4;
          f32x4 a0 = {0.f, 0.f, 0.f, 0.f}, a1 = {0.f, 0.f, 0.f, 0.f};
#pragma unroll 4
          for (int j = 0; j < 192; j += 4) { const f32x4 q0 = *(const f32x4*)(p0 + j), q1 = *(const f32x4*)(p1 + j), sv = *(const f32x4*)(sr + j);
#pragma unroll
              for (int r = 0; r < 4; ++r) { const f32x4 w = *(const f32x4*)(wc + (size_t)(j + r) * 1024); a0 += w * (q0[r] * sv[r]); a1 += w * (q1[r] * sv[r]); } }
          const int k = g * 192 + 2 * c2;
#pragma unroll
          for (int r = 0; r < 4; ++r) *(unsigned*)(wo + (size_t)(4 * n4 + r) * 1024 + k) = cvt_pk_bf16(a0[r], a1[r]); }
      bf16_t* wr = (bf16_t*)(ws + WS_WR);
      for (size_t i = gt; i < (size_t)2 * 64 * 128; i += ngt) { const int l = (int)(i / (64 * 128)), rr = (int)((i / 128) % 64), ch = (int)(i % 128);
          const int row = 64 + rr;
          *(u32x4*)(wr + ((size_t)l * 256 + row) * 1024 + ch * 8) = (u32x4){0u, 0u, 0u, 0u}; } }
    { float* b1p = (float*)(ws + WS_B1P); const float* b1 = a.in[19];
      for (size_t i = gt; i < (size_t)2 * 32 * 2048; i += ngt) { const int np = (int)(i & 2047); const size_t le = i >> 11;
          const int orig = 2 * (128 * (np >> 8) + (np & 127)) + ((np >> 7) & 1); b1p[i] = b1[le * 2048 + orig]; }
      float* gwt = (float*)(ws + WS_GWT); const float* kvw = a.in[11];
      for (size_t i = gt; i < (size_t)12 * 1024; i += ngt) { const int j = (int)(i / 1024), k = (int)(i % 1024); gwt[i] = kvw[(size_t)k * 1548 + 1536 + j]; } }
}

__device__ __forceinline__ void pool_d_phase(const bf16_t* proj, bf16_t* dbuf) {
    const size_t gt = (size_t)blockIdx.x * NTHR + threadIdx.x, ngt = (size_t)gridDim.x * NTHR;
    for (size_t id = gt; id < (size_t)1024 * 96; id += ngt) {
        const int cc = (int)(id % 96), seg = (int)(id / 96), b = seg >> 5, s0 = (seg & 31) * 64, g = cc / 24, w = 2 << g;
        const bf16_t* up = proj + (size_t)b * S * 1024 + cc * 8; bf16_t* dp = dbuf + (size_t)b * S * 1024 + cc * 8;
        float sum[8];
#pragma unroll
        for (int q = 0; q < 8; ++q) sum[q] = 0.f;
        for (int r = s0 - w; r < s0; ++r) if (r >= 0) { const u32x4 v = *(const u32x4*)(up + (size_t)r * 1024);
            sum[0] += bf_lo(v.x); sum[1] += bf_hi(v.x); sum[2] += bf_lo(v.y); sum[3] += bf_hi(v.y); sum[4] += bf_lo(v.z); sum[5] += bf_hi(v.z); sum[6] += bf_lo(v.w); sum[7] += bf_hi(v.w); }
        for (int t = s0; t < s0 + 64; ++t) {
            const u32x4 v = *(const u32x4*)(up + (size_t)t * 1024);
            float ut[8] = {bf_lo(v.x), bf_hi(v.x), bf_lo(v.y), bf_hi(v.y), bf_lo(v.z), bf_hi(v.z), bf_lo(v.w), bf_hi(v.w)};
#pragma unroll
            for (int q = 0; q < 8; ++q) sum[q] += ut[q];
            if (t - w >= 0) { const u32x4 o = *(const u32x4*)(up + (size_t)(t - w) * 1024);
                sum[0] -= bf_lo(o.x); sum[1] -= bf_hi(o.x); sum[2] -= bf_lo(o.y); sum[3] -= bf_hi(o.y); sum[4] -= bf_lo(o.z); sum[5] -= bf_hi(o.z); sum[6] -= bf_lo(o.w); sum[7] -= bf_hi(o.w); }
            const float inv = 1.0f / (float)((t + 1) < w ? (t + 1) : w);
            float d[8];
#pragma unroll
            for (int q = 0; q < 8; ++q) d[q] = sum[q] * inv - ut[q];
            u32x4 o; o.x = cvt_pk_bf16(d[0], d[1]); o.y = cvt_pk_bf16(d[2], d[3]); o.z = cvt_pk_bf16(d[4], d[5]); o.w = cvt_pk_bf16(d[6], d[7]);
            *(u32x4*)(dp + (size_t)t * 1024) = o;
        }
    }
}

typedef float f32x16 __attribute__((ext_vector_type(16)));
typedef short v4i16_t __attribute__((ext_vector_type(4)));
constexpr int ATT_SLOT = 16384, ATT_NSLOT = 4, ATT_C_OFF = ATT_NSLOT * ATT_SLOT  , ATT_W_OFF = ATT_C_OFF + 8192  , ATT_LDS = ATT_W_OFF + 64;
static_assert(ATT_LDS <= RING_BYTES, "attention LDS map");
constexpr float ATT_L2E = 1.4426950408889634f, ATT_C2 = 0.125f * 1.4426950408889634f, ATT_THR = 8.0f;

template <bool FOX>
__device__ __forceinline__ void att_tile(const LAS unsigned char* sb, f32x16& s0, f32x16& s1, const bf16x8 (&qf)[4], f32x16& O0, f32x16& O1, float& m, float& l,
                                         int kt, int qrow, bool diag, int h2, int kfo, int vfo) {
    __builtin_amdgcn_sched_barrier(0);
#pragma unroll
    for (int ks = 0; ks < 4; ++ks) {
        const bf16x8 k0 = *(const LAS bf16x8*)(sb + kfo + ks * 2048), k1 = *(const LAS bf16x8*)(sb + kfo + ks * 2048 + 512);
        s0 = __builtin_amdgcn_mfma_f32_32x32x16_bf16(k0, qf[ks], s0, 0, 0, 0); s1 = __builtin_amdgcn_mfma_f32_32x32x16_bf16(k1, qf[ks], s1, 0, 0, 0); }
    __builtin_amdgcn_sched_barrier(0);
    const unsigned va_ = (unsigned)(unsigned long)(sb + vfo);
    v4i16_t tv[2][4][2];
#define ATT_TR(dst, off) asm volatile("ds_read_b64_tr_b16 %0, %1 offset:%2" : "=v"(dst) : "v"(va_), "i"(off) : "memory")
    ATT_TR(tv[0][0][0], 0 * 4096 + 0 * 1024);    ATT_TR(tv[0][0][1], 0 * 4096 + 0 * 1024 + 512);
    ATT_TR(tv[0][1][0], 0 * 4096 + 1 * 1024);    ATT_TR(tv[0][1][1], 0 * 4096 + 1 * 1024 + 512);
    ATT_TR(tv[0][2][0], 0 * 4096 + 2 * 1024);    ATT_TR(tv[0][2][1], 0 * 4096 + 2 * 1024 + 512);
    ATT_TR(tv[0][3][0], 0 * 4096 + 3 * 1024);    ATT_TR(tv[0][3][1], 0 * 4096 + 3 * 1024 + 512);
    ATT_TR(tv[1][0][0], 1 * 4096 + 0 * 1024);    ATT_TR(tv[1][0][1], 1 * 4096 + 0 * 1024 + 512);
    ATT_TR(tv[1][1][0], 1 * 4096 + 1 * 1024);    ATT_TR(tv[1][1][1], 1 * 4096 + 1 * 1024 + 512);
    ATT_TR(tv[1][2][0], 1 * 4096 + 2 * 1024);    ATT_TR(tv[1][2][1], 1 * 4096 + 2 * 1024 + 512);
    ATT_TR(tv[1][3][0], 1 * 4096 + 3 * 1024);    ATT_TR(tv[1][3][1], 1 * 4096 + 3 * 1024 + 512);
#undef ATT_TR
    if (FOX && diag) {
#pragma unroll
        for (int r = 0; r < 16; ++r) { const int key = kt * 64 + (r & 3) + 8 * (r >> 2) + 4 * h2;
            s0[r] = (key > qrow) ? -INFINITY : s0[r]; s1[r] = (key + 32 > qrow) ? -INFINITY : s1[r]; }
    }
    float ta = fmaxf(fmaxf(s0[0], s0[1]), s1[0]), tb = fmaxf(fmaxf(s0[2], s0[3]), s1[1]); ta = fmaxf(fmaxf(ta, s1[2]), s1[3]);
#pragma unroll
    for (int r = 4; r < 16; r += 4) { ta = fmaxf(fmaxf(ta, s0[r]), s0[r + 1]); tb = fmaxf(fmaxf(tb, s0[r + 2]), s0[r + 3]); ta = fmaxf(fmaxf(ta, s1[r]), s1[r + 1]); tb = fmaxf(fmaxf(tb, s1[r + 2]), s1[r + 3]); }
    float tmax = fmaxf(ta, tb);
    { const auto rr = __builtin_amdgcn_permlane32_swap(__float_as_uint(tmax), __float_as_uint(tmax), false, false); tmax = fmaxf(__uint_as_float(rr[0]), __uint_as_float(rr[1])); }
    if (__any(tmax > m + ATT_THR)) {
        const float mn = fmaxf(m, tmax), alpha = __builtin_amdgcn_exp2f(m - mn); m = mn; l *= alpha;
#pragma unroll
        for (int r = 0; r < 16; ++r) { O0[r] *= alpha; O1[r] *= alpha; }
    }
    float ps = 0.f;
#pragma unroll
    for (int r = 0; r < 16; ++r) { s0[r] = __builtin_amdgcn_exp2f(s0[r] - m); s1[r] = __builtin_amdgcn_exp2f(s1[r] - m); ps += s0[r] + s1[r]; }
    l += ps;
    bf16x8 pf[2][2];
#pragma unroll
    for (int sp = 0; sp < 2; ++sp) { u32x4 a, b;
        a.x = cvt_pk_bf16(s0[8 * sp + 0], s0[8 * sp + 1]); a.y = cvt_pk_bf16(s0[8 * sp + 2], s0[8 * sp + 3]); a.z = cvt_pk_bf16(s0[8 * sp + 4], s0[8 * sp + 5]); a.w = cvt_pk_bf16(s0[8 * sp + 6], s0[8 * sp + 7]);
        b.x = cvt_pk_bf16(s1[8 * sp + 0], s1[8 * sp + 1]); b.y = cvt_pk_bf16(s1[8 * sp + 2], s1[8 * sp + 3]); b.z = cvt_pk_bf16(s1[8 * sp + 4], s1[8 * sp + 5]); b.w = cvt_pk_bf16(s1[8 * sp + 6], s1[8 * sp + 7]);
        pf[0][sp] = __builtin_bit_cast(bf16x8, a); pf[1][sp] = __builtin_bit_cast(bf16x8, b); }
    __builtin_amdgcn_sched_barrier(0);
    asm volatile("s_waitcnt lgkmcnt(0)" ::: "memory");
    __builtin_amdgcn_sched_barrier(0);
#pragma unroll
    for (int kb = 0; kb < 2; ++kb)
#pragma unroll
        for (int sp = 0; sp < 2; ++sp) { const int ki = 2 * kb + sp;
            const v4i16_t a0 = tv[0][ki][0], a1 = tv[0][ki][1], b0 = tv[1][ki][0], b1 = tv[1][ki][1];
            const bf16x8 va = (bf16x8){a0[0], a0[1], a0[2], a0[3], a1[0], a1[1], a1[2], a1[3]}, vb = (bf16x8){b0[0], b0[1], b0[2], b0[3], b1[0], b1[1], b1[2], b1[3]};
            O0 = __builtin_amdgcn_mfma_f32_32x32x16_bf16(va, pf[kb][sp], O0, 0, 0, 0); O1 = __builtin_amdgcn_mfma_f32_32x32x16_bf16(vb, pf[kb][sp], O1, 0, 0, 0); }
    __builtin_amdgcn_sched_barrier(0);
}
__device__ __forceinline__ void att_load_q(bf16x8 (&qf)[4], const bf16_t* Qrow, int h2) {
    u32x4 qraw[4];
#pragma unroll
    for (int ks = 0; ks < 4; ++ks) qraw[ks] = *(const u32x4*)(Qrow + 16 * ks + 8 * h2);
#pragma unroll
    for (int ks = 0; ks < 4; ++ks) { const u32x4 w = qraw[ks];
        u32x4 o; o.x = cvt_pk_bf16(ATT_C2 * bf_lo(w.x), ATT_C2 * bf_hi(w.x)); o.y = cvt_pk_bf16(ATT_C2 * bf_lo(w.y), ATT_C2 * bf_hi(w.y));
        o.z = cvt_pk_bf16(ATT_C2 * bf_lo(w.z), ATT_C2 * bf_hi(w.z)); o.w = cvt_pk_bf16(ATT_C2 * bf_lo(w.w), ATT_C2 * bf_hi(w.w)); qf[ks] = __builtin_bit_cast(bf16x8, o); }
}
__device__ __forceinline__ void att_store_o(bf16_t* op, const f32x16& O0, const f32x16& O1, float l) {
    { const auto rr = __builtin_amdgcn_permlane32_swap(__float_as_uint(l), __float_as_uint(l), false, false); l = __uint_as_float(rr[0]) + __uint_as_float(rr[1]); }
    const float il = 1.0f / l;
#pragma unroll
    for (int g = 0; g < 4; ++g) { u32x2 w0, w1;
        w0.x = cvt_pk_bf16(O0[4 * g + 0] * il, O0[4 * g + 1] * il); w0.y = cvt_pk_bf16(O0[4 * g + 2] * il, O0[4 * g + 3] * il);
        w1.x = cvt_pk_bf16(O1[4 * g + 0] * il, O1[4 * g + 1] * il); w1.y = cvt_pk_bf16(O1[4 * g + 2] * il, O1[4 * g + 3] * il);
        *(u32x2*)(op + 8 * g) = w0; *(u32x2*)(op + 32 + 8 * g) = w1; }
}
constexpr float ATT_S8 = 16.0f;
typedef int i32x8a __attribute__((ext_vector_type(8)));
typedef int i32x4a __attribute__((ext_vector_type(4)));
__device__ __forceinline__ void att_tile8(const LAS unsigned char* sb, f32x16& s0, f32x16& s1, const i32x8a qf8, f32x16& O0, f32x16& O1, float& m, float& l,
                                          int kt, int qrow, bool diag, int h2, int ql, int vfo) {
    __builtin_amdgcn_sched_barrier(0);
    {   const int sw = (ql >> 2) & 3;
        const LAS unsigned char* k0p = sb + ql * 64; const LAS unsigned char* k1p = k0p + 32 * 64;
        const int c0 = ((2 * h2) ^ sw) * 16, c1 = ((2 * h2 + 1) ^ sw) * 16;
        const i32x4a a00 = *(const LAS i32x4a*)(k0p + c0), a01 = *(const LAS i32x4a*)(k0p + c1), a10 = *(const LAS i32x4a*)(k1p + c0), a11 = *(const LAS i32x4a*)(k1p + c1);
        const i32x8a ka = __builtin_shufflevector(a00, a01, 0, 1, 2, 3, 4, 5, 6, 7), kb = __builtin_shufflevector(a10, a11, 0, 1, 2, 3, 4, 5, 6, 7);
        s0 = __builtin_amdgcn_mfma_scale_f32_32x32x64_f8f6f4(ka, qf8, s0, 0, 0, 0, 0, 0, 0);
        s1 = __builtin_amdgcn_mfma_scale_f32_32x32x64_f8f6f4(kb, qf8, s1, 0, 0, 0, 0, 0, 0); }
    __builtin_amdgcn_sched_barrier(0);
    const unsigned va_ = (unsigned)(unsigned long)(sb + vfo);
    v4i16_t tv[2][4][2];
#define ATT_TR(dst, off) asm volatile("ds_read_b64_tr_b16 %0, %1 offset:%2" : "=v"(dst) : "v"(va_), "i"(off) : "memory")
    ATT_TR(tv[0][0][0], 0 * 4096 + 0 * 1024);    ATT_TR(tv[0][0][1], 0 * 4096 + 0 * 1024 + 512);
    ATT_TR(tv[0][1][0], 0 * 4096 + 1 * 1024);    ATT_TR(tv[0][1][1], 0 * 4096 + 1 * 1024 + 512);
    ATT_TR(tv[0][2][0], 0 * 4096 + 2 * 1024);    ATT_TR(tv[0][2][1], 0 * 4096 + 2 * 1024 + 512);
    ATT_TR(tv[0][3][0], 0 * 4096 + 3 * 1024);    ATT_TR(tv[0][3][1], 0 * 4096 + 3 * 1024 + 512);
    ATT_TR(tv[1][0][0], 1 * 4096 + 0 * 1024);    ATT_TR(tv[1][0][1], 1 * 4096 + 0 * 1024 + 512);
    ATT_TR(tv[1][1][0], 1 * 4096 + 1 * 1024);    ATT_TR(tv[1][1][1], 1 * 4096 + 1 * 1024 + 512);
    ATT_TR(tv[1][2][0], 1 * 4096 + 2 * 1024);    ATT_TR(tv[1][2][1], 1 * 4096 + 2 * 1024 + 512);
    ATT_TR(tv[1][3][0], 1 * 4096 + 3 * 1024);    ATT_TR(tv[1][3][1], 1 * 4096 + 3 * 1024 + 512);
#undef ATT_TR
    if (diag) {
#pragma unroll
        for (int r = 0; r < 16; ++r) { const int key = kt * 64 + (r & 3) + 8 * (r >> 2) + 4 * h2;
            s0[r] = (key > qrow) ? -INFINITY : s0[r]; s1[r] = (key + 32 > qrow) ? -INFINITY : s1[r]; }
    }
    float ta = fmaxf(fmaxf(s0[0], s0[1]), s1[0]), tb = fmaxf(fmaxf(s0[2], s0[3]), s1[1]); ta = fmaxf(fmaxf(ta, s1[2]), s1[3]);
#pragma unroll
    for (int r = 4; r < 16; r += 4) { ta = fmaxf(fmaxf(ta, s0[r]), s0[r + 1]); tb = fmaxf(fmaxf(tb, s0[r + 2]), s0[r + 3]); ta = fmaxf(fmaxf(ta, s1[r]), s1[r + 1]); tb = fmaxf(fmaxf(tb, s1[r + 2]), s1[r + 3]); }
    float tmax = fmaxf(ta, tb);
    { const auto rr = __builtin_amdgcn_permlane32_swap(__float_as_uint(tmax), __float_as_uint(tmax), false, false); tmax = fmaxf(__uint_as_float(rr[0]), __uint_as_float(rr[1])); }
    if (__any(tmax > m + ATT_THR * ATT_S8)) {
        const float mn = fmaxf(m, tmax), alpha = __builtin_amdgcn_exp2f((m - mn) * (1.0f / ATT_S8)); m = mn; l *= alpha;
#pragma unroll
        for (int r = 0; r < 16; ++r) { O0[r] *= alpha; O1[r] *= alpha; }
    }
    const float nm = -m * (1.0f / ATT_S8);
    float ps = 0.f;
#pragma unroll
    for (int r = 0; r < 16; ++r) { s0[r] = __builtin_amdgcn_exp2f(fmaf(s0[r], 1.0f / ATT_S8, nm)); s1[r] = __builtin_amdgcn_exp2f(fmaf(s1[r], 1.0f / ATT_S8, nm)); ps += s0[r] + s1[r]; }
    l += ps;
    bf16x8 pf[2][2];
#pragma unroll
    for (int sp = 0; sp < 2; ++sp) { u32x4 a, b;
        a.x = cvt_pk_bf16(s0[8 * sp + 0], s0[8 * sp + 1]); a.y = cvt_pk_bf16(s0[8 * sp + 2], s0[8 * sp + 3]); a.z = cvt_pk_bf16(s0[8 * sp + 4], s0[8 * sp + 5]); a.w = cvt_pk_bf16(s0[8 * sp + 6], s0[8 * sp + 7]);
        b.x = cvt_pk_bf16(s1[8 * sp + 0], s1[8 * sp + 1]); b.y = cvt_pk_bf16(s1[8 * sp + 2], s1[8 * sp + 3]); b.z = cvt_pk_bf16(s1[8 * sp + 4], s1[8 * sp + 5]); b.w = cvt_pk_bf16(s1[8 * sp + 6], s1[8 * sp + 7]);
        pf[0][sp] = __builtin_bit_cast(bf16x8, a); pf[1][sp] = __builtin_bit_cast(bf16x8, b); }
    __builtin_amdgcn_sched_barrier(0);
    asm volatile("s_waitcnt lgkmcnt(0)" ::: "memory");
    __builtin_amdgcn_sched_barrier(0);
#pragma unroll
    for (int kb = 0; kb < 2; ++kb)
#pragma unroll
        for (int sp = 0; sp < 2; ++sp) { const int ki = 2 * kb + sp;
            const v4i16_t a0 = tv[0][ki][0], a1 = tv[0][ki][1], b0 = tv[1][ki][0], b1 = tv[1][ki][1];
            const bf16x8 va = (bf16x8){a0[0], a0[1], a0[2], a0[3], a1[0], a1[1], a1[2], a1[3]}, vb = (bf16x8){b0[0], b0[1], b0[2], b0[3], b1[0], b1[1], b1[2], b1[3]};
            O0 = __builtin_amdgcn_mfma_f32_32x32x16_bf16(va, pf[kb][sp], O0, 0, 0, 0); O1 = __builtin_amdgcn_mfma_f32_32x32x16_bf16(vb, pf[kb][sp], O1, 0, 0, 0); }
    __builtin_amdgcn_sched_barrier(0);
}
__device__ __forceinline__ void attn_unit_fox2(const unsigned char* Q8, const unsigned char* K8, const bf16_t* Vp, bf16_t* Op, int qA, int qB, LAS unsigned char* lds) {
    int tid = threadIdx.x; asm volatile("" : "+v"(tid));
    const int lane = tid & 63, wave = __builtin_amdgcn_readfirstlane(tid >> 6), ql = lane & 31, h2 = lane >> 5;
    const LAS float* ncl = (const LAS float*)(lds + ATT_C_OFF);
    const int q0A = 256 * qA, q0B = 256 * qB, nkt = 4 * qA + 4, nktB = 4 * qB + 4;
    const int qrowA = q0A + 32 * wave + ql, qrowB = q0B + 32 * wave + ql;
    const int kkey = 16 * (wave & 3) + (lane >> 2);
    const unsigned char* ksrc = K8 + (size_t)kkey * 768 + 16 * ((lane & 3) ^ ((kkey >> 2) & 3));
    const bf16_t* vsrc = Vp + (size_t)(16 * (wave & 3) + (lane >> 2)) * 768 + 32 * (wave >> 2) + 8 * (lane & 3);
    const bool kwave = wave < 4;
#define ATT_DMA(t, slot) do { if (kwave) __builtin_amdgcn_global_load_lds((const unsigned*)(ksrc + (size_t)(t) * 64 * 768), (LAS unsigned*)(lds + (slot) * ATT_SLOT + wave * 1024), 16, 0, 0); \
                              __builtin_amdgcn_global_load_lds((const unsigned*)(vsrc + (size_t)(t) * 64 * 768), (LAS unsigned*)(lds + (slot) * ATT_SLOT + 8192 + wave * 1024), 16, 0, 0); } while (0)
    i32x8a qfA, qfB;
    { const i32x4a a0 = *(const i32x4a*)(Q8 + (size_t)qrowA * 768 + 32 * h2), a1 = *(const i32x4a*)(Q8 + (size_t)qrowA * 768 + 32 * h2 + 16);
      const i32x4a b0 = *(const i32x4a*)(Q8 + (size_t)qrowB * 768 + 32 * h2), b1 = *(const i32x4a*)(Q8 + (size_t)qrowB * 768 + 32 * h2 + 16);
      qfA = __builtin_shufflevector(a0, a1, 0, 1, 2, 3, 4, 5, 6, 7); qfB = __builtin_shufflevector(b0, b1, 0, 1, 2, 3, 4, 5, 6, 7); }
    ATT_DMA(0, 0);
    ATT_DMA(1, 1);
    f32x16 OA0, OA1, OB0, OB1;
#pragma unroll
    for (int r = 0; r < 16; ++r) { OA0[r] = 0.f; OA1[r] = 0.f; OB0[r] = 0.f; OB1[r] = 0.f; }
    float mA = -1e30f, lA = 0.f, mB = -1e30f, lB = 0.f;
    const int vfo = 8192 + (4 * h2 + ((lane & 15) >> 2)) * 64 + ((lane >> 4) & 1) * 32 + (lane & 3) * 8;
    const int lastA = (q0A + 32 * wave + 31) >> 6, lastB = (q0B + 32 * wave + 31) >> 6;
    int pair = 0;
    for (int kt0 = 0; kt0 < nkt; kt0 += 2) {
        asm volatile("s_waitcnt vmcnt(0)" ::: "memory");
        __builtin_amdgcn_s_barrier();
        asm volatile("" ::: "memory");
        if (kt0 + 2 < nkt) { ATT_DMA(kt0 + 2, 2 * (pair ^ 1)); ATT_DMA(kt0 + 3, 2 * (pair ^ 1) + 1); }
#pragma unroll 1
        for (int sub = 0; sub < 2; ++sub) { const int kt = kt0 + sub; const LAS unsigned char* sb = lds + (2 * pair + sub) * ATT_SLOT;
            if (kt <= lastA) { f32x16 s0, s1;
#pragma unroll
                for (int g = 0; g < 4; ++g) { const f32x4 c0 = *(const LAS f32x4*)(ncl + kt * 64 + 8 * g + 4 * h2), c1 = *(const LAS f32x4*)(ncl + kt * 64 + 32 + 8 * g + 4 * h2);
#pragma unroll
                    for (int j = 0; j < 4; ++j) { s0[4 * g + j] = c0[j]; s1[4 * g + j] = c1[j]; } }
                att_tile8(sb, s0, s1, qfA, OA0, OA1, mA, lA, kt, qrowA, kt * 64 + 63 > q0A + 32 * wave, h2, ql, vfo); }
            if (kt < nktB && kt <= lastB) { f32x16 s0, s1;
#pragma unroll
                for (int g = 0; g < 4; ++g) { const f32x4 c0 = *(const LAS f32x4*)(ncl + kt * 64 + 8 * g + 4 * h2), c1 = *(const LAS f32x4*)(ncl + kt * 64 + 32 + 8 * g + 4 * h2);
#pragma unroll
                    for (int j = 0; j < 4; ++j) { s0[4 * g + j] = c0[j]; s1[4 * g + j] = c1[j]; } }
                att_tile8(sb, s0, s1, qfB, OB0, OB1, mB, lB, kt, qrowB, kt * 64 + 63 > q0B + 32 * wave, h2, ql, vfo); }
        }
        pair ^= 1;
    }
#undef ATT_DMA
    att_store_o(Op + (size_t)qrowA * 1024 + 4 * h2, OA0, OA1, lA);
    att_store_o(Op + (size_t)qrowB * 1024 + 4 * h2, OB0, OB1, lB);
    asm volatile("s_waitcnt lgkmcnt(0)" ::: "memory"); __builtin_amdgcn_s_barrier(); asm volatile("" ::: "memory");
}
__device__ __forceinline__ void memattn_mfma(const bf16_t* proj, const bf16_t* kvmem, int koff, bf16_t* cat, LAS unsigned char* lds) {
    const int tid = threadIdx.x, lane = tid & 63, wave = __builtin_amdgcn_readfirstlane(tid >> 6), ql = lane & 31, h2 = lane >> 5;
    const int kfo = h2 * 1024 + ql * 16, vfo = 8192 + (4 * h2 + ((lane & 15) >> 2)) * 64 + ((lane >> 4) & 1) * 32 + (lane & 3) * 8;
    for (int u = blockIdx.x; u < NB * 4 * 2; u += gridDim.x) {
        const int half = u & 1, h = (u >> 1) & 3, b = u >> 3;
        const bf16_t* Kp = kvmem + (size_t)b * MEMT * 1024 + koff + 64 * h; const bf16_t* Vp = Kp + 256;
        const bf16_t* ksrc = Kp + (size_t)lane * 1024 + 8 * wave;
        const bf16_t* vsrc = Vp + (size_t)(16 * (wave & 3) + (lane >> 2)) * 1024 + 32 * (wave >> 2) + 8 * (lane & 3);
        __syncthreads();
#pragma unroll
        for (int t = 0; t < 4; ++t) { __builtin_amdgcn_global_load_lds((const unsigned*)(ksrc + (size_t)t * 64 * 1024), (LAS unsigned*)(lds + t * ATT_SLOT + wave * 1024), 16, 0, 0);
                                       __builtin_amdgcn_global_load_lds((const unsigned*)(vsrc + (size_t)t * 64 * 1024), (LAS unsigned*)(lds + t * ATT_SLOT + 8192 + wave * 1024), 16, 0, 0); }
        const bf16_t* Qb = proj + (size_t)b * S * 1024 + 768 + 64 * h; bf16_t* Ob = cat + (size_t)b * S * 1024 + 768 + 64 * h;
        bf16x8 qf[4];
        att_load_q(qf, Qb + (size_t)(half * 1024 + 32 * wave + ql) * 1024, h2);
        asm volatile("s_waitcnt vmcnt(0)" ::: "memory");
        __builtin_amdgcn_s_barrier();
        asm volatile("" ::: "memory");
        for (int qb = 0; qb < 4; ++qb) {
            const int qrow = half * 1024 + qb * 256 + 32 * wave + ql;
            f32x16 O0, O1;
#pragma unroll
            for (int r = 0; r < 16; ++r) { O0[r] = 0.f; O1[r] = 0.f; }
            float m = -1e30f, l = 0.f;
            bf16x8 qn[4];
            if (qb + 1 < 4) att_load_q(qn, Qb + (size_t)(qrow + 256) * 1024, h2);
#pragma unroll 1
            for (int kt = 0; kt < 4; ++kt) { f32x16 s0, s1;
#pragma unroll
                for (int r = 0; r < 16; ++r) { s0[r] = 0.f; s1[r] = 0.f; }
                att_tile<false>(lds + kt * ATT_SLOT, s0, s1, qf, O0, O1, m, l, kt, qrow, false, h2, kfo, vfo); }
            att_store_o(Ob + (size_t)qrow * 1024 + 4 * h2, O0, O1, l);
            if (qb + 1 < 4) {
#pragma unroll
                for (int ks = 0; ks < 4; ++ks) qf[ks] = qn[ks]; }
        }
    }
}
__device__ __forceinline__ void fox_mfma(const unsigned char* Q8, const unsigned char* K8, const bf16_t* Vf, const float* glog, bf16_t* cat, LAS unsigned char* lds) {
    const int tid = threadIdx.x, lane = tid & 63, wave = tid >> 6;
    LAS float* cl = (LAS float*)(lds + ATT_C_OFF); LAS float* wtot = (LAS float*)(lds + ATT_W_OFF);
    const int G = gridDim.x, vcu = (G % 8 == 0) ? ((int)(blockIdx.x % 8) * (G / 8) + (int)(blockIdx.x / 8)) : (int)blockIdx.x;
    const int npair = NB * 12 * 4, npp = (npair + G - 1) / G; int last_bh = -1;
    for (int ip = 0; ip < npp; ++ip) {
        const int p = vcu * npp + ip; if (p >= npair) break;
        const int bh = p >> 2, j = p & 3, b = bh / 12, h = bh % 12;
        if (bh != last_bh) {
            last_bh = bh;
            float v[4];
#pragma unroll
            for (int k = 0; k < 4; ++k) v[k] = glog[((size_t)b * S + 4 * tid + k) * 16 + h];
            v[1] += v[0]; v[2] += v[1]; v[3] += v[2];
            float inc = v[3];
#pragma unroll
            for (int off = 1; off < 64; off <<= 1) { const float n = __shfl_up(inc, off); if (lane >= off) inc += n; }
            if (lane == 63) wtot[wave] = inc;
            __syncthreads();
            float base = inc - v[3];
            for (int w = 0; w < wave; ++w) base += wtot[w];
#pragma unroll
            for (int k = 0; k < 4; ++k) cl[4 * tid + k] = -(base + v[k]) * (ATT_L2E * ATT_S8);
            __syncthreads();
        }
        attn_unit_fox2(Q8 + (size_t)b * S * 768 + 64 * h, K8 + (size_t)b * S * 768 + 64 * h, Vf + (size_t)b * S * 768 + 64 * h,
                       cat + (size_t)b * S * 1024 + 64 * h, 7 - j, j, lds);
    }
}

constexpr float Y8_SCALE = 32.0f;
__device__ __forceinline__ void add_fp8x16(float (&v)[16], const u32x4 w, float sc) {
    const unsigned ww[4] = {w.x, w.y, w.z, w.w};
#pragma unroll
    for (int q = 0; q < 4; ++q) { const f32x2 lo = __builtin_amdgcn_cvt_pk_f32_fp8((int)ww[q], false), hi = __builtin_amdgcn_cvt_pk_f32_fp8((int)ww[q], true);
        v[4 * q + 0] += sc * lo[0]; v[4 * q + 1] += sc * lo[1]; v[4 * q + 2] += sc * hi[0]; v[4 * q + 3] += sc * hi[1]; }
}
__device__ __forceinline__ void unpack_bf16x8(float* v, const u32x4 x, float sc) {
    v[0] = sc * bf_lo(x.x); v[1] = sc * bf_hi(x.x); v[2] = sc * bf_lo(x.y); v[3] = sc * bf_hi(x.y); v[4] = sc * bf_lo(x.z); v[5] = sc * bf_hi(x.z); v[6] = sc * bf_lo(x.w); v[7] = sc * bf_hi(x.w);
}
template <bool HP32, bool COMBINE, bool GATES>
__device__ __forceinline__ void ln_phase(const void* hprev, const void* add, const int* tok_slot, const float* gam, const float* bet, bf16_t* hout, float* fout,
                                         const float* gwt, const float* fgate_b, float* glog, LAS unsigned char* lds, unsigned char* qout = nullptr) {
    static_assert(!(HP32 && (COMBINE || GATES)), "the f32-input form is the plain LN1 of layer 0");
    constexpr int NCH = HP32 ? 4 : 2, CW = 16 / NCH, CS = 1024 / NCH;
    const int tid = threadIdx.x, lane = tid & 63, wave = tid >> 6;
    const int gw = blockIdx.x * NWAVES + wave, NGW = gridDim.x * NWAVES;
    LAS float* gl = (LAS float*)lds;
    if (GATES) { for (int i = tid; i < 12 * 1024; i += NTHR) gl[i] = gwt[i]; __syncthreads(); }
    float g[16], bb[16];
#pragma unroll
    for (int ch = 0; ch < NCH; ++ch)
#pragma unroll
        for (int q = 0; q < CW / 4; ++q) { const f32x4 gv = *(const f32x4*)(gam + CS * ch + CW * lane + 4 * q), bv = *(const f32x4*)(bet + CS * ch + CW * lane + 4 * q);
#pragma unroll
            for (int j = 0; j < 4; ++j) { g[ch * CW + q * 4 + j] = gv[j]; bb[ch * CW + q * 4 + j] = bv[j]; } }
    for (int rp = gw; rp < T / 2; rp += NGW) {
        const int row0 = 2 * rp;
        float v[2][16];
        f32x4 xf[2][4]; u32x4 xh[2][2], am[2][2]; u32x2 am2[2][4], ay[2][4][2];
        int myslot = 0;
        if (COMBINE) myslot = tok_slot[(size_t)row0 * 4 + (lane & 7)];
#pragma unroll
        for (int r = 0; r < 2; ++r) {
            if (HP32) { const float* hp = (const float*)hprev + (size_t)(row0 + r) * 1024 + 4 * lane; const bf16_t* ap = (const bf16_t*)add + (size_t)(row0 + r) * 1024 + 4 * lane;
#pragma unroll
                for (int ch = 0; ch < 4; ++ch) { xf[r][ch] = *(const f32x4*)(hp + 256 * ch); am2[r][ch] = *(const u32x2*)(ap + 256 * ch); }
            } else { const bf16_t* hp = (const bf16_t*)hprev + (size_t)(row0 + r) * 1024 + 8 * lane; xh[r][0] = *(const u32x4*)hp; xh[r][1] = *(const u32x4*)(hp + 512);
                if (!COMBINE) { const bf16_t* ap = (const bf16_t*)add + (size_t)(row0 + r) * 1024 + 8 * lane; am[r][0] = *(const u32x4*)ap; am[r][1] = *(const u32x4*)(ap + 512); } }
        }
        if (COMBINE) {
#pragma unroll
            for (int r = 0; r < 2; ++r)
#pragma unroll
                for (int k = 0; k < 4; ++k) { const int sl = __shfl(myslot, 4 * r + k); const unsigned char* yp = (const unsigned char*)add + (size_t)sl * 1024 + 8 * lane;
                    ay[r][k][0] = *(const u32x2*)yp; ay[r][k][1] = *(const u32x2*)(yp + 512); }
        }
#pragma unroll
        for (int r = 0; r < 2; ++r) {
            if (HP32) {
#pragma unroll
                for (int ch = 0; ch < 4; ++ch) { const u32x2 mw = am2[r][ch];
                    v[r][4 * ch + 0] = DN_ALPHA * xf[r][ch][0] + bf_lo(mw.x); v[r][4 * ch + 1] = DN_ALPHA * xf[r][ch][1] + bf_hi(mw.x);
                    v[r][4 * ch + 2] = DN_ALPHA * xf[r][ch][2] + bf_lo(mw.y); v[r][4 * ch + 3] = DN_ALPHA * xf[r][ch][3] + bf_hi(mw.y); }
            } else {
                unpack_bf16x8(&v[r][0], xh[r][0], DN_ALPHA); unpack_bf16x8(&v[r][8], xh[r][1], DN_ALPHA);
                if (COMBINE) {
                    float acc[16];
#pragma unroll
                    for (int i = 0; i < 16; ++i) acc[i] = 0.f;
#pragma unroll
                    for (int k = 0; k < 4; ++k)
#pragma unroll
                        for (int ch = 0; ch < 2; ++ch) { const unsigned ww[2] = {ay[r][k][ch].x, ay[r][k][ch].y};
#pragma unroll
                            for (int q = 0; q < 2; ++q) { const f32x2 lo = __builtin_amdgcn_cvt_pk_f32_fp8((int)ww[q], false), hi = __builtin_amdgcn_cvt_pk_f32_fp8((int)ww[q], true);
                                acc[8 * ch + 4 * q + 0] += lo[0]; acc[8 * ch + 4 * q + 1] += lo[1]; acc[8 * ch + 4 * q + 2] += hi[0]; acc[8 * ch + 4 * q + 3] += hi[1]; } }
#pragma unroll
                    for (int i = 0; i < 16; ++i) v[r][i] += acc[i] * (1.0f / Y8_SCALE);
                } else { float t[16]; unpack_bf16x8(&t[0], am[r][0], 1.0f); unpack_bf16x8(&t[8], am[r][1], 1.0f);
#pragma unroll
                    for (int i = 0; i < 16; ++i) v[r][i] += t[i]; }
            }
        }
        float s[2] = {0.f, 0.f};
#pragma unroll
        for (int r = 0; r < 2; ++r)
#pragma unroll
            for (int i = 0; i < 16; ++i) s[r] += v[r][i];
        float mean[2], s2[2] = {0.f, 0.f};
#pragma unroll
        for (int r = 0; r < 2; ++r) { mean[r] = wave_sum(s[r]) * (1.0f / 1024.0f);
#pragma unroll
            for (int i = 0; i < 16; ++i) { v[r][i] -= mean[r]; s2[r] += v[r][i] * v[r][i]; } }
#pragma unroll
        for (int r = 0; r < 2; ++r) { const float rstd = 1.0f / sqrtf(wave_sum(s2[r]) * (1.0f / 1024.0f) + LN_EPS);
#pragma unroll
            for (int i = 0; i < 16; ++i) v[r][i] = v[r][i] * rstd * g[i] + bb[i]; }
#pragma unroll
        for (int r = 0; r < 2; ++r) {
            if (hout) { bf16_t* op = hout + (size_t)(row0 + r) * 1024 + CW * lane;
                if (HP32) {
#pragma unroll
                    for (int ch = 0; ch < 4; ++ch) { u32x2 w; w.x = cvt_pk_bf16(v[r][4 * ch + 0], v[r][4 * ch + 1]); w.y = cvt_pk_bf16(v[r][4 * ch + 2], v[r][4 * ch + 3]); *(u32x2*)(op + 256 * ch) = w; }
                } else {
#pragma unroll
                    for (int ch = 0; ch < 2; ++ch) { u32x4 w; w.x = cvt_pk_bf16(v[r][ch * 8 + 0], v[r][ch * 8 + 1]); w.y = cvt_pk_bf16(v[r][ch * 8 + 2], v[r][ch * 8 + 3]);
                        w.z = cvt_pk_bf16(v[r][ch * 8 + 4], v[r][ch * 8 + 5]); w.w = cvt_pk_bf16(v[r][ch * 8 + 6], v[r][ch * 8 + 7]); *(u32x4*)(op + 512 * ch) = w; } } }
            if (qout) { unsigned char* qp = qout + (size_t)(row0 + r) * 1024 + CW * lane;
                if (HP32) {
#pragma unroll
                    for (int ch = 0; ch < 4; ++ch) *(unsigned*)(qp + 256 * ch) = pg8::pk_fp8x4(v[r][4 * ch + 0], v[r][4 * ch + 1], v[r][4 * ch + 2], v[r][4 * ch + 3]);
                } else {
#pragma unroll
                    for (int ch = 0; ch < 2; ++ch) { u32x2 w; w.x = pg8::pk_fp8x4(v[r][8 * ch + 0], v[r][8 * ch + 1], v[r][8 * ch + 2], v[r][8 * ch + 3]);
                        w.y = pg8::pk_fp8x4(v[r][8 * ch + 4], v[r][8 * ch + 5], v[r][8 * ch + 6], v[r][8 * ch + 7]); *(u32x2*)(qp + 512 * ch) = w; } } }
            if (!HP32 && fout) { float* op = fout + (size_t)(row0 + r) * 1024 + 8 * lane;
#pragma unroll
                for (int ch = 0; ch < 2; ++ch)
#pragma unroll
                    for (int q = 0; q < 2; ++q) *(f32x4*)(op + 512 * ch + 4 * q) = (f32x4){v[r][ch * 8 + q * 4 + 0], v[r][ch * 8 + q * 4 + 1], v[r][ch * 8 + q * 4 + 2], v[r][ch * 8 + q * 4 + 3]}; }
            if (GATES) {
                float mine = 0.f;
#pragma unroll
                for (int j = 0; j < 12; ++j) { float p = 0.f;
#pragma unroll
                    for (int ch = 0; ch < 2; ++ch)
#pragma unroll
                        for (int q = 0; q < 2; ++q) { const f32x4 w = *(const LAS f32x4*)(gl + j * 1024 + 512 * ch + 8 * lane + 4 * q);
                            p += v[r][ch * 8 + q * 4 + 0] * w[0] + v[r][ch * 8 + q * 4 + 1] * w[1] + v[r][ch * 8 + q * 4 + 2] * w[2] + v[r][ch * 8 + q * 4 + 3] * w[3]; }
                    p = wave_sum(p); if (lane == j) mine = p; }
                if (lane < 12) { const float z = mine + fgate_b[lane]; const float ls = fminf(z, 0.f) - log1pf(expf(-fabsf(z))); glog[(size_t)(row0 + r) * 16 + lane] = ls; }
            }
        }
    }
}

__device__ __forceinline__ void top4_phase(const float* logits, const float* rb, int* tok_e, float* tok_g, int* tok_r, unsigned* wg_hist, LAS unsigned char* lds) {
    const int tid = threadIdx.x;
    LAS unsigned* hist = (LAS unsigned*)lds;
    for (int ch = blockIdx.x; ch < NCHUNK; ch += gridDim.x) {
        __syncthreads();
        if (tid < 32) hist[tid] = 0u;
        __syncthreads();
        if (tid < 256) {
            const int t = ch * 256 + tid; const float* lp = logits + (size_t)t * 32;
            float lg[32];
#pragma unroll
            for (int q = 0; q < 8; ++q) { const f32x4 hv = *(const f32x4*)(lp + 4 * q) + *(const f32x4*)(lp + (size_t)T * 32 + 4 * q), bv = *(const f32x4*)(rb + 4 * q);
#pragma unroll
                for (int j = 0; j < 4; ++j) lg[4 * q + j] = hv[j] + bv[j]; }
            unsigned used = 0u; int sel[4]; float val[4];
#pragma unroll
            for (int k = 0; k < 4; ++k) { float best = -INFINITY; int bi = 0;
#pragma unroll
                for (int e = 0; e < 32; ++e) { const float c = ((used >> e) & 1u) ? -INFINITY : lg[e]; if (c > best) { best = c; bi = e; } }
                sel[k] = bi; val[k] = best; used |= 1u << bi; }
            const float e1 = __expf(val[1] - val[0]), e2 = __expf(val[2] - val[0]), e3 = __expf(val[3] - val[0]); const float inv = 1.0f / (1.0f + e1 + e2 + e3);
            const float gt[4] = {inv, e1 * inv, e2 * inv, e3 * inv};
            int rk[4];
#pragma unroll
            for (int k = 0; k < 4; ++k) rk[k] = (int)atomicAdd((unsigned*)(hist + sel[k]), 1u);
            *(int4*)(tok_e + (size_t)t * 4) = make_int4(sel[0], sel[1], sel[2], sel[3]);
            *(f32x4*)(tok_g + (size_t)t * 4) = (f32x4){gt[0], gt[1], gt[2], gt[3]};
            *(int4*)(tok_r + (size_t)t * 4) = make_int4(rk[0], rk[1], rk[2], rk[3]);
        }
        __syncthreads();
        if (tid < 32) wg_hist[ch * 32 + tid] = hist[tid];
    }
}

__device__ __forceinline__ void assign_phase(const unsigned* wg_hist, const int* tok_e, const float* tok_g, const int* tok_r, int* tok_s, float* slot_g, int* slot_t,
                                             int* tiletab, LAS unsigned char* lds) {
    const int tid = threadIdx.x, lane = tid & 63, wave = tid >> 6;
    LAS unsigned* rtot = (LAS unsigned*)lds;
    LAS unsigned* rpre = rtot + 512;
    LAS unsigned* cnt = rpre + 512;
    LAS unsigned* pstart = cnt + 32;
    LAS unsigned* base = pstart + 40;
    LAS int* sl = (LAS int*)(base + 32);
    for (int ch = blockIdx.x; ch < NCHUNK; ch += gridDim.x) {
        __syncthreads();
        { const int e = tid & 31, part = tid >> 5; unsigned tot = 0u, pre = 0u;
          for (int c = part * 16; c < part * 16 + 16; ++c) { const unsigned hv = wg_hist[c * 32 + e]; tot += hv; if (c < ch) pre += hv; }
          rtot[part * 32 + e] = tot; rpre[part * 32 + e] = pre; }
        __syncthreads();
        if (tid < 32) { unsigned tot = 0u, pre = 0u;
            for (int p = 0; p < 16; ++p) { tot += rtot[p * 32 + tid]; pre += rpre[p * 32 + tid]; }
            cnt[tid] = tot; base[tid] = pre; }
        __syncthreads();
        if (tid == 0) { unsigned acc = 0u; for (int e = 0; e < 32; ++e) { pstart[e] = acc; acc += (cnt[e] + 255u) & ~255u; } pstart[32] = acc; }
        __syncthreads();
        if (tid < 256) { const int t = ch * 256 + tid;
            const int4 e4 = *(const int4*)(tok_e + (size_t)t * 4), r4 = *(const int4*)(tok_r + (size_t)t * 4); const f32x4 g4 = *(const f32x4*)(tok_g + (size_t)t * 4);
            const int es[4] = {e4.x, e4.y, e4.z, e4.w}, rs[4] = {r4.x, r4.y, r4.z, r4.w}; int so[4];
#pragma unroll
            for (int k = 0; k < 4; ++k) { so[k] = (int)(pstart[es[k]] + base[es[k]]) + rs[k]; slot_g[so[k]] = g4[k]; slot_t[so[k]] = t; }
            *(int4*)(tok_s + (size_t)t * 4) = make_int4(so[0], so[1], so[2], so[3]); }
        __syncthreads();
        if (ch == (int)blockIdx.x) {
            for (int e = blockIdx.x; e < NE; e += gridDim.x) {
                const int p0 = (int)(pstart[e] + cnt[e]), p1 = (int)pstart[e + 1];
                for (int s = p0 + tid; s < p1; s += NTHR) { slot_g[s] = 0.f; slot_t[s] = 0; }
                for (int tl = (int)(pstart[e] >> 8) + tid; tl < (int)(pstart[e + 1] >> 8); tl += NTHR) tiletab[16 + tl] = e;
            }
            if (blockIdx.x == 0 && tid == 0) tiletab[0] = (int)(pstart[32] >> 8);
        }
    }
}

__global__ void __launch_bounds__(NTHR, 2) fwd_kernel(Args args) {
    extern __shared__ __attribute__((aligned(16))) unsigned char lds_raw[];
    LAS unsigned char* lds = (LAS unsigned char*)lds_raw;
    volatile LAS unsigned* MISC = (volatile LAS unsigned*)(lds + MISC_OFF);
    const int tid = threadIdx.x, lane = tid & 63, wave = __builtin_amdgcn_readfirstlane(tid >> 6);
    const int G = gridDim.x;
    unsigned char* ws = args.ws;
    unsigned* ctl = (unsigned*)(ws + WS_CTL);
    if (tid < 32) MISC[tid] = 0u;
    __syncthreads();
    XcdBarrier bar; bar.bar = ctl + CW_BAR; bar.x = 0; bar.st = nullptr;
#if !MK_PER_PHASE
    bar = xcd_barrier_post(ctl + CW_BAR, MISC + 8);
#endif
    const int lo = args.ph_lo, hi = args.ph_hi;
#ifndef PH_MASK
#define PH_MASK 0xFFFFFFFFu
#endif
#ifndef PH_TWICE
#define PH_TWICE 0u
#endif
#define TW(k) ((((unsigned)PH_TWICE >> (k)) & 1u) != 0u)
#define IN(k) (((PH_MASK >> (k)) & 1u) && lo <= (k) && (k) < hi)
#if MK_PER_PHASE
#define SEAM(k) do { } while (0)
#else
#define SEAM(k) do { if (IN(k) && IN((k) + 1)) xcd_barrier(bar); } while (0)
#endif
    bf16_t* const R1 = (bf16_t*)(ws + WS_R1); bf16_t* const R2 = (bf16_t*)(ws + WS_R2);
    bf16_t* const PROJ = (bf16_t*)(ws + WS_PROJ); bf16_t* const CAT = (bf16_t*)(ws + WS_CAT); bf16_t* const MIX = (bf16_t*)(ws + WS_MIX); bf16_t* const DBUF = (bf16_t*)(ws + WS_DBUF);
    bf16_t* const KF = (bf16_t*)(ws + WS_KF); bf16_t* const VF = (bf16_t*)(ws + WS_VF);
    bf16_t* const ACT = (bf16_t*)(ws + WS_ACT); bf16_t* const YB = (bf16_t*)(ws + WS_Y);
    unsigned char* const MEMB = ws + WS_MEMB; bf16_t* const KVMEM = (bf16_t*)(ws + WS_KVMEM);
    float* const LOGITS = (float*)(ws + WS_LOGITS); float* const GLOG = (float*)(ws + WS_GLOG);
    int* const TOKE = (int*)(ws + WS_TOKE); float* const TOKG = (float*)(ws + WS_TOKG); int* const TOKR = (int*)(ws + WS_TOKR); int* const TOKS = (int*)(ws + WS_TOKS);
    float* const SLOTG = (float*)(ws + WS_SLOTG); int* const SLOTT = (int*)(ws + WS_SLOTT);
    unsigned* const WGH = (unsigned*)(ws + WS_WGHIST); int* const TILETAB = (int*)(ws + WS_TILETAB);

    if (IN(0)) { p0_prologue(args, lds, wave, lane); } if (TW(0) && IN(0)) { p0_prologue(args, lds, wave, lane); }
    SEAM(0);
    if (IN(1)) {
        { pg8::Gemm g{R1, ws + WS_WINA, T, 1024, 2048}; pg8::StaticOrder So; So.init(T, 1024, G, (int)blockIdx.x);
          pg8::EpiBf16 E{PROJ, 1024, nullptr, 0, 0, 1.0f}; pg8::gemm_phase(lds, g, So, E); }
        { pg8::Gemm g{MEMB, ws + WS_WMKV, NB * MEMT, 1024, 1024}; pg8::StaticOrder So; So.init(NB * MEMT, 1024, G, (int)((blockIdx.x + 128) % G));
          pg8::EpiBf16 E{KVMEM, 1024, nullptr, 0, 0, 1.0f / pg8::W8_SCALE}; pg8::gemm_phase<pg8::EpiBf16, pg8::StaticOrder, true>(lds, g, So, E); }
    }
    SEAM(1);
    if (IN(2)) { pool_d_phase(PROJ, CAT); memattn_mfma(PROJ, KVMEM, 0, CAT, lds); } if (TW(2) && IN(2)) { pool_d_phase(PROJ, CAT); memattn_mfma(PROJ, KVMEM, 0, CAT, lds); }
    SEAM(2);
    if (IN(4)) { pg8::Gemm g{CAT, ws + WS_WOUTA, T, 1024, 2048}; pg8::StaticOrder So; So.init(T, 1024, G, (int)blockIdx.x);
        pg8::EpiBf16 E{MIX, 1024, nullptr, 0, 0, 1.0f}; pg8::gemm_phase(lds, g, So, E); }
    SEAM(4);
    if (IN(5)) ln_phase<false, false, false>(R1, MIX, nullptr, args.in[2], args.in[3], R1, nullptr, nullptr, nullptr, nullptr, lds, ws + WS_H1Q); if (TW(5) && IN(5)) ln_phase<false, false, false>(R1, MIX, nullptr, args.in[2], args.in[3], R1, nullptr, nullptr, nullptr, nullptr, lds, ws + WS_H1Q);
    SEAM(5);
#define MOE_BLOCK(P, L, HIN) \
    if (IN(P)) { pg8::Gemm g{HIN, ws + WS_WR + (size_t)(L) * 256 * 2048, T, 256, 2048}; pg8::StaticOrder So; So.init(T, 256, G, (int)blockIdx.x); \
        if (G == 256) { pg8::EpiRouter E{args.in[17] + (L) * 32, TOKE, TOKG, TOKR, WGH}; pg8::gemm_phase(lds, g, So, E); } \
        else { pg8::EpiLogits E{LOGITS}; pg8::gemm_phase(lds, g, So, E); } } \
    if (G != 256) SEAM(P); \
    if (G != 256 && IN((P) + 1)) top4_phase(LOGITS, args.in[17] + (L) * 32, TOKE, TOKG, TOKR, WGH, lds); \
    SEAM((P) + 1); \
    if (IN((P) + 2)) assign_phase(WGH, TOKE, TOKG, TOKR, TOKS, SLOTG, SLOTT, TILETAB, lds); if (TW((P) + 2) && IN((P) + 2)) assign_phase(WGH, TOKE, TOKG, TOKR, TOKS, SLOTG, SLOTT, TILETAB, lds); \
    SEAM((P) + 2); \
    if (IN((P) + 3)) { LAS int* tab = (LAS int*)(lds + TAB_OFF); const int ntl = (int)__hip_atomic_load((unsigned*)TILETAB, RLX_AGENT); \
        for (int i = tid; i < NTILE_MAX; i += NTHR) tab[i] = (i < ntl) ? TILETAB[16 + i] : 0; __syncthreads(); \
        pg8::Gemm g{ws + WS_H1Q, ws + WS_W1 + (size_t)(L) * 32 * 2048 * 1024, NSLOT_MAX, 2048, 1024}; pg8::MoeOrder Mo{ntl, 8, G, (int)blockIdx.x, tab}; \
        pg8::EpiSwiglu E{(unsigned char*)ACT, (const float*)(ws + WS_B1P) + (size_t)(L) * 32 * 2048}; pg8::gemm_phase<pg8::EpiSwiglu, pg8::MoeOrder, true, true>(lds, g, Mo, E, SLOTT); } \
    SEAM((P) + 3); \
    if (IN((P) + 4)) { LAS int* tab = (LAS int*)(lds + TAB_OFF); const int ntl = (int)__hip_atomic_load((unsigned*)TILETAB, RLX_AGENT); \
        for (int i = tid; i < NTILE_MAX; i += NTHR) tab[i] = (i < ntl) ? TILETAB[16 + i] : 0; __syncthreads(); \
        pg8::Gemm g{ACT, ws + WS_W2 + (size_t)(L) * 32 * 1024 * 1024, NSLOT_MAX, 1024, 1024}; pg8::MoeOrder Mo{ntl, 4, G, (int)blockIdx.x, tab}; \
        pg8::EpiMoe2 E{(unsigned char*)YB, args.in[21] + (size_t)(L) * 32 * 1024, SLOTG, Y8_SCALE}; pg8::gemm_phase<pg8::EpiMoe2, pg8::MoeOrder, true>(lds, g, Mo, E); } \
    SEAM((P) + 4);
    MOE_BLOCK(6, 0, R1)
    if (IN(11)) ln_phase<false, true, true>(R1, YB, TOKS, args.in[4], args.in[5], R2, nullptr, (const float*)(ws + WS_GWT), args.in[12], GLOG, lds, ws + WS_H1Q); if (TW(11) && IN(11)) ln_phase<false, true, true>(R1, YB, TOKS, args.in[4], args.in[5], R2, nullptr, (const float*)(ws + WS_GWT), args.in[12], GLOG, lds, ws + WS_H1Q);
    SEAM(11);
    if (IN(12)) {
        { pg8::Gemm g{ws + WS_H1Q, ws + WS_WKV, T, 1536, 1024}; pg8::StaticOrder So; So.init(T, 1536, G, (int)blockIdx.x);
          pg8::EpiMixed8 E{ws + WS_KF, 768, 1.0f / pg8::W8_SCALE, 3, VF, 768, 1, 1.0f / pg8::W8_SCALE}; pg8::gemm_phase<pg8::EpiMixed8, pg8::StaticOrder, true>(lds, g, So, E); }
        { pg8::Gemm g{ws + WS_H1Q, ws + WS_WINB, T, 1024, 1024}; pg8::StaticOrder So; So.init(T, 1024, G, (int)blockIdx.x);
          pg8::EpiMixed8 E{ws + WS_Q8, 768, ATT_C2 * ATT_S8 / pg8::W8_SCALE, 3, PROJ, 1024, 0, 1.0f / pg8::W8_SCALE}; pg8::gemm_phase<pg8::EpiMixed8, pg8::StaticOrder, true>(lds, g, So, E); }
    }
    SEAM(12);
    if (IN(13)) { fox_mfma(ws + WS_Q8, ws + WS_KF, VF, GLOG, CAT, lds); memattn_mfma(PROJ, KVMEM, 512, CAT, lds); } if (TW(13) && IN(13)) { fox_mfma(ws + WS_Q8, ws + WS_KF, VF, GLOG, CAT, lds); memattn_mfma(PROJ, KVMEM, 512, CAT, lds); }
    SEAM(13);
    if (IN(14)) { pg8::Gemm g{CAT, ws + WS_WOUTB, T, 1024, 2048}; pg8::StaticOrder So; So.init(T, 1024, G, (int)blockIdx.x);
        pg8::EpiBf16 E{MIX, 1024, nullptr, 0, 0, 1.0f}; pg8::gemm_phase(lds, g, So, E); }
    SEAM(14);
    if (IN(15)) ln_phase<false, false, false>(R2, MIX, nullptr, args.in[2] + 1024, args.in[3] + 1024, R1, nullptr, nullptr, nullptr, nullptr, lds, ws + WS_H1Q); if (TW(15) && IN(15)) ln_phase<false, false, false>(R2, MIX, nullptr, args.in[2] + 1024, args.in[3] + 1024, R1, nullptr, nullptr, nullptr, nullptr, lds, ws + WS_H1Q);
    SEAM(15);
    MOE_BLOCK(16, 1, R1)
    if (IN(21)) ln_phase<false, true, false>(R1, YB, TOKS, args.in[4] + 1024, args.in[5] + 1024, nullptr, args.out, nullptr, nullptr, nullptr, lds); if (TW(21) && IN(21)) ln_phase<false, true, false>(R1, YB, TOKS, args.in[4] + 1024, args.in[5] + 1024, nullptr, args.out, nullptr, nullptr, nullptr, lds);
#undef IN
#undef SEAM
}

extern "C" void kernel_launch(void* const* d_in, const int* in_sizes, int n_in, void* d_out, int out_size, void* d_ws, size_t ws_size, hipStream_t stream) {
    static int grid = 0;
    if (grid == 0) {
        if (n_in != 22 || out_size != T * D || ws_size < WS_END) { fprintf(stderr, "kernel_launch: unexpected problem (n_in %d out %d ws %zu)\n", n_in, out_size, ws_size); grid = -1; return; }
        int dev = 0, cus = 0;
        if (hipGetDevice(&dev) != hipSuccess || hipDeviceGetAttribute(&cus, hipDeviceAttributeMultiprocessorCount, dev) != hipSuccess) { grid = -1; return; }
        if (hipFuncSetAttribute((const void*)fwd_kernel, hipFuncAttributeMaxDynamicSharedMemorySize, LDS_BYTES) != hipSuccess) { fprintf(stderr, "kernel_launch: hipFuncSetAttribute failed\n"); grid = -1; return; }
        int per_cu = 0;
        if (hipOccupancyMaxActiveBlocksPerMultiprocessor(&per_cu, (const void*)fwd_kernel, NTHR, LDS_BYTES) != hipSuccess || per_cu < 1) fprintf(stderr, "kernel_launch: occupancy query says %d\n", per_cu);
        (void)hipGetLastError();
        grid = cus;
    }
    if (grid < 0) return;
    if (hipMemsetAsync((char*)d_ws + WS_CTL, 0, CTL_ZERO_BYTES, stream) != hipSuccess) return;
    Args a{};
    for (int i = 0; i < 22; ++i) a.in[i] = (const float*)d_in[i];
    a.out = (float*)d_out; a.ws = (unsigned char*)d_ws;
#if MK_PER_PHASE
    for (int p = 0; p < NPH; ++p) { a.ph_lo = p; a.ph_hi = p + 1; hipLaunchKernelGGL(fwd_kernel, dim3(grid), dim3(NTHR), LDS_BYTES, stream, a); }
#else
    a.ph_lo = 0; a.ph_hi = NPH; hipLaunchKernelGGL(fwd_kernel, dim3(grid), dim3(NTHR), LDS_BYTES, stream, a);
#endif
}
```

```cpp
#include <hip/hip_runtime.h>
#include <cstdio>
#include <cstdint>

#ifndef MK_PER_PHASE
#define MK_PER_PHASE 0
#endif

#define LAS __attribute__((address_space(3)))
#define GAS __attribute__((address_space(1)))
typedef unsigned short bf16_t;
typedef short bf16x8 __attribute__((ext_vector_type(8)));
typedef float f32x4 __attribute__((ext_vector_type(4)));
typedef float f32x2 __attribute__((ext_vector_type(2)));
typedef unsigned u32x4 __attribute__((ext_vector_type(4)));
typedef unsigned u32x2 __attribute__((ext_vector_type(2)));

__device__ __forceinline__ unsigned cvt_pk_bf16(float lo, float hi) { unsigned r; asm volatile("v_cvt_pk_bf16_f32 %0, %1, %2" : "=v"(r) : "v"(lo), "v"(hi)); return r; }
__device__ __forceinline__ float bf_lo(unsigned w) { return __uint_as_float(w << 16); }
__device__ __forceinline__ float bf_hi(unsigned w) { return __uint_as_float(w & 0xffff0000u); }

namespace pg8 {
constexpr int BM = 256, BK = 64, HALF = 128, HTB = HALF * BK * 2, STAGE_BYTES = 8 * HTB, NXCD = 8, WGM = 8;
__host__ __device__ __forceinline__ int lds_byte(int r, int c) { const int st = (r >> 4) * 2 + (c >> 5), rr = r & 15, cc = c & 31, ob = rr * 64 + cc * 2; return st * 1024 + (ob ^ (((ob >> 9) & 1) << 5)); }
__host__ __device__ __forceinline__ void stage_rc(int b, int& R, int& C) { const int st = b / 1024, sb = b % 1024, swz = sb ^ (((sb >> 9) & 1) << 5); R = (st >> 1) * 16 + swz / 64; C = (st & 1) * 32 + (swz % 64) / 2; }
__host__ __device__ __forceinline__ int perm32(int rho) { const int n = rho >> 4, i = rho & 15; return 8 * (i >> 2) + 4 * n + (i & 3); }

struct Unit { int pm, pn, e; };
struct Gemm { const void* A; const void* Bt; int M, N, Kb; };

struct StaticOrder {
    int nM, nN, nwg, G, c;
    __device__ void init(int M, int N, int G_, int c_) { nM = M / BM; nN = N / BM; nwg = nM * nN; G = G_; c = c_; }
    __device__ bool next(int i, Unit& u) const {
        const long L = (long)i * G + c; if (L >= nwg) return false;
        int wgid = (int)L; { const int q = nwg / NXCD, r = nwg % NXCD, xcd = wgid % NXCD, off = wgid / NXCD; wgid = (xcd < r ? xcd * (q + 1) : r * (q + 1) + (xcd - r) * q) + off; }
        const int nig = WGM * nN, gid = wgid / nig, fm = gid * WGM, gsz = (nM - fm) < WGM ? (nM - fm) : WGM;
        u.pm = fm + ((wgid % nig) % gsz); u.pn = (wgid % nig) / gsz; u.e = 0; return true;
    }
};
struct MoeOrder {
    int n_tiles, nN, G, c; const LAS int* tab;
    __device__ bool next(int i, Unit& u) const {
        int rt, pn;
        if (G == 256) { const int x = c & 7, r = c >> 3, rpi = 32 / nN, tpx = (n_tiles + 7) >> 3, lt = rpi * i + r / nN;
            if (lt >= tpx) return false; rt = x * tpx + lt; pn = r % nN; }

        else { const long L = (long)i * G + c; rt = (int)(L / nN); pn = (int)(L % nN); }
        if (rt >= n_tiles) return false;
        u.pm = rt; u.pn = pn; u.e = __builtin_amdgcn_readfirstlane(tab[rt]); return true;
    }
};

struct EpiBf16 {
    static constexpr bool PERM = true, AFTER = false, ALIGN = false; static constexpr bool SKIP_B1 = false;
    struct Pre {}; __device__ __forceinline__ Pre preload(const Unit&, int, int, int, int) const { return Pre{}; } static constexpr int NPRE = 0; static constexpr bool HOISTOK = false; static __device__ __forceinline__ void touch(Pre&) {}
    __device__ __forceinline__ const float* stash_ptr(const Unit&, int) const { return nullptr; } __device__ __forceinline__ Pre from_stash(const LAS float*, int, int, int, int) const { return Pre{}; }
    bf16_t* O; int ldc; const float* colscale; int split_cols; size_t split_stride; float scale;
    __device__ __forceinline__ void operator()(const f32x4 (&acc)[2][2][4][2], const Unit& u, int wr, int wc, int fr, int fq, const Pre&) const {
        const int row0 = u.pm * BM + wr * 64 + fr; int colt = u.pn * BM; bf16_t* base = O;
        if (split_cols) { const int t = colt / split_cols; base += (size_t)t * split_stride; colt -= t * split_cols; }
        const int col0 = colt + wc * 32 + 8 * fq, scol0 = u.pn * BM + wc * 32 + 8 * fq;
        f32x4 sv[2][2];
#pragma unroll
        for (int bj = 0; bj < 2; ++bj)
#pragma unroll
            for (int n = 0; n < 2; ++n) sv[bj][n] = colscale ? *(const f32x4*)(colscale + scol0 + bj * HALF + 4 * n) * scale : (f32x4){scale, scale, scale, scale};
#pragma unroll
        for (int ai = 0; ai < 2; ++ai)
#pragma unroll
            for (int m = 0; m < 4; ++m) { bf16_t* rowp = base + (size_t)(row0 + ai * HALF + m * 16) * ldc + col0;
#pragma unroll
                for (int bj = 0; bj < 2; ++bj) { const f32x4 v0 = acc[ai][bj][m][0] * sv[bj][0], v1 = acc[ai][bj][m][1] * sv[bj][1];
                    u32x4 w; w.x = cvt_pk_bf16(v0[0], v0[1]); w.y = cvt_pk_bf16(v0[2], v0[3]); w.z = cvt_pk_bf16(v1[0], v1[1]); w.w = cvt_pk_bf16(v1[2], v1[3]);
                    *(u32x4*)(rowp + bj * HALF) = w; } }
    }
};
__device__ __forceinline__ unsigned pk_fp8x4(float a, float b, float c, float d) { int w = 0; w = __builtin_amdgcn_cvt_pk_fp8_f32(a, b, w, false); w = __builtin_amdgcn_cvt_pk_fp8_f32(c, d, w, true); return (unsigned)w; }
constexpr float W8_SCALE = 64.0f, ACT8_SCALE = 4.0f;
struct EpiMixed8 {
    static constexpr bool PERM = true, AFTER = false, ALIGN = false; static constexpr bool SKIP_B1 = false;
    struct Pre {}; __device__ __forceinline__ Pre preload(const Unit&, int, int, int, int) const { return Pre{}; } static constexpr int NPRE = 0; static constexpr bool HOISTOK = false; static __device__ __forceinline__ void touch(Pre&) {}
    __device__ __forceinline__ const float* stash_ptr(const Unit&, int) const { return nullptr; } __device__ __forceinline__ Pre from_stash(const LAS float*, int, int, int, int) const { return Pre{}; }
    unsigned char* O8; int ld8; float scale8; int ncut8; bf16_t* O16; int ld16; int rebase16; float scale16;
    __device__ __forceinline__ void operator()(const f32x4 (&acc)[2][2][4][2], const Unit& u, int wr, int wc, int fr, int fq, const Pre&) const {
        const int row0 = u.pm * BM + wr * 64 + fr;
        if (u.pn < ncut8) {
            const int col0 = u.pn * BM + wc * 32 + 8 * fq;
#pragma unroll
            for (int ai = 0; ai < 2; ++ai)
#pragma unroll
                for (int m = 0; m < 4; ++m) { unsigned char* rowp = O8 + (size_t)(row0 + ai * HALF + m * 16) * ld8 + col0;
#pragma unroll
                    for (int bj = 0; bj < 2; ++bj) { const f32x4 v0 = acc[ai][bj][m][0] * scale8, v1 = acc[ai][bj][m][1] * scale8;
                        u32x2 w; w.x = pk_fp8x4(v0[0], v0[1], v0[2], v0[3]); w.y = pk_fp8x4(v1[0], v1[1], v1[2], v1[3]); *(u32x2*)(rowp + bj * HALF) = w; } }
        } else {
            const int col0 = (u.pn - (rebase16 ? ncut8 : 0)) * BM + wc * 32 + 8 * fq;
#pragma unroll
            for (int ai = 0; ai < 2; ++ai)
#pragma unroll
                for (int m = 0; m < 4; ++m) { bf16_t* rowp = O16 + (size_t)(row0 + ai * HALF + m * 16) * ld16 + col0;
#pragma unroll
                    for (int bj = 0; bj < 2; ++bj) { const f32x4 v0 = acc[ai][bj][m][0] * scale16, v1 = acc[ai][bj][m][1] * scale16;
                        u32x4 w; w.x = cvt_pk_bf16(v0[0], v0[1]); w.y = cvt_pk_bf16(v0[2], v0[3]); w.z = cvt_pk_bf16(v1[0], v1[1]); w.w = cvt_pk_bf16(v1[2], v1[3]); *(u32x4*)(rowp + bj * HALF) = w; } }
        }
    }
};
struct EpiLogits {
    static constexpr bool PERM = false, AFTER = false, ALIGN = true; static constexpr bool SKIP_B1 = true;
    struct Pre {}; __device__ __forceinline__ Pre preload(const Unit&, int, int, int, int) const { return Pre{}; } static constexpr int NPRE = 0; static constexpr bool HOISTOK = false; static __device__ __forceinline__ void touch(Pre&) {}
    __device__ __forceinline__ const float* stash_ptr(const Unit&, int) const { return nullptr; } __device__ __forceinline__ Pre from_stash(const LAS float*, int, int, int, int) const { return Pre{}; }
    float* L;
    __device__ __forceinline__ void operator()(const f32x4 (&acc)[2][2][4][2], const Unit& u, int wr, int wc, int fr, int fq, const Pre&) const {
        if (wc > 1) return;
        const int row0 = u.pm * BM + wr * 64 + fr;
#pragma unroll
        for (int ai = 0; ai < 2; ++ai)
#pragma unroll
            for (int m = 0; m < 4; ++m) { float* rowp = L + (size_t)wc * 65536 * 32 + (size_t)(row0 + ai * HALF + m * 16) * 32 + 4 * fq;
#pragma unroll
                for (int n = 0; n < 2; ++n) *(f32x4*)(rowp + n * 16) = acc[ai][0][m][n]; }
    }
};
struct EpiRouter {
    static constexpr bool PERM = false, AFTER = true, ALIGN = true; static constexpr bool SKIP_B1 = true;
    struct Pre {}; __device__ __forceinline__ Pre preload(const Unit&, int, int, int, int) const { return Pre{}; } static constexpr int NPRE = 0; static constexpr bool HOISTOK = false; static __device__ __forceinline__ void touch(Pre&) {}
    __device__ __forceinline__ const float* stash_ptr(const Unit&, int) const { return nullptr; } __device__ __forceinline__ Pre from_stash(const LAS float*, int, int, int, int) const { return Pre{}; }
    const float* rb; int* tok_e; float* tok_g; int* tok_r; unsigned* wg_hist;
    __device__ __forceinline__ void operator()(const f32x4 (&)[2][2][4][2], const Unit&, int, int, int, int, const Pre&) const {}
    __device__ __forceinline__ void after(const f32x4 (&acc)[2][2][4][2], const Unit& u, int wr, int wc, int fr, int fq, LAS unsigned char* lds) const {
        LAS float* Lg = (LAS float*)lds;
        LAS unsigned* hist = (LAS unsigned*)(lds + 2 * 256 * 33 * 4);
        const int tid = threadIdx.x;
        if (wc < 2) {
#pragma unroll
            for (int ai = 0; ai < 2; ++ai)
#pragma unroll
                for (int m = 0; m < 4; ++m) { LAS float* rowp = Lg + wc * (256 * 33) + (ai * HALF + wr * 64 + m * 16 + fr) * 33 + 4 * fq;
#pragma unroll
                    for (int n = 0; n < 2; ++n) { const f32x4 v = acc[ai][0][m][n]; rowp[n * 16 + 0] = v[0]; rowp[n * 16 + 1] = v[1]; rowp[n * 16 + 2] = v[2]; rowp[n * 16 + 3] = v[3]; } }
        }
        if (tid < 32) hist[tid] = 0u;
        __syncthreads();
        if (tid < 256) {
            const int t = u.pm * BM + tid; const LAS float* lp = Lg + tid * 33;
            float lg[32];
#pragma unroll
            for (int e = 0; e < 32; ++e) lg[e] = (lp[e] + lp[256 * 33 + e]) + rb[e];
            unsigned used = 0u; int sel[4]; float val[4];
#pragma unroll
            for (int k = 0; k < 4; ++k) { float best = -INFINITY; int bi = 0;
#pragma unroll
                for (int e = 0; e < 32; ++e) { const float c = ((used >> e) & 1u) ? -INFINITY : lg[e]; if (c > best) { best = c; bi = e; } }
                sel[k] = bi; val[k] = best; used |= 1u << bi; }
            const float e1 = __expf(val[1] - val[0]), e2 = __expf(val[2] - val[0]), e3 = __expf(val[3] - val[0]); const float inv = 1.0f / (1.0f + e1 + e2 + e3);
            int rk[4];
#pragma unroll
            for (int k = 0; k < 4; ++k) rk[k] = (int)atomicAdd((unsigned*)(hist + sel[k]), 1u);
            *(int4*)(tok_e + (size_t)t * 4) = make_int4(sel[0], sel[1], sel[2], sel[3]);
            *(f32x4*)(tok_g + (size_t)t * 4) = (f32x4){inv, e1 * inv, e2 * inv, e3 * inv};
            *(int4*)(tok_r + (size_t)t * 4) = make_int4(rk[0], rk[1], rk[2], rk[3]);
        }
        __syncthreads();
        if (tid < 32) wg_hist[u.pm * 32 + tid] = hist[tid];
    }
};
struct EpiSwiglu {
    static constexpr bool PERM = true, AFTER = false, ALIGN = true; static constexpr bool SKIP_B1 = false;
    unsigned char* O; const float* b1p;
    struct Pre { f32x4 bg[2], bl[2]; }; static constexpr bool HOISTOK = true; static constexpr int NPRE = 4;
    __device__ __forceinline__ const float* stash_ptr(const Unit& u, int tid) const { return b1p + (size_t)u.e * 2048 + u.pn * BM + (tid & 255); }
    __device__ __forceinline__ Pre from_stash(const LAS float* st, int wr, int wc, int fr, int fq) const { Pre p; const LAS float* bp = st + wc * 32 + 8 * fq;
        p.bg[0] = *(const LAS f32x4*)bp; p.bg[1] = *(const LAS f32x4*)(bp + 4); p.bl[0] = *(const LAS f32x4*)(bp + HALF); p.bl[1] = *(const LAS f32x4*)(bp + HALF + 4); return p; }
    static __device__ __forceinline__ void touch(Pre& p) { asm volatile("" : "+v"(p.bg[0]), "+v"(p.bg[1]), "+v"(p.bl[0]), "+v"(p.bl[1])); }
    __device__ __forceinline__ Pre preload(const Unit& u, int wr, int wc, int fr, int fq) const {
        Pre p; const float* bp = b1p + (size_t)u.e * 2048 + u.pn * BM + wc * 32 + 8 * fq;
#pragma unroll
        for (int n = 0; n < 2; ++n) { p.bg[n] = *(const f32x4*)(bp + 4 * n); p.bl[n] = *(const f32x4*)(bp + HALF + 4 * n); }
        return p; }
    __device__ __forceinline__ void operator()(const f32x4 (&acc)[2][2][4][2], const Unit& u, int wr, int wc, int fr, int fq, const Pre& pre) const {
        const int row0 = u.pm * BM + wr * 64 + fr, ocol0 = u.pn * HALF + wc * 32 + 8 * fq;
#pragma unroll
        for (int ai = 0; ai < 2; ++ai)
#pragma unroll
            for (int m = 0; m < 4; ++m) { unsigned char* rowp = O + (size_t)(row0 + ai * HALF + m * 16) * 1024 + ocol0; float r[8];
#pragma unroll
                for (int n = 0; n < 2; ++n) { const f32x4 g = acc[ai][0][m][n] * (1.0f / W8_SCALE) + pre.bg[n], l = acc[ai][1][m][n] * (1.0f / W8_SCALE) + pre.bl[n];
#pragma unroll
                    for (int j = 0; j < 4; j += 2) {
                        const f32x2 xg = {fminf(g[j], 7.0f), fminf(g[j + 1], 7.0f)}, xl = {__builtin_amdgcn_fmed3f(l[j], -7.0f, 7.0f), __builtin_amdgcn_fmed3f(l[j + 1], -7.0f, 7.0f)};
                        const f32x2 t = xg * (-1.702f * 1.4426950408889634f);
                        const f32x2 d = (f32x2){__builtin_amdgcn_exp2f(t[0]), __builtin_amdgcn_exp2f(t[1])} + 1.0f;
                        const f32x2 sg = {__builtin_amdgcn_rcpf(d[0]), __builtin_amdgcn_rcpf(d[1])};
                        const f32x2 o = (xg * sg) * (xl * ACT8_SCALE + ACT8_SCALE);
                        r[4 * n + j] = o[0]; r[4 * n + j + 1] = o[1]; } }
                u32x2 w; w.x = pk_fp8x4(r[0], r[1], r[2], r[3]); w.y = pk_fp8x4(r[4], r[5], r[6], r[7]);
                *(u32x2*)rowp = w; }
    }
};
struct EpiMoe2 {
    static constexpr bool PERM = true, AFTER = false, ALIGN = true; static constexpr bool SKIP_B1 = false;
    unsigned char* O; const float* b2; const float* gate; float yscale;
    struct Pre { f32x4 bv[2][2]; float gts[2][4]; }; static constexpr bool HOISTOK = true; static constexpr int NPRE = 12;
    __device__ __forceinline__ const float* stash_ptr(const Unit& u, int tid) const { return tid < 256 ? gate + u.pm * BM + tid : b2 + (size_t)u.e * 1024 + u.pn * BM + (tid - 256); }
    __device__ __forceinline__ Pre from_stash(const LAS float* st, int wr, int wc, int fr, int fq) const { Pre p; const LAS float* bp = st + 256 + wc * 32 + 8 * fq;
#pragma unroll
        for (int bj = 0; bj < 2; ++bj) { p.bv[bj][0] = *(const LAS f32x4*)(bp + bj * HALF); p.bv[bj][1] = *(const LAS f32x4*)(bp + bj * HALF + 4); }
#pragma unroll
        for (int ai = 0; ai < 2; ++ai)
#pragma unroll
            for (int m = 0; m < 4; ++m) p.gts[ai][m] = st[ai * HALF + wr * 64 + m * 16 + fr];
        return p; }

    static __device__ __forceinline__ void touch(Pre& p) { asm volatile("" : "+v"(p.bv[0][0]), "+v"(p.bv[0][1]), "+v"(p.bv[1][0]), "+v"(p.bv[1][1]));
        asm volatile("" : "+v"(p.gts[0][0]), "+v"(p.gts[0][1]), "+v"(p.gts[0][2]), "+v"(p.gts[0][3]), "+v"(p.gts[1][0]), "+v"(p.gts[1][1]), "+v"(p.gts[1][2]), "+v"(p.gts[1][3])); }
    __device__ __forceinline__ Pre preload(const Unit& u, int wr, int wc, int fr, int fq) const {
        Pre p; const int row0 = u.pm * BM + wr * 64 + fr; const float* bp = b2 + (size_t)u.e * 1024 + u.pn * BM + wc * 32 + 8 * fq;
#pragma unroll
        for (int bj = 0; bj < 2; ++bj)
#pragma unroll
            for (int n = 0; n < 2; ++n) p.bv[bj][n] = *(const f32x4*)(bp + bj * HALF + 4 * n);
#pragma unroll
        for (int ai = 0; ai < 2; ++ai)
#pragma unroll
            for (int m = 0; m < 4; ++m) p.gts[ai][m] = gate[row0 + ai * HALF + m * 16];
        return p; }
    __device__ __forceinline__ void operator()(const f32x4 (&acc)[2][2][4][2], const Unit& u, int wr, int wc, int fr, int fq, const Pre& pre) const {
        const int row0 = u.pm * BM + wr * 64 + fr, col0 = u.pn * BM + wc * 32 + 8 * fq;
#pragma unroll
        for (int ai = 0; ai < 2; ++ai)
#pragma unroll
            for (int m = 0; m < 4; ++m) { const int row = row0 + ai * HALF + m * 16; const float gt = pre.gts[ai][m] * yscale; unsigned char* rowp = O + (size_t)row * 1024 + col0;
#pragma unroll
                for (int bj = 0; bj < 2; ++bj) { const f32x4 v0 = (acc[ai][bj][m][0] * (1.0f / (W8_SCALE * ACT8_SCALE)) + pre.bv[bj][0]) * gt, v1 = (acc[ai][bj][m][1] * (1.0f / (W8_SCALE * ACT8_SCALE)) + pre.bv[bj][1]) * gt;
#define Y8C(x) __builtin_amdgcn_fmed3f((x), -448.0f, 448.0f)
                    u32x2 w; w.x = pk_fp8x4(Y8C(v0[0]), Y8C(v0[1]), Y8C(v0[2]), Y8C(v0[3])); w.y = pk_fp8x4(Y8C(v1[0]), Y8C(v1[1]), Y8C(v1[2]), Y8C(v1[3]));
#undef Y8C
                    *(u32x2*)(rowp + bj * HALF) = w; } }
    }
};

#ifndef F8_SCALE
#define F8_SCALE 0
#endif
constexpr int STASH_OFF = 8 * HTB + 4608 + 128;
typedef int i32x8 __attribute__((ext_vector_type(8)));
typedef int i32x4 __attribute__((ext_vector_type(4)));
__device__ __forceinline__ i32x8 cat8(bf16x8 a, bf16x8 b) { const i32x4 x = __builtin_bit_cast(i32x4, a), y = __builtin_bit_cast(i32x4, b); return __builtin_shufflevector(x, y, 0, 1, 2, 3, 4, 5, 6, 7); }
template <class Epi, class Sched, bool F8 = false, bool GATHER = false>
__device__ __forceinline__ void gemm_phase(LAS unsigned char* lds, const Gemm g, const Sched& S, const Epi& E, const int* rowidx = nullptr) {
    const int tid = threadIdx.x, wid = __builtin_amdgcn_readfirstlane(tid >> 6), lane = tid & 63, wr = wid >> 2, wc = wid & 3, fr = lane & 15, fq = lane >> 4;
    const int Kb = g.Kb, nt = Kb / (BK * 2);
    int Ri[2], Ci2[2]; unsigned voffB[2];
#pragma unroll
    for (int i = 0; i < 2; ++i) { int R, C; stage_rc(tid * 16 + i * 8192, R, C); const int Rb = Epi::PERM ? ((R & ~31) + perm32(R & 31)) : R;
        Ri[i] = R; Ci2[i] = C * 2; voffB[i] = (unsigned)(Rb * Kb + C * 2); }
    const size_t kstep = (size_t)(BK * 2);
    const size_t hstep = (size_t)HALF * Kb;
    const size_t tstep = 2 * hstep;
    const size_t estep = (size_t)g.N * Kb;
    const unsigned ldsw = (unsigned)wid * 1024u;
    const int aoff = lds_byte(wr * 64 + fr, fq * 8), boff = lds_byte(wc * 32 + fr, fq * 8);
#define PG8_SA(b, h) (((b) * 2 + (h)) * HTB)
#define PG8_SB(b, h) ((4 + (b) * 2 + (h)) * HTB)
#define PG8_STAGE(bufoff, gbase, voff) do { _Pragma("unroll") for (int _i = 0; _i < 2; ++_i) \
        __builtin_amdgcn_global_load_lds((const unsigned*)((const char*)(gbase) + (voff)[_i]), (LAS unsigned*)(lds + (bufoff) + ldsw + _i * 8192), 16, 0, 0); } while (0)
#define PG8_LDA(dst, b, h) do { _Pragma("unroll") for (int m = 0; m < 4; ++m) _Pragma("unroll") for (int k = 0; k < 2; ++k) dst[m][k] = *(const LAS bf16x8*)(lds + PG8_SA(b, h) + aoff + m * 2048 + k * 1024); } while (0)
#define PG8_LDB(dst, b, h) do { _Pragma("unroll") for (int n = 0; n < 2; ++n) _Pragma("unroll") for (int k = 0; k < 2; ++k) dst[n][k] = *(const LAS bf16x8*)(lds + PG8_SB(b, h) + boff + n * 2048 + k * 1024); } while (0)
#define PG8_MMA(ai, bj, At, Bt) do { __builtin_amdgcn_s_setprio(1); _Pragma("unroll") for (int m = 0; m < 4; ++m) _Pragma("unroll") for (int n = 0; n < 2; ++n) { \
        if constexpr (F8) { const i32x8 b8_ = cat8(Bt[n][0], Bt[n][1]), a8_ = cat8(At[m][0], At[m][1]); \
            asm volatile("v_mfma_f32_16x16x128_f8f6f4 %0, %1, %2, %0" : "+v"(acc[ai][bj][m][n]) : "v"(b8_), "v"(a8_)); }   \
        else { _Pragma("unroll") for (int k = 0; k < 2; ++k) acc[ai][bj][m][n] = __builtin_amdgcn_mfma_f32_16x16x32_bf16(Bt[n][k], At[m][k], acc[ai][bj][m][n], 0, 0, 0); } } \
        __builtin_amdgcn_s_setprio(0); } while (0)
#define PG8_WAIT_V_(n) asm volatile("s_waitcnt vmcnt(" #n ")" ::: "memory")
#define PG8_WAIT_V(n) PG8_WAIT_V_(n)
#define PG8_WAIT_L(n) asm volatile("s_waitcnt lgkmcnt(" #n ")" ::: "memory")
#define PG8_BAR __builtin_amdgcn_s_barrier()
#define PG8_SCHED __builtin_amdgcn_sched_barrier(0)
#define PG8_AOFF(dst, u) do { _Pragma("unroll") for (int h_ = 0; h_ < 2; ++h_) _Pragma("unroll") for (int i_ = 0; i_ < 2; ++i_) { const int r_ = (u).pm * BM + h_ * HALF + Ri[i_]; \
        dst[h_][i_] = (unsigned)(GATHER ? rowidx[r_] : r_) * (unsigned)Kb + (unsigned)Ci2[i_]; } } while (0)
    Unit cur, nxt, nn; int ui = 0; bool has_nn = false;
    typename Epi::Pre pre{}; unsigned offNN[2][2] = {{0u, 0u}, {0u, 0u}}; float stash_v = 0.f;
    if (!S.next(0, cur)) return;
    bool has_next = S.next(1, nxt);
    unsigned offC[2][2], offN[2][2];
    PG8_AOFF(offC, cur);
    if (has_next) PG8_AOFF(offN, nxt); else PG8_AOFF(offN, cur);
    f32x4 acc[2][2][4][2];
#pragma unroll
    for (int a = 0; a < 2; ++a)
#pragma unroll
        for (int b = 0; b < 2; ++b)
#pragma unroll
            for (int m = 0; m < 4; ++m)
#pragma unroll
                for (int n = 0; n < 2; ++n) acc[a][b][m][n] = (f32x4){0.f, 0.f, 0.f, 0.f};
    bf16x8 At[4][2], B0[2][2], B1[2][2];
    const char* const gA = (const char*)g.A;
    const char* cB = (const char*)g.Bt + (size_t)cur.e * estep + (size_t)cur.pn * tstep;
    PG8_STAGE(PG8_SB(0, 0), cB, voffB); PG8_STAGE(PG8_SB(0, 1), cB + hstep, voffB); PG8_STAGE(PG8_SA(0, 0), gA, offC[0]); PG8_STAGE(PG8_SA(0, 1), gA, offC[1]);
    if (wr == 1) PG8_BAR;
    PG8_WAIT_V(2); PG8_BAR;
    PG8_STAGE(PG8_SB(1, 0), cB + kstep, voffB); PG8_STAGE(PG8_SA(1, 0), gA + kstep, offC[0]); PG8_STAGE(PG8_SB(1, 1), cB + hstep + kstep, voffB);
    PG8_WAIT_V(6); PG8_BAR;
    for (;;) {
        const char* nB = has_next ? (const char*)g.Bt + (size_t)nxt.e * estep + (size_t)nxt.pn * tstep : cB;
#pragma nounroll
        for (int t = 0; t < nt; t += 2) {
            const bool last = (t == nt - 2);
            const char* a1 = gA + (size_t)(t + 1) * kstep;
            const char* a2 = last ? gA : gA + (size_t)(t + 2) * kstep; const char* b2 = last ? nB : cB + (size_t)(t + 2) * kstep;
            const char* a3 = a2 + kstep; const char* b3 = b2 + kstep;
            unsigned o2[2][2];
#pragma unroll
            for (int h = 0; h < 2; ++h)
#pragma unroll
                for (int i = 0; i < 2; ++i) o2[h][i] = last ? offN[h][i] : offC[h][i];
            constexpr int HOIST = Epi::HOISTOK ? 1 + (GATHER ? 4 : 0) : 0;
#define PG8_WAIT_H() do { if (HOIST > 0 && last) { if constexpr (HOIST == 5) PG8_WAIT_V(13); else if constexpr (HOIST == 1) PG8_WAIT_V(9); else PG8_WAIT_V(8); } else PG8_WAIT_V(8); } while (0)
            static_assert(HOIST == 0 || HOIST == 1 || HOIST == 5, "add the matching wait count");
            PG8_LDB(B0, 0, 0); if constexpr (!Epi::SKIP_B1) PG8_LDB(B1, 0, 1); PG8_SCHED; PG8_LDA(At, 0, 0); PG8_STAGE(PG8_SA(1, 1), a1, offC[1]);
            if (HOIST > 0 && last) { PG8_SCHED;
                { const float* sp_ = E.stash_ptr(cur, tid); asm volatile("global_load_dword %0, %1, off" : "=v"(stash_v) : "v"(sp_) : "memory"); }
                has_nn = has_next && S.next(ui + 2, nn);
                if constexpr (GATHER) { const int pmn = has_nn ? nn.pm : cur.pm;
#pragma unroll
                    for (int h_ = 0; h_ < 2; ++h_)
#pragma unroll
                        for (int i_ = 0; i_ < 2; ++i_) { const int* ip_ = rowidx + (pmn * BM + h_ * HALF + Ri[i_]); asm volatile("global_load_dword %0, %1, off" : "=v"(offNN[h_][i_]) : "v"(ip_) : "memory"); } }
                else { if (has_nn) PG8_AOFF(offNN, nn); else PG8_AOFF(offNN, cur); }
                PG8_SCHED; }
            PG8_WAIT_H(); PG8_WAIT_L(0); PG8_BAR; PG8_MMA(0, 0, At, B0); if constexpr (!Epi::SKIP_B1) PG8_MMA(0, 1, At, B1); PG8_BAR; PG8_SCHED;
            PG8_LDA(At, 0, 1); PG8_STAGE(PG8_SB(0, 0), b2, voffB); PG8_STAGE(PG8_SB(0, 1), b2 + hstep, voffB); PG8_STAGE(PG8_SA(0, 0), a2, o2[0]);
            PG8_WAIT_H(); PG8_WAIT_L(0); PG8_BAR; PG8_MMA(1, 0, At, B0); if constexpr (!Epi::SKIP_B1) PG8_MMA(1, 1, At, B1); PG8_BAR; PG8_SCHED;
            PG8_LDB(B0, 1, 0); if constexpr (!Epi::SKIP_B1) PG8_LDB(B1, 1, 1); PG8_SCHED; PG8_LDA(At, 1, 0); PG8_STAGE(PG8_SA(0, 1), a2, o2[1]);
            PG8_WAIT_V(8);
            if (HOIST > 0 && last) { ((LAS float*)(lds + STASH_OFF))[tid] = stash_v;
                if constexpr (GATHER) {
#pragma unroll
                    for (int h_ = 0; h_ < 2; ++h_)
#pragma unroll
                        for (int i_ = 0; i_ < 2; ++i_) offNN[h_][i_] = offNN[h_][i_] * (unsigned)Kb + (unsigned)Ci2[i_]; } }
            PG8_WAIT_L(0); PG8_BAR; PG8_MMA(0, 0, At, B0); if constexpr (!Epi::SKIP_B1) PG8_MMA(0, 1, At, B1); PG8_BAR; PG8_SCHED;
            PG8_LDA(At, 1, 1); PG8_STAGE(PG8_SB(1, 0), b3, voffB); PG8_STAGE(PG8_SB(1, 1), b3 + hstep, voffB); PG8_STAGE(PG8_SA(1, 0), a3, o2[0]);
            PG8_WAIT_V(8); PG8_WAIT_L(0); PG8_BAR; PG8_MMA(1, 0, At, B0); if constexpr (!Epi::SKIP_B1) PG8_MMA(1, 1, At, B1); PG8_BAR; PG8_SCHED;
#undef PG8_WAIT_H
        }
        if constexpr (Epi::ALIGN) { if (wr == 0) PG8_BAR; }
        if constexpr (F8) asm volatile("s_nop 7\n\ts_nop 7\n\ts_nop 7" ::: "memory");
        if constexpr (!Epi::HOISTOK) {
            has_nn = has_next && S.next(ui + 2, nn);
            pre = E.preload(cur, wr, wc, fr, fq);
            if (has_nn) PG8_AOFF(offNN, nn); else PG8_AOFF(offNN, cur);
            if constexpr (GATHER) asm volatile("" : "+v"(offNN[0][0]), "+v"(offNN[0][1]), "+v"(offNN[1][0]), "+v"(offNN[1][1])); }
        if constexpr (Epi::HOISTOK) pre = E.from_stash((const LAS float*)(lds + STASH_OFF), wr, wc, fr, fq);
        E(acc, cur, wr, wc, fr, fq, pre);
        if (!has_next) break;
#pragma unroll
        for (int a = 0; a < 2; ++a)
#pragma unroll
            for (int b = 0; b < 2; ++b)
#pragma unroll
                for (int m = 0; m < 4; ++m)
#pragma unroll
                    for (int n = 0; n < 2; ++n) acc[a][b][m][n] = (f32x4){0.f, 0.f, 0.f, 0.f};
#pragma unroll
        for (int h = 0; h < 2; ++h)
#pragma unroll
            for (int i = 0; i < 2; ++i) { offC[h][i] = offN[h][i]; if (has_nn) offN[h][i] = offNN[h][i]; }
        cur = nxt; cB = nB; nxt = nn; has_next = has_nn; ++ui;
        if constexpr (Epi::ALIGN) { if (wr == 1) PG8_BAR; }
    }
    PG8_WAIT_V(0);
    if constexpr (!Epi::ALIGN) { if (wr == 0) PG8_BAR; }
    PG8_BAR;
    if constexpr (Epi::AFTER) E.after(acc, cur, wr, wc, fr, fq, lds);
#undef PG8_SA
#undef PG8_SB
#undef PG8_STAGE
#undef PG8_LDA
#undef PG8_LDB
#undef PG8_MMA
#undef PG8_WAIT_V
#undef PG8_WAIT_V_
#undef PG8_WAIT_L
#undef PG8_BAR
#undef PG8_SCHED
#undef PG8_AOFF
}
}

constexpr int NWAVES = 8, NTHR = 512;
constexpr int T = 65536, D = 1024, NB = 32, S = 2048, MEMT = 256;
constexpr int NE = 32, TOPK = 4;
constexpr int NSLOT_MAX = T * TOPK + NE * 256;
constexpr int NTILE_MAX = NSLOT_MAX / 256;
constexpr int NCHUNK = T / 256;
constexpr float LN_EPS = 1e-5f;
constexpr float DN_ALPHA = 1.4142135623730951f;
constexpr int NPH = 22;

constexpr size_t MiB = 1u << 20;
constexpr size_t WS_CTL = 0, CTL_ZERO_BYTES = 1 * MiB;
constexpr size_t WS_WGHIST = 1 * MiB;
constexpr size_t WS_TILETAB = 1 * MiB + 256 * 1024;
constexpr size_t WS_B1P = 1 * MiB + 512 * 1024;
constexpr size_t WS_GWT = 2 * MiB;
constexpr size_t WS_TOKE = 3 * MiB, WS_TOKG = 4 * MiB, WS_TOKR = 5 * MiB, WS_TOKS = 6 * MiB;
constexpr size_t WS_SLOTG = 7 * MiB, WS_SLOTT = 9 * MiB;
constexpr size_t WS_GLOG = 11 * MiB;
constexpr size_t WS_LOGITS = 16 * MiB;
constexpr size_t WS_WINA = 32 * MiB, WS_WOUTA = 34 * MiB, WS_WINB = 36 * MiB, WS_WOUTB = 38 * MiB, WS_WMKV = 40 * MiB, WS_WKV = 42 * MiB, WS_WPOOL = 45 * MiB, WS_WR = 47 * MiB;
constexpr size_t WS_MEMB = 48 * MiB, WS_KVMEM = 64 * MiB;
constexpr size_t WS_W1 = 80 * MiB, WS_W2 = 336 * MiB;
constexpr size_t WS_R1 = 464 * MiB, WS_R2 = 592 * MiB;
constexpr size_t WS_ACT = 720 * MiB, WS_Y = 1248 * MiB, WS_H1Q = 1776 * MiB, WS_END = 1840 * MiB;
constexpr size_t WS_PROJ = 720 * MiB, WS_CAT = 848 * MiB, WS_MIX = 976 * MiB, WS_DBUF = 1104 * MiB, WS_KF = 1200 * MiB  , WS_Q8 = 1248 * MiB  , WS_VF = 1296 * MiB;
static_assert(WS_ACT + (size_t)NSLOT_MAX * 2048 <= WS_Y && WS_Y + (size_t)NSLOT_MAX * 2048 <= WS_END, "ws map");
constexpr int CW_BAR = 4096;

constexpr int RING_BYTES = 131072;
constexpr int TAB_OFF = RING_BYTES;
constexpr int MISC_OFF = TAB_OFF + 4608;
constexpr int LDS_BYTES = 147456;
static_assert(MISC_OFF + 128 == pg8::STASH_OFF && pg8::STASH_OFF + 2048 <= LDS_BYTES, "LDS map");

#define RLX_AGENT __ATOMIC_RELAXED, __HIP_MEMORY_SCOPE_AGENT
#define LDS_WAIT() asm volatile("s_waitcnt lgkmcnt(0)" ::: "memory")
#define VM_WAIT() asm volatile("s_waitcnt vmcnt(0)" ::: "memory")

#define XB_TMO      128
#define XB_XCNT(j)  (256  + 64 * (j))
#define XB_XSUB(j)  (1280 + 64 * (j))
#define XB_XGEN(j)  (2304 + 64 * (j))
#define XB_TOP      3328
#define XB_TOPGEN   3392
#define XCD_BAR_WORDS 3456
#define XB_SPIN_CAP (1u << 18)
__device__ __forceinline__ unsigned xb_ld(unsigned* p)              { return __hip_atomic_load(p, __ATOMIC_RELAXED, __HIP_MEMORY_SCOPE_AGENT); }
__device__ __forceinline__ unsigned xb_add(unsigned* p, unsigned v) { return __hip_atomic_fetch_add(p, v, __ATOMIC_RELAXED, __HIP_MEMORY_SCOPE_AGENT); }
__device__ __forceinline__ unsigned xb_xcc_id() { return (unsigned)__builtin_amdgcn_s_getreg((3 << 11) | 20) & 0xFu; }
#define XB_SPIN(cond, bar) do { unsigned _sp = 0; while (cond) { __builtin_amdgcn_s_sleep(1); \
    if ((++_sp & 255u) == 0u) { if (xb_ld(&(bar)[XB_TMO])) break; if (_sp > XB_SPIN_CAP) { atomicAdd(&(bar)[XB_TMO], 1u); break; } } } } while (0)
struct XcdBarrier { unsigned* bar; unsigned x; volatile LAS unsigned* st; };
__device__ __forceinline__ XcdBarrier xcd_barrier_post(unsigned* bar, volatile LAS unsigned* st) {
    XcdBarrier b; b.bar = bar; b.x = xb_xcc_id(); b.st = st;
    if (threadIdx.x == 0) (void)xb_add(&bar[XB_XCNT(b.x)], 1u);
    return b;
}
__device__ __forceinline__ void xcd_barrier_complete(unsigned* bar, unsigned x, unsigned& nloc, unsigned& nx) {
    const unsigned G = gridDim.x * gridDim.y * gridDim.z;
    unsigned sum, cnt, mine, sp = 0u;
    for (;;) {
        sum = 0u; cnt = 0u; mine = 0u;
#pragma unroll
        for (unsigned j = 0; j < 16; ++j) { const unsigned c = xb_ld(&bar[XB_XCNT(j)]); sum += c; cnt += (c > 0u) ? 1u : 0u; mine = (j == x) ? c : mine; }
        if (sum == G) break;
        __builtin_amdgcn_s_sleep(1);
        if ((++sp & 255u) == 0u) { if (xb_ld(&bar[XB_TMO])) break; if (sp > XB_SPIN_CAP) { atomicAdd(&bar[XB_TMO], 1u); break; } }
    }
    nloc = mine > 0u ? mine : 1u; nx = cnt > 0u ? cnt : 1u;
}
__device__ __forceinline__ void xcd_barrier(const XcdBarrier& b) {
    asm volatile("s_waitcnt vmcnt(0)" ::: "memory");
    __syncthreads();
    if (threadIdx.x == 0) {
        unsigned* bar = b.bar;
        __builtin_amdgcn_s_waitcnt(0);
        unsigned nloc = b.st[0], nx = b.st[1];
        if (nloc == 0u) { xcd_barrier_complete(bar, b.x, nloc, nx); b.st[0] = nloc; b.st[1] = nx; }
        const unsigned old = xb_add(&bar[XB_XSUB(b.x)], 1u);
        const unsigned gen = old / nloc;
        if (old + 1u == (gen + 1u) * nloc) {
            __builtin_amdgcn_fence(__ATOMIC_RELEASE, "agent");
            asm volatile("s_waitcnt vmcnt(0)" ::: "memory");
            const unsigned og = xb_add(&bar[XB_TOP], 1u);
            const unsigned tg = og / nx;
            if (og + 1u == (tg + 1u) * nx) xb_add(&bar[XB_TOPGEN], 1u);
            else XB_SPIN(xb_ld(&bar[XB_TOPGEN]) == tg, bar);
            __builtin_amdgcn_fence(__ATOMIC_ACQUIRE, "agent");
            xb_add(&bar[XB_XGEN(b.x)], 1u);
            asm volatile("s_waitcnt vmcnt(0)" ::: "memory");
        } else {
            XB_SPIN(xb_ld(&bar[XB_XGEN(b.x)]) == gen, bar);
            __builtin_amdgcn_fence(__ATOMIC_ACQUIRE, "agent");
            asm volatile("s_waitcnt vmcnt(0)" ::: "memory");
        }
    }
    __syncthreads();
}

__device__ __forceinline__ float wave_sum(float v) {
#define WS_DPP(x, ctrl) __int_as_float(__builtin_amdgcn_update_dpp(0, __float_as_int(x), (ctrl), 0xf, 0xf, false))
    v += WS_DPP(v, 0x128); v += WS_DPP(v, 0x124); v += WS_DPP(v, 0x122); v += WS_DPP(v, 0x121);
#undef WS_DPP
    { const auto rr = __builtin_amdgcn_permlane16_swap(__float_as_uint(v), __float_as_uint(v), false, false); v = __uint_as_float(rr[0]) + __uint_as_float(rr[1]); }
    { const auto rr = __builtin_amdgcn_permlane32_swap(__float_as_uint(v), __float_as_uint(v), false, false); v = __uint_as_float(rr[0]) + __uint_as_float(rr[1]); }
    return v;
}

template <int MODE>
__device__ __forceinline__ void tr_item(const float* W, int ldn, bf16_t* WT, int dld, int row_off, int col_off, LAS float* scr, int k0, int n0, int lane) {
    {
        f32x4 t[8];
#pragma unroll
        for (int i = 0; i < 8; ++i) t[i] = *(const f32x4*)(W + (size_t)(k0 + 8 * i + (lane >> 3)) * ldn + n0 + 4 * (lane & 7));
#pragma unroll
        for (int i = 0; i < 8; ++i) { LAS float* d = scr + (8 * i + (lane >> 3)) * 33 + 4 * (lane & 7); d[0] = t[i][0]; d[1] = t[i][1]; d[2] = t[i][2]; d[3] = t[i][3]; }
    }
    LDS_WAIT(); asm volatile("" ::: "memory");
    const int c = lane & 7;
#pragma unroll
    for (int j = 0; j < 4; ++j) { const int n = (lane >> 3) + 8 * j; const LAS float* s = scr + (8 * c) * 33 + n;
        float f[8];
#pragma unroll
        for (int q = 0; q < 8; ++q) f[q] = s[q * 33];
        u32x4 o; o.x = cvt_pk_bf16(f[0], f[1]); o.y = cvt_pk_bf16(f[2], f[3]); o.z = cvt_pk_bf16(f[4], f[5]); o.w = cvt_pk_bf16(f[6], f[7]);
        const int nn = n0 + n;
        const int drow = (MODE == 1) ? ((nn & ~255) + 128 * (nn & 1) + ((nn & 255) >> 1)) : (row_off + nn);
        *(u32x4*)(WT + (size_t)drow * dld + col_off + k0 + 8 * c) = o;
        if (MODE == 2) {
            u32x4 l; l.x = cvt_pk_bf16(f[0] - bf_lo(o.x), f[1] - bf_hi(o.x)); l.y = cvt_pk_bf16(f[2] - bf_lo(o.y), f[3] - bf_hi(o.y));
            l.z = cvt_pk_bf16(f[4] - bf_lo(o.z), f[5] - bf_hi(o.z)); l.w = cvt_pk_bf16(f[6] - bf_lo(o.w), f[7] - bf_hi(o.w));
            *(u32x4*)(WT + (size_t)(drow + 32) * dld + col_off + k0 + 8 * c) = l;
        }
    }
    LDS_WAIT(); asm volatile("" ::: "memory");
}

template <bool PERMW>
__device__ __forceinline__ void tr_item8(const float* W, int ldn, unsigned char* WT, int dld, LAS float* scr, int k0, int n0, int lane) {
    {
        f32x4 t[8];
#pragma unroll
        for (int i = 0; i < 8; ++i) t[i] = *(const f32x4*)(W + (size_t)(k0 + 8 * i + (lane >> 3)) * ldn + n0 + 4 * (lane & 7));
#pragma unroll
        for (int i = 0; i < 8; ++i) { LAS float* d = scr + (8 * i + (lane >> 3)) * 33 + 4 * (lane & 7); d[0] = t[i][0]; d[1] = t[i][1]; d[2] = t[i][2]; d[3] = t[i][3]; }
    }
    LDS_WAIT(); asm volatile("" ::: "memory");
    const int c = lane & 3;
#pragma unroll
    for (int j = 0; j < 2; ++j) { const int n = (lane >> 2) + 16 * j; const LAS float* s = scr + (16 * c) * 33 + n;
        float f[16];
#pragma unroll
        for (int q = 0; q < 16; ++q) f[q] = s[q * 33] * pg8::W8_SCALE;
        u32x4 o; o.x = pg8::pk_fp8x4(f[0], f[1], f[2], f[3]); o.y = pg8::pk_fp8x4(f[4], f[5], f[6], f[7]); o.z = pg8::pk_fp8x4(f[8], f[9], f[10], f[11]); o.w = pg8::pk_fp8x4(f[12], f[13], f[14], f[15]);
        const int nn = n0 + n;
        const int drow = PERMW ? ((nn & ~255) + 128 * (nn & 1) + ((nn & 255) >> 1)) : nn;
        *(u32x4*)(WT + (size_t)drow * dld + k0 + 16 * c) = o;
    }
    LDS_WAIT(); asm volatile("" ::: "memory");
}

struct Args {
    const float* in[22]; float* out; unsigned char* ws; int ph_lo, ph_hi;
};

__device__ __forceinline__ void f32_to_bf16_rows(const float* __restrict__ src, bf16_t* __restrict__ dst, size_t n4, size_t gt, size_t ngt) {
    size_t i = gt;
    for (; i + 7 * ngt < n4; i += 8 * ngt) { f32x4 a[8];
#pragma unroll
        for (int u = 0; u < 8; ++u) a[u] = *(const f32x4*)(src + (i + u * ngt) * 4);
#pragma unroll
        for (int u = 0; u < 8; ++u) { u32x2 o; o.x = cvt_pk_bf16(a[u][0], a[u][1]); o.y = cvt_pk_bf16(a[u][2], a[u][3]); *(u32x2*)(dst + (i + u * ngt) * 4) = o; } }
    for (; i < n4; i += ngt) { const f32x4 a = *(const f32x4*)(src + i * 4); u32x2 o; o.x = cvt_pk_bf16(a[0], a[1]); o.y = cvt_pk_bf16(a[2], a[3]); *(u32x2*)(dst + i * 4) = o; }
}

__device__ __forceinline__ void p0_prologue(const Args& a, LAS unsigned char* lds, int wave, int lane) {
    unsigned char* ws = a.ws;
    LAS float* scr = (LAS float*)(lds + wave * 16384);
    const int G = gridDim.x, gw = blockIdx.x * NWAVES + wave, NGW = G * NWAVES;
    const size_t gt = (size_t)blockIdx.x * NTHR + threadIdx.x, ngt = (size_t)G * NTHR;
    constexpr int I_SQ = 16 * 32, I_MKV = 16 * 16, I_KV = 16 * 48, I_R = 16, I_POOL = 3 * 6, I_W1 = 16 * 64, I_W2 = 16 * 32;
    constexpr int NIT = 4 * I_SQ + 2 * I_MKV + I_KV + 2 * I_R + 4 * I_POOL + 64 * I_W1 + 64 * I_W2;
    for (int it = gw; it < NIT; it += NGW) {
        int r = it;
        if (r < 4 * I_SQ) { const int w = r / I_SQ; r -= w * I_SQ; const float* src = a.in[w == 0 ? 6 : (w == 1 ? 10 : (w == 2 ? 13 : 15))];
            bf16_t* dst = (bf16_t*)(ws + (w == 0 ? WS_WINA : (w == 1 ? WS_WOUTA : (w == 2 ? WS_WINB : WS_WOUTB))));
            if (w == 1 && r < 12 * 32) continue;
            if (w == 2) { tr_item8<false>(src, 1024, (unsigned char*)dst, 1024, scr, 64 * (r / 32), 32 * (r % 32), lane); continue; }
            tr_item<0>(src, 1024, dst, 1024, 0, 0, scr, 64 * (r / 32), 32 * (r % 32), lane); continue; }
        r -= 4 * I_SQ;
        if (r < 2 * I_MKV) { const int w = r / I_MKV; r -= w * I_MKV;
            tr_item8<false>(a.in[w == 0 ? 9 : 14], 512, ws + WS_WMKV + (size_t)512 * w * 1024, 1024, scr, 64 * (r / 16), 32 * (r % 16), lane); continue; }
        r -= 2 * I_MKV;
        if (r < I_KV) { tr_item8<false>(a.in[11], 1548, ws + WS_WKV, 1024, scr, 64 * (r / 48), 32 * (r % 48), lane); continue; }
        r -= I_KV;
        if (r < 2 * I_R) { const int l = r / I_R; r -= l * I_R;
            tr_item<2>(a.in[16] + (size_t)l * 1024 * 32, 32, (bf16_t*)(ws + WS_WR) + (size_t)l * 256 * 1024, 1024, 0, 0, scr, 64 * r, 0, lane); continue; }
        r -= 2 * I_R;
        if (r < 4 * I_POOL) continue;
        r -= 4 * I_POOL;
        if (r < 64 * I_W1) { const int le = r / I_W1; r -= le * I_W1;
            tr_item8<true>(a.in[18] + (size_t)le * 1024 * 2048, 2048, ws + WS_W1 + (size_t)le * 2048 * 1024, 1024, scr, 64 * (r / 64), 32 * (r % 64), lane); continue; }
        r -= 64 * I_W1;
        { const int le = r / I_W2; r -= le * I_W2;
            tr_item8<false>(a.in[20] + (size_t)le * 1024 * 1024, 1024, ws + WS_W2 + (size_t)le * 1024 * 1024, 1024, scr, 64 * (r / 32), 32 * (r % 32), lane); }
    }
    f32_to_bf16_rows(a.in[0], (bf16_t*)(ws + WS_R1), (size_t)T * D / 4, gt, ngt);
    for (size_t i = gt; i < (size_t)NB * MEMT * D / 4; i += ngt) { const f32x4 v = *(const f32x4*)(a.in[1] + i * 4); *(unsigned*)(ws + WS_MEMB + i * 4) = pg8::pk_fp8x4(v[0], v[1], v[2], v[3]); }
    {
      bf16_t* wo = (bf16_t*)(ws + WS_WOUTA); const float* pw = a.in[7]; const float* psc = a.in[8]; const float* wout = a.in[10];
      for (size_t i = gt; i < (size_t)4 * 96 * 256; i += ngt) { const int n4 = (int)(i & 255), kk = (int)(i >> 8), g = kk / 96, c2 = kk % 96;
          const float* p0 = pw + ((size_t)g * 192 + 2 * c2) * 192; const float* p1 = p0 + 192; const float* sr = psc + g * 192; const float* wc = wout + (size_t)g * 192 * 1024 + 4 * n4;
          f32x4 a0 = {0.f, 0.f, 0.f, 0.f}, a1 = {0.f, 0.f, 0.f, 0.f};
#pragma unroll 4
          for (int j = 0; j < 192; j += 4) { const f32x4 q0 = *(const f32x4*)(p0 + j), q1 = *(const f32x4*)(p1 + j), sv = *(const f32x4*)(sr + j);
#pragma unroll
              for (int r = 0; r < 4; ++r) { const f32x4 w = *(const f32x4*)(wc + (size_t)(j + r) * 1024); a0 += w * (q0[r] * sv[r]); a1 += w * (q1[r] * sv[r]); } }
          const int k = g * 192 + 2 * c2;
#pragma unroll
          for (int r = 0; r < 4; ++r) *(unsigned*)(wo + (size_t)(4 * n4 + r) * 1024 + k) = cvt_pk_bf16(a0[r], a1[r]); }
      bf16_t* wr = (bf16_t*)(ws + WS_WR);
      for (size_t i = gt; i < (size_t)2 * 64 * 128; i += ngt) { const int l = (int)(i / (64 * 128)), rr = (int)((i / 128) % 64), ch = (int)(i % 128);
          const int row = 64 + rr;
          *(u32x4*)(wr + ((size_t)l * 256 + row) * 1024 + ch * 8) = (u32x4){0u, 0u, 0u, 0u}; } }
    { float* b1p = (float*)(ws + WS_B1P); const float* b1 = a.in[19];
      for (size_t i = gt; i < (size_t)2 * 32 * 2048; i += ngt) { const int np = (int)(i & 2047); const size_t le = i >> 11;
          const int orig = 2 * (128 * (np >> 8) + (np & 127)) + ((np >> 7) & 1); b1p[i] = b1[le * 2048 + orig]; }
      float* gwt = (float*)(ws + WS_GWT); const float* kvw = a.in[11];
      for (size_t i = gt; i < (size_t)12 * 1024; i += ngt) { const int j = (int)(i / 1024), k = (int)(i % 1024); gwt[i] = kvw[(size_t)k * 1548 + 1536 + j]; } }
}

__device__ __forceinline__ void pool_d_phase(const bf16_t* proj, bf16_t* dbuf) {
    const size_t gt = (size_t)blockIdx.x * NTHR + threadIdx.x, ngt = (size_t)gridDim.x * NTHR;
    for (size_t id = gt; id < (size_t)1024 * 96; id += ngt) {
        const int cc = (int)(id % 96), seg = (int)(id / 96), b = seg >> 5, s0 = (seg & 31) * 64, g = cc / 24, w = 2 << g;
        const bf16_t* up = proj + (size_t)b * S * 1024 + cc * 8; bf16_t* dp = dbuf + (size_t)b * S * 1024 + cc * 8;
        float sum[8];
#pragma unroll
        for (int q = 0; q < 8; ++q) sum[q] = 0.f;
        for (int r = s0 - w; r < s0; ++r) if (r >= 0) { const u32x4 v = *(const u32x4*)(up + (size_t)r * 1024);
            sum[0] += bf_lo(v.x); sum[1] += bf_hi(v.x); sum[2] += bf_lo(v.y); sum[3] += bf_hi(v.y); sum[4] += bf_lo(v.z); sum[5] += bf_hi(v.z); sum[6] += bf_lo(v.w); sum[7] += bf_hi(v.w); }
        for (int t = s0; t < s0 + 64; ++t) {
            const u32x4 v = *(const u32x4*)(up + (size_t)t * 1024);
            float ut[8] = {bf_lo(v.x), bf_hi(v.x), bf_lo(v.y), bf_hi(v.y), bf_lo(v.z), bf_hi(v.z), bf_lo(v.w), bf_hi(v.w)};
#pragma unroll
            for (int q = 0; q < 8; ++q) sum[q] += ut[q];
            if (t - w >= 0) { const u32x4 o = *(const u32x4*)(up + (size_t)(t - w) * 1024);
                sum[0] -= bf_lo(o.x); sum[1] -= bf_hi(o.x); sum[2] -= bf_lo(o.y); sum[3] -= bf_hi(o.y); sum[4] -= bf_lo(o.z); sum[5] -= bf_hi(o.z); sum[6] -= bf_lo(o.w); sum[7] -= bf_hi(o.w); }
            const float inv = 1.0f / (float)((t + 1) < w ? (t + 1) : w);
            float d[8];
#pragma unroll
            for (int q = 0; q < 8; ++q) d[q] = sum[q] * inv - ut[q];
            u32x4 o; o.x = cvt_pk_bf16(d[0], d[1]); o.y = cvt_pk_bf16(d[2], d[3]); o.z = cvt_pk_bf16(d[4], d[5]); o.w = cvt_pk_bf16(d[6], d[7]);
            *(u32x4*)(dp + (size_t)t * 1024) = o;
        }
    }
}

typedef float f32x16 __attribute__((ext_vector_type(16)));
typedef short v4i16_t __attribute__((ext_vector_type(4)));
constexpr int ATT_SLOT = 16384, ATT_NSLOT = 4, ATT_C_OFF = ATT_NSLOT * ATT_SLOT  , ATT_W_OFF = ATT_C_OFF + 8192  , ATT_LDS = ATT_W_OFF + 64;
static_assert(ATT_LDS <= RING_BYTES, "attention LDS map");
constexpr float ATT_L2E = 1.4426950408889634f, ATT_C2 = 0.125f * 1.4426950408889634f, ATT_THR = 8.0f;

template <bool FOX>
__device__ __forceinline__ void att_tile(const LAS unsigned char* sb, f32x16& s0, f32x16& s1, const bf16x8 (&qf)[4], f32x16& O0, f32x16& O1, float& m, float& l,
                                         int kt, int qrow, bool diag, int h2, int kfo, int vfo) {
    __builtin_amdgcn_sched_barrier(0);
#pragma unroll
    for (int ks = 0; ks < 4; ++ks) {
        const bf16x8 k0 = *(const LAS bf16x8*)(sb + kfo + ks * 2048), k1 = *(const LAS bf16x8*)(sb + kfo + ks * 2048 + 512);
        s0 = __builtin_amdgcn_mfma_f32_32x32x16_bf16(k0, qf[ks], s0, 0, 0, 0); s1 = __builtin_amdgcn_mfma_f32_32x32x16_bf16(k1, qf[ks], s1, 0, 0, 0); }
    __builtin_amdgcn_sched_barrier(0);
    const unsigned va_ = (unsigned)(unsigned long)(sb + vfo);
    v4i16_t tv[2][4][2];
#define ATT_TR(dst, off) asm volatile("ds_read_b64_tr_b16 %0, %1 offset:%2" : "=v"(dst) : "v"(va_), "i"(off) : "memory")
    ATT_TR(tv[0][0][0], 0 * 4096 + 0 * 1024);    ATT_TR(tv[0][0][1], 0 * 4096 + 0 * 1024 + 512);
    ATT_TR(tv[0][1][0], 0 * 4096 + 1 * 1024);    ATT_TR(tv[0][1][1], 0 * 4096 + 1 * 1024 + 512);
    ATT_TR(tv[0][2][0], 0 * 4096 + 2 * 1024);    ATT_TR(tv[0][2][1], 0 * 4096 + 2 * 1024 + 512);
    ATT_TR(tv[0][3][0], 0 * 4096 + 3 * 1024);    ATT_TR(tv[0][3][1], 0 * 4096 + 3 * 1024 + 512);
    ATT_TR(tv[1][0][0], 1 * 4096 + 0 * 1024);    ATT_TR(tv[1][0][1], 1 * 4096 + 0 * 1024 + 512);
    ATT_TR(tv[1][1][0], 1 * 4096 + 1 * 1024);    ATT_TR(tv[1][1][1], 1 * 4096 + 1 * 1024 + 512);
    ATT_TR(tv[1][2][0], 1 * 4096 + 2 * 1024);    ATT_TR(tv[1][2][1], 1 * 4096 + 2 * 1024 + 512);
    ATT_TR(tv[1][3][0], 1 * 4096 + 3 * 1024);    ATT_TR(tv[1][3][1], 1 * 4096 + 3 * 1024 + 512);
#undef ATT_TR
    if (FOX && diag) {
#pragma unroll
        for (int r = 0; r < 16; ++r) { const int key = kt * 64 + (r & 3) + 8 * (r >> 2) + 4 * h2;
            s0[r] = (key > qrow) ? -INFINITY : s0[r]; s1[r] = (key + 32 > qrow) ? -INFINITY : s1[r]; }
    }
    float ta = fmaxf(fmaxf(s0[0], s0[1]), s1[0]), tb = fmaxf(fmaxf(s0[2], s0[3]), s1[1]); ta = fmaxf(fmaxf(ta, s1[2]), s1[3]);
#pragma unroll
    for (int r = 4; r < 16; r += 4) { ta = fmaxf(fmaxf(ta, s0[r]), s0[r + 1]); tb = fmaxf(fmaxf(tb, s0[r + 2]), s0[r + 3]); ta = fmaxf(fmaxf(ta, s1[r]), s1[r + 1]); tb = fmaxf(fmaxf(tb, s1[r + 2]), s1[r + 3]); }
    float tmax = fmaxf(ta, tb);
    { const auto rr = __builtin_amdgcn_permlane32_swap(__float_as_uint(tmax), __float_as_uint(tmax), false, false); tmax = fmaxf(__uint_as_float(rr[0]), __uint_as_float(rr[1])); }
    if (__any(tmax > m + ATT_THR)) {
        const float mn = fmaxf(m, tmax), alpha = __builtin_amdgcn_exp2f(m - mn); m = mn; l *= alpha;
#pragma unroll
        for (int r = 0; r < 16; ++r) { O0[r] *= alpha; O1[r] *= alpha; }
    }
    float ps = 0.f;
#pragma unroll
    for (int r = 0; r < 16; ++r) { s0[r] = __builtin_amdgcn_exp2f(s0[r] - m); s1[r] = __builtin_amdgcn_exp2f(s1[r] - m); ps += s0[r] + s1[r]; }
    l += ps;
    bf16x8 pf[2][2];
#pragma unroll
    for (int sp = 0; sp < 2; ++sp) { u32x4 a, b;
        a.x = cvt_pk_bf16(s0[8 * sp + 0], s0[8 * sp + 1]); a.y = cvt_pk_bf16(s0[8 * sp + 2], s0[8 * sp + 3]); a.z = cvt_pk_bf16(s0[8 * sp + 4], s0[8 * sp + 5]); a.w = cvt_pk_bf16(s0[8 * sp + 6], s0[8 * sp + 7]);
        b.x = cvt_pk_bf16(s1[8 * sp + 0], s1[8 * sp + 1]); b.y = cvt_pk_bf16(s1[8 * sp + 2], s1[8 * sp + 3]); b.z = cvt_pk_bf16(s1[8 * sp + 4], s1[8 * sp + 5]); b.w = cvt_pk_bf16(s1[8 * sp + 6], s1[8 * sp + 7]);
        pf[0][sp] = __builtin_bit_cast(bf16x8, a); pf[1][sp] = __builtin_bit_cast(bf16x8, b); }
    __builtin_amdgcn_sched_barrier(0);
    asm volatile("s_waitcnt lgkmcnt(0)" ::: "memory");
    __builtin_amdgcn_sched_barrier(0);
#pragma unroll
    for (int kb = 0; kb < 2; ++kb)
#pragma unroll
        for (int sp = 0; sp < 2; ++sp) { const int ki = 2 * kb + sp;
            const v4i16_t a0 = tv[0][ki][0], a1 = tv[0][ki][1], b0 = tv[1][ki][0], b1 = tv[1][ki][1];
            const bf16x8 va = (bf16x8){a0[0], a0[1], a0[2], a0[3], a1[0], a1[1], a1[2], a1[3]}, vb = (bf16x8){b0[0], b0[1], b0[2], b0[3], b1[0], b1[1], b1[2], b1[3]};
            O0 = __builtin_amdgcn_mfma_f32_32x32x16_bf16(va, pf[kb][sp], O0, 0, 0, 0); O1 = __builtin_amdgcn_mfma_f32_32x32x16_bf16(vb, pf[kb][sp], O1, 0, 0, 0); }
    __builtin_amdgcn_sched_barrier(0);
}
__device__ __forceinline__ void att_load_q(bf16x8 (&qf)[4], const bf16_t* Qrow, int h2) {
    u32x4 qraw[4];
#pragma unroll
    for (int ks = 0; ks < 4; ++ks) qraw[ks] = *(const u32x4*)(Qrow + 16 * ks + 8 * h2);
#pragma unroll
    for (int ks = 0; ks < 4; ++ks) { const u32x4 w = qraw[ks];
        u32x4 o; o.x = cvt_pk_bf16(ATT_C2 * bf_lo(w.x), ATT_C2 * bf_hi(w.x)); o.y = cvt_pk_bf16(ATT_C2 * bf_lo(w.y), ATT_C2 * bf_hi(w.y));
        o.z = cvt_pk_bf16(ATT_C2 * bf_lo(w.z), ATT_C2 * bf_hi(w.z)); o.w = cvt_pk_bf16(ATT_C2 * bf_lo(w.w), ATT_C2 * bf_hi(w.w)); qf[ks] = __builtin_bit_cast(bf16x8, o); }
}
__device__ __forceinline__ void att_store_o(bf16_t* op, const f32x16& O0, const f32x16& O1, float l) {
    { const auto rr = __builtin_amdgcn_permlane32_swap(__float_as_uint(l), __float_as_uint(l), false, false); l = __uint_as_float(rr[0]) + __uint_as_float(rr[1]); }
    const float il = 1.0f / l;
#pragma unroll
    for (int g = 0; g < 4; ++g) { u32x2 w0, w1;
        w0.x = cvt_pk_bf16(O0[4 * g + 0] * il, O0[4 * g + 1] * il); w0.y = cvt_pk_bf16(O0[4 * g + 2] * il, O0[4 * g + 3] * il);
        w1.x = cvt_pk_bf16(O1[4 * g + 0] * il, O1[4 * g + 1] * il); w1.y = cvt_pk_bf16(O1[4 * g + 2] * il, O1[4 * g + 3] * il);
        *(u32x2*)(op + 8 * g) = w0; *(u32x2*)(op + 32 + 8 * g) = w1; }
}
constexpr float ATT_S8 = 16.0f;
typedef int i32x8a __attribute__((ext_vector_type(8)));
typedef int i32x4a __attribute__((ext_vector_type(4)));
__device__ __forceinline__ void att_tile8(const LAS unsigned char* sb, f32x16& s0, f32x16& s1, const i32x8a qf8, f32x16& O0, f32x16& O1, float& m, float& l,
                                          int kt, int qrow, bool diag, int h2, int ql, int vfo) {
    __builtin_amdgcn_sched_barrier(0);
    {   const int sw = (ql >> 2) & 3;
        const LAS unsigned char* k0p = sb + ql * 64; const LAS unsigned char* k1p = k0p + 32 * 64;
        const int c0 = ((2 * h2) ^ sw) * 16, c1 = ((2 * h2 + 1) ^ sw) * 16;
        const i32x4a a00 = *(const LAS i32x4a*)(k0p + c0), a01 = *(const LAS i32x4a*)(k0p + c1), a10 = *(const LAS i32x4a*)(k1p + c0), a11 = *(const LAS i32x4a*)(k1p + c1);
        const i32x8a ka = __builtin_shufflevector(a00, a01, 0, 1, 2, 3, 4, 5, 6, 7), kb = __builtin_shufflevector(a10, a11, 0, 1, 2, 3, 4, 5, 6, 7);
        s0 = __builtin_amdgcn_mfma_scale_f32_32x32x64_f8f6f4(ka, qf8, s0, 0, 0, 0, 0, 0, 0);
        s1 = __builtin_amdgcn_mfma_scale_f32_32x32x64_f8f6f4(kb, qf8, s1, 0, 0, 0, 0, 0, 0); }
    __builtin_amdgcn_sched_barrier(0);
    const unsigned va_ = (unsigned)(unsigned long)(sb + vfo);
    v4i16_t tv[2][4][2];
#define ATT_TR(dst, off) asm volatile("ds_read_b64_tr_b16 %0, %1 offset:%2" : "=v"(dst) : "v"(va_), "i"(off) : "memory")
    ATT_TR(tv[0][0][0], 0 * 4096 + 0 * 1024);    ATT_TR(tv[0][0][1], 0 * 4096 + 0 * 1024 + 512);
    ATT_TR(tv[0][1][0], 0 * 4096 + 1 * 1024);    ATT_TR(tv[0][1][1], 0 * 4096 + 1 * 1024 + 512);
    ATT_TR(tv[0][2][0], 0 * 4096 + 2 * 1024);    ATT_TR(tv[0][2][1], 0 * 4096 + 2 * 1024 + 512);
    ATT_TR(tv[0][3][0], 0 * 4096 + 3 * 1024);    ATT_TR(tv[0][3][1], 0 * 4096 + 3 * 1024 + 512);
    ATT_TR(tv[1][0][0], 1 * 4096 + 0 * 1024);    ATT_TR(tv[1][0][1], 1 * 4096 + 0 * 1024 + 512);
    ATT_TR(tv[1][1][0], 1 * 4096 + 1 * 1024);    ATT_TR(tv[1][1][1], 1 * 4096 + 1 * 1024 + 512);
    ATT_TR(tv[1][2][0], 1 * 4096 + 2 * 1024);    ATT_TR(tv[1][2][1], 1 * 4096 + 2 * 1024 + 512);
    ATT_TR(tv[1][3][0], 1 * 4096 + 3 * 1024);    ATT_TR(tv[1][3][1], 1 * 4096 + 3 * 1024 + 512);
#undef ATT_TR
    if (diag) {
#pragma unroll
        for (int r = 0; r < 16; ++r) { const int key = kt * 64 + (r & 3) + 8 * (r >> 2) + 4 * h2;
            s0[r] = (key > qrow) ? -INFINITY : s0[r]; s1[r] = (key + 32 > qrow) ? -INFINITY : s1[r]; }
    }
    float ta = fmaxf(fmaxf(s0[0], s0[1]), s1[0]), tb = fmaxf(fmaxf(s0[2], s0[3]), s1[1]); ta = fmaxf(fmaxf(ta, s1[2]), s1[3]);
#pragma unroll
    for (int r = 4; r < 16; r += 4) { ta = fmaxf(fmaxf(ta, s0[r]), s0[r + 1]); tb = fmaxf(fmaxf(tb, s0[r + 2]), s0[r + 3]); ta = fmaxf(fmaxf(ta, s1[r]), s1[r + 1]); tb = fmaxf(fmaxf(tb, s1[r + 2]), s1[r + 3]); }
    float tmax = fmaxf(ta, tb);
    { const auto rr = __builtin_amdgcn_permlane32_swap(__float_as_uint(tmax), __float_as_uint(tmax), false, false); tmax = fmaxf(__uint_as_float(rr[0]), __uint_as_float(rr[1])); }
    if (__any(tmax > m + ATT_THR * ATT_S8)) {
        const float mn = fmaxf(m, tmax), alpha = __builtin_amdgcn_exp2f((m - mn) * (1.0f / ATT_S8)); m = mn; l *= alpha;
#pragma unroll
        for (int r = 0; r < 16; ++r) { O0[r] *= alpha; O1[r] *= alpha; }
    }
    const float nm = -m * (1.0f / ATT_S8);
    float ps = 0.f;
#pragma unroll
    for (int r = 0; r < 16; ++r) { s0[r] = __builtin_amdgcn_exp2f(fmaf(s0[r], 1.0f / ATT_S8, nm)); s1[r] = __builtin_amdgcn_exp2f(fmaf(s1[r], 1.0f / ATT_S8, nm)); ps += s0[r] + s1[r]; }
    l += ps;
    bf16x8 pf[2][2];
#pragma unroll
    for (int sp = 0; sp < 2; ++sp) { u32x4 a, b;
        a.x = cvt_pk_bf16(s0[8 * sp + 0], s0[8 * sp + 1]); a.y = cvt_pk_bf16(s0[8 * sp + 2], s0[8 * sp + 3]); a.z = cvt_pk_bf16(s0[8 * sp + 4], s0[8 * sp + 5]); a.w = cvt_pk_bf16(s0[8 * sp + 6], s0[8 * sp + 7]);
        b.x = cvt_pk_bf16(s1[8 * sp + 0], s1[8 * sp + 1]); b.y = cvt_pk_bf16(s1[8 * sp + 2], s1[8 * sp + 3]); b.z = cvt_pk_bf16(s1[8 * sp + 4], s1[8 * sp + 5]); b.w = cvt_pk_bf16(s1[8 * sp + 6], s1[8 * sp + 7]);
        pf[0][sp] = __builtin_bit_cast(bf16x8, a); pf[1][sp] = __builtin_bit_cast(bf16x8, b); }
    __builtin_amdgcn_sched_barrier(0);
    asm volatile("s_waitcnt lgkmcnt(0)" ::: "memory");
    __builtin_amdgcn_sched_barrier(0);
#pragma unroll
    for (int kb = 0; kb < 2; ++kb)
#pragma unroll
        for (int sp = 0; sp < 2; ++sp) { const int ki = 2 * kb + sp;
            const v4i16_t a0 = tv[0][ki][0], a1 = tv[0][ki][1], b0 = tv[1][ki][0], b1 = tv[1][ki][1];
            const bf16x8 va = (bf16x8){a0[0], a0[1], a0[2], a0[3], a1[0], a1[1], a1[2], a1[3]}, vb = (bf16x8){b0[0], b0[1], b0[2], b0[3], b1[0], b1[1], b1[2], b1[3]};
            O0 = __builtin_amdgcn_mfma_f32_32x32x16_bf16(va, pf[kb][sp], O0, 0, 0, 0); O1 = __builtin_amdgcn_mfma_f32_32x32x16_bf16(vb, pf[kb][sp], O1, 0, 0, 0); }
    __builtin_amdgcn_sched_barrier(0);
}
__device__ __forceinline__ void attn_unit_fox2(const unsigned char* Q8, const unsigned char* K8, const bf16_t* Vp, bf16_t* Op, int qA, int qB, LAS unsigned char* lds) {
    int tid = threadIdx.x; asm volatile("" : "+v"(tid));
    const int lane = tid & 63, wave = __builtin_amdgcn_readfirstlane(tid >> 6), ql = lane & 31, h2 = lane >> 5;
    const LAS float* ncl = (const LAS float*)(lds + ATT_C_OFF);
    const int q0A = 256 * qA, q0B = 256 * qB, nkt = 4 * qA + 4, nktB = 4 * qB + 4;
    const int qrowA = q0A + 32 * wave + ql, qrowB = q0B + 32 * wave + ql;
    const int kkey = 16 * (wave & 3) + (lane >> 2);
    const unsigned char* ksrc = K8 + (size_t)kkey * 768 + 16 * ((lane & 3) ^ ((kkey >> 2) & 3));
    const bf16_t* vsrc = Vp + (size_t)(16 * (wave & 3) + (lane >> 2)) * 768 + 32 * (wave >> 2) + 8 * (lane & 3);
    const bool kwave = wave < 4;
#define ATT_DMA(t, slot) do { if (kwave) __builtin_amdgcn_global_load_lds((const unsigned*)(ksrc + (size_t)(t) * 64 * 768), (LAS unsigned*)(lds + (slot) * ATT_SLOT + wave * 1024), 16, 0, 0); \
                              __builtin_amdgcn_global_load_lds((const unsigned*)(vsrc + (size_t)(t) * 64 * 768), (LAS unsigned*)(lds + (slot) * ATT_SLOT + 8192 + wave * 1024), 16, 0, 0); } while (0)
    i32x8a qfA, qfB;
    { const i32x4a a0 = *(const i32x4a*)(Q8 + (size_t)qrowA * 768 + 32 * h2), a1 = *(const i32x4a*)(Q8 + (size_t)qrowA * 768 + 32 * h2 + 16);
      const i32x4a b0 = *(const i32x4a*)(Q8 + (size_t)qrowB * 768 + 32 * h2), b1 = *(const i32x4a*)(Q8 + (size_t)qrowB * 768 + 32 * h2 + 16);
      qfA = __builtin_shufflevector(a0, a1, 0, 1, 2, 3, 4, 5, 6, 7); qfB = __builtin_shufflevector(b0, b1, 0, 1, 2, 3, 4, 5, 6, 7); }
    ATT_DMA(0, 0);
    ATT_DMA(1, 1);
    f32x16 OA0, OA1, OB0, OB1;
#pragma unroll
    for (int r = 0; r < 16; ++r) { OA0[r] = 0.f; OA1[r] = 0.f; OB0[r] = 0.f; OB1[r] = 0.f; }
    float mA = -1e30f, lA = 0.f, mB = -1e30f, lB = 0.f;
    const int vfo = 8192 + (4 * h2 + ((lane & 15) >> 2)) * 64 + ((lane >> 4) & 1) * 32 + (lane & 3) * 8;
    const int lastA = (q0A + 32 * wave + 31) >> 6, lastB = (q0B + 32 * wave + 31) >> 6;
    int pair = 0;
    for (int kt0 = 0; kt0 < nkt; kt0 += 2) {
        asm volatile("s_waitcnt vmcnt(0)" ::: "memory");
        __builtin_amdgcn_s_barrier();
        asm volatile("" ::: "memory");
        if (kt0 + 2 < nkt) { ATT_DMA(kt0 + 2, 2 * (pair ^ 1)); ATT_DMA(kt0 + 3, 2 * (pair ^ 1) + 1); }
#pragma unroll 1
        for (int sub = 0; sub < 2; ++sub) { const int kt = kt0 + sub; const LAS unsigned char* sb = lds + (2 * pair + sub) * ATT_SLOT;
            if (kt <= lastA) { f32x16 s0, s1;
#pragma unroll
                for (int g = 0; g < 4; ++g) { const f32x4 c0 = *(const LAS f32x4*)(ncl + kt * 64 + 8 * g + 4 * h2), c1 = *(const LAS f32x4*)(ncl + kt * 64 + 32 + 8 * g + 4 * h2);
#pragma unroll
                    for (int j = 0; j < 4; ++j) { s0[4 * g + j] = c0[j]; s1[4 * g + j] = c1[j]; } }
                att_tile8(sb, s0, s1, qfA, OA0, OA1, mA, lA, kt, qrowA, kt * 64 + 63 > q0A + 32 * wave, h2, ql, vfo); }
            if (kt < nktB && kt <= lastB) { f32x16 s0, s1;
#pragma unroll
                for (int g = 0; g < 4; ++g) { const f32x4 c0 = *(const LAS f32x4*)(ncl + kt * 64 + 8 * g + 4 * h2), c1 = *(const LAS f32x4*)(ncl + kt * 64 + 32 + 8 * g + 4 * h2);
#pragma unroll
                    for (int j = 0; j < 4; ++j) { s0[4 * g + j] = c0[j]; s1[4 * g + j] = c1[j]; } }
                att_tile8(sb, s0, s1, qfB, OB0, OB1, mB, lB, kt, qrowB, kt * 64 + 63 > q0B + 32 * wave, h2, ql, vfo); }
        }
        pair ^= 1;
    }
#undef ATT_DMA
    att_store_o(Op + (size_t)qrowA * 1024 + 4 * h2, OA0, OA1, lA);
    att_store_o(Op + (size_t)qrowB * 1024 + 4 * h2, OB0, OB1, lB);
    asm volatile("s_waitcnt lgkmcnt(0)" ::: "memory"); __builtin_amdgcn_s_barrier(); asm volatile("" ::: "memory");
}
__device__ __forceinline__ void memattn_mfma(const bf16_t* proj, const bf16_t* kvmem, int koff, bf16_t* cat, LAS unsigned char* lds) {
    const int tid = threadIdx.x, lane = tid & 63, wave = __builtin_amdgcn_readfirstlane(tid >> 6), ql = lane & 31, h2 = lane >> 5;
    const int kfo = h2 * 1024 + ql * 16, vfo = 8192 + (4 * h2 + ((lane & 15) >> 2)) * 64 + ((lane >> 4) & 1) * 32 + (lane & 3) * 8;
    for (int u = blockIdx.x; u < NB * 4 * 2; u += gridDim.x) {
        const int half = u & 1, h = (u >> 1) & 3, b = u >> 3;
        const bf16_t* Kp = kvmem + (size_t)b * MEMT * 1024 + koff + 64 * h; const bf16_t* Vp = Kp + 256;
        const bf16_t* ksrc = Kp + (size_t)lane * 1024 + 8 * wave;
        const bf16_t* vsrc = Vp + (size_t)(16 * (wave & 3) + (lane >> 2)) * 1024 + 32 * (wave >> 2) + 8 * (lane & 3);
        __syncthreads();
#pragma unroll
        for (int t = 0; t < 4; ++t) { __builtin_amdgcn_global_load_lds((const unsigned*)(ksrc + (size_t)t * 64 * 1024), (LAS unsigned*)(lds + t * ATT_SLOT + wave * 1024), 16, 0, 0);
                                       __builtin_amdgcn_global_load_lds((const unsigned*)(vsrc + (size_t)t * 64 * 1024), (LAS unsigned*)(lds + t * ATT_SLOT + 8192 + wave * 1024), 16, 0, 0); }
        const bf16_t* Qb = proj + (size_t)b * S * 1024 + 768 + 64 * h; bf16_t* Ob = cat + (size_t)b * S * 1024 + 768 + 64 * h;
        bf16x8 qf[4];
        att_load_q(qf, Qb + (size_t)(half * 1024 + 32 * wave + ql) * 1024, h2);
        asm volatile("s_waitcnt vmcnt(0)" ::: "memory");
        __builtin_amdgcn_s_barrier();
        asm volatile("" ::: "memory");
        for (int qb = 0; qb < 4; ++qb) {
            const int qrow = half * 1024 + qb * 256 + 32 * wave + ql;
            f32x16 O0, O1;
#pragma unroll
            for (int r = 0; r < 16; ++r) { O0[r] = 0.f; O1[r] = 0.f; }
            float m = -1e30f, l = 0.f;
            bf16x8 qn[4];
            if (qb + 1 < 4) att_load_q(qn, Qb + (size_t)(qrow + 256) * 1024, h2);
#pragma unroll 1
            for (int kt = 0; kt < 4; ++kt) { f32x16 s0, s1;
#pragma unroll
                for (int r = 0; r < 16; ++r) { s0[r] = 0.f; s1[r] = 0.f; }
                att_tile<false>(lds + kt * ATT_SLOT, s0, s1, qf, O0, O1, m, l, kt, qrow, false, h2, kfo, vfo); }
            att_store_o(Ob + (size_t)qrow * 1024 + 4 * h2, O0, O1, l);
            if (qb + 1 < 4) {
#pragma unroll
                for (int ks = 0; ks < 4; ++ks) qf[ks] = qn[ks]; }
        }
    }
}
__device__ __forceinline__ void fox_mfma(const unsigned char* Q8, const unsigned char* K8, const bf16_t* Vf, const float* glog, bf16_t* cat, LAS unsigned char* lds) {
    const int tid = threadIdx.x, lane = tid & 63, wave = tid >> 6;
    LAS float* cl = (LAS float*)(lds + ATT_C_OFF); LAS float* wtot = (LAS float*)(lds + ATT_W_OFF);
    const int G = gridDim.x, vcu = (G % 8 == 0) ? ((int)(blockIdx.x % 8) * (G / 8) + (int)(blockIdx.x / 8)) : (int)blockIdx.x;
    const int npair = NB * 12 * 4, npp = (npair + G - 1) / G; int last_bh = -1;
    for (int ip = 0; ip < npp; ++ip) {
        const int p = vcu * npp + ip; if (p >= npair) break;
        const int bh = p >> 2, j = p & 3, b = bh / 12, h = bh % 12;
        if (bh != last_bh) {
            last_bh = bh;
            float v[4];
#pragma unroll
            for (int k = 0; k < 4; ++k) v[k] = glog[((size_t)b * S + 4 * tid + k) * 16 + h];
            v[1] += v[0]; v[2] += v[1]; v[3] += v[2];
            float inc = v[3];
#pragma unroll
            for (int off = 1; off < 64; off <<= 1) { const float n = __shfl_up(inc, off); if (lane >= off) inc += n; }
            if (lane == 63) wtot[wave] = inc;
            __syncthreads();
            float base = inc - v[3];
            for (int w = 0; w < wave; ++w) base += wtot[w];
#pragma unroll
            for (int k = 0; k < 4; ++k) cl[4 * tid + k] = -(base + v[k]) * (ATT_L2E * ATT_S8);
            __syncthreads();
        }
        attn_unit_fox2(Q8 + (size_t)b * S * 768 + 64 * h, K8 + (size_t)b * S * 768 + 64 * h, Vf + (size_t)b * S * 768 + 64 * h,
                       cat + (size_t)b * S * 1024 + 64 * h, 7 - j, j, lds);
    }
}

constexpr float Y8_SCALE = 32.0f;
__device__ __forceinline__ void add_fp8x16(float (&v)[16], const u32x4 w, float sc) {
    const unsigned ww[4] = {w.x, w.y, w.z, w.w};
#pragma unroll
    for (int q = 0; q < 4; ++q) { const f32x2 lo = __builtin_amdgcn_cvt_pk_f32_fp8((int)ww[q], false), hi = __builtin_amdgcn_cvt_pk_f32_fp8((int)ww[q], true);
        v[4 * q + 0] += sc * lo[0]; v[4 * q + 1] += sc * lo[1]; v[4 * q + 2] += sc * hi[0]; v[4 * q + 3] += sc * hi[1]; }
}
__device__ __forceinline__ void unpack_bf16x8(float* v, const u32x4 x, float sc) {
    v[0] = sc * bf_lo(x.x); v[1] = sc * bf_hi(x.x); v[2] = sc * bf_lo(x.y); v[3] = sc * bf_hi(x.y); v[4] = sc * bf_lo(x.z); v[5] = sc * bf_hi(x.z); v[6] = sc * bf_lo(x.w); v[7] = sc * bf_hi(x.w);
}
template <bool HP32, bool COMBINE, bool GATES>
__device__ __forceinline__ void ln_phase(const void* hprev, const void* add, const int* tok_slot, const float* gam, const float* bet, bf16_t* hout, float* fout,
                                         const float* gwt, const float* fgate_b, float* glog, LAS unsigned char* lds, unsigned char* qout = nullptr) {
    static_assert(!(HP32 && (COMBINE || GATES)), "the f32-input form is the plain LN1 of layer 0");
    constexpr int NCH = HP32 ? 4 : 2, CW = 16 / NCH, CS = 1024 / NCH;
    const int tid = threadIdx.x, lane = tid & 63, wave = tid >> 6;
    const int gw = blockIdx.x * NWAVES + wave, NGW = gridDim.x * NWAVES;
    LAS float* gl = (LAS float*)lds;
    if (GATES) { for (int i = tid; i < 12 * 1024; i += NTHR) gl[i] = gwt[i]; __syncthreads(); }
    float g[16], bb[16];
#pragma unroll
    for (int ch = 0; ch < NCH; ++ch)
#pragma unroll
        for (int q = 0; q < CW / 4; ++q) { const f32x4 gv = *(const f32x4*)(gam + CS * ch + CW * lane + 4 * q), bv = *(const f32x4*)(bet + CS * ch + CW * lane + 4 * q);
#pragma unroll
            for (int j = 0; j < 4; ++j) { g[ch * CW + q * 4 + j] = gv[j]; bb[ch * CW + q * 4 + j] = bv[j]; } }
    for (int rp = gw; rp < T / 2; rp += NGW) {
        const int row0 = 2 * rp;
        float v[2][16];
        f32x4 xf[2][4]; u32x4 xh[2][2], am[2][2]; u32x2 am2[2][4], ay[2][4][2];
        int myslot = 0;
        if (COMBINE) myslot = tok_slot[(size_t)row0 * 4 + (lane & 7)];
#pragma unroll
        for (int r = 0; r < 2; ++r) {
            if (HP32) { const float* hp = (const float*)hprev + (size_t)(row0 + r) * 1024 + 4 * lane; const bf16_t* ap = (const bf16_t*)add + (size_t)(row0 + r) * 1024 + 4 * lane;
#pragma unroll
                for (int ch = 0; ch < 4; ++ch) { xf[r][ch] = *(const f32x4*)(hp + 256 * ch); am2[r][ch] = *(const u32x2*)(ap + 256 * ch); }
            } else { const bf16_t* hp = (const bf16_t*)hprev + (size_t)(row0 + r) * 1024 + 8 * lane; xh[r][0] = *(const u32x4*)hp; xh[r][1] = *(const u32x4*)(hp + 512);
                if (!COMBINE) { const bf16_t* ap = (const bf16_t*)add + (size_t)(row0 + r) * 1024 + 8 * lane; am[r][0] = *(const u32x4*)ap; am[r][1] = *(const u32x4*)(ap + 512); } }
        }
        if (COMBINE) {
#pragma unroll
            for (int r = 0; r < 2; ++r)
#pragma unroll
                for (int k = 0; k < 4; ++k) { const int sl = __builtin_amdgcn_readlane(myslot, 4 * r + k); const unsigned char* yp = (const unsigned char*)add + (size_t)sl * 1024 + 8 * lane;
                    ay[r][k][0] = *(const u32x2*)yp; ay[r][k][1] = *(const u32x2*)(yp + 512); }
        }
#pragma unroll
        for (int r = 0; r < 2; ++r) {
            if (HP32) {
#pragma unroll
                for (int ch = 0; ch < 4; ++ch) { const u32x2 mw = am2[r][ch];
                    v[r][4 * ch + 0] = DN_ALPHA * xf[r][ch][0] + bf_lo(mw.x); v[r][4 * ch + 1] = DN_ALPHA * xf[r][ch][1] + bf_hi(mw.x);
                    v[r][4 * ch + 2] = DN_ALPHA * xf[r][ch][2] + bf_lo(mw.y); v[r][4 * ch + 3] = DN_ALPHA * xf[r][ch][3] + bf_hi(mw.y); }
            } else {
                unpack_bf16x8(&v[r][0], xh[r][0], DN_ALPHA); unpack_bf16x8(&v[r][8], xh[r][1], DN_ALPHA);
                if (COMBINE) {
                    float acc[16];
#pragma unroll
                    for (int i = 0; i < 16; ++i) acc[i] = 0.f;
#pragma unroll
                    for (int k = 0; k < 4; ++k)
#pragma unroll
                        for (int ch = 0; ch < 2; ++ch) { const unsigned ww[2] = {ay[r][k][ch].x, ay[r][k][ch].y};
#pragma unroll
                            for (int q = 0; q < 2; ++q) { const f32x2 lo = __builtin_amdgcn_cvt_pk_f32_fp8((int)ww[q], false), hi = __builtin_amdgcn_cvt_pk_f32_fp8((int)ww[q], true);
                                acc[8 * ch + 4 * q + 0] += lo[0]; acc[8 * ch + 4 * q + 1] += lo[1]; acc[8 * ch + 4 * q + 2] += hi[0]; acc[8 * ch + 4 * q + 3] += hi[1]; } }
#pragma unroll
                    for (int i = 0; i < 16; ++i) v[r][i] += acc[i] * (1.0f / Y8_SCALE);
                } else { float t[16]; unpack_bf16x8(&t[0], am[r][0], 1.0f); unpack_bf16x8(&t[8], am[r][1], 1.0f);
#pragma unroll
                    for (int i = 0; i < 16; ++i) v[r][i] += t[i]; }
            }
        }
        float s[2] = {0.f, 0.f};
#pragma unroll
        for (int r = 0; r < 2; ++r)
#pragma unroll
            for (int i = 0; i < 16; ++i) s[r] += v[r][i];
        float mean[2], s2[2] = {0.f, 0.f};
#pragma unroll
        for (int r = 0; r < 2; ++r) { mean[r] = wave_sum(s[r]) * (1.0f / 1024.0f);
#pragma unroll
            for (int i = 0; i < 16; ++i) { v[r][i] -= mean[r]; s2[r] += v[r][i] * v[r][i]; } }
#pragma unroll
        for (int r = 0; r < 2; ++r) { const float rstd = 1.0f / sqrtf(wave_sum(s2[r]) * (1.0f / 1024.0f) + LN_EPS);
#pragma unroll
            for (int i = 0; i < 16; ++i) v[r][i] = v[r][i] * rstd * g[i] + bb[i]; }
#pragma unroll
        for (int r = 0; r < 2; ++r) {
            if (hout) { bf16_t* op = hout + (size_t)(row0 + r) * 1024 + CW * lane;
                if (HP32) {
#pragma unroll
                    for (int ch = 0; ch < 4; ++ch) { u32x2 w; w.x = cvt_pk_bf16(v[r][4 * ch + 0], v[r][4 * ch + 1]); w.y = cvt_pk_bf16(v[r][4 * ch + 2], v[r][4 * ch + 3]); *(u32x2*)(op + 256 * ch) = w; }
                } else {
#pragma unroll
                    for (int ch = 0; ch < 2; ++ch) { u32x4 w; w.x = cvt_pk_bf16(v[r][ch * 8 + 0], v[r][ch * 8 + 1]); w.y = cvt_pk_bf16(v[r][ch * 8 + 2], v[r][ch * 8 + 3]);
                        w.z = cvt_pk_bf16(v[r][ch * 8 + 4], v[r][ch * 8 + 5]); w.w = cvt_pk_bf16(v[r][ch * 8 + 6], v[r][ch * 8 + 7]); *(u32x4*)(op + 512 * ch) = w; } } }
            if (qout) { unsigned char* qp = qout + (size_t)(row0 + r) * 1024 + CW * lane;
                if (HP32) {
#pragma unroll
                    for (int ch = 0; ch < 4; ++ch) *(unsigned*)(qp + 256 * ch) = pg8::pk_fp8x4(v[r][4 * ch + 0], v[r][4 * ch + 1], v[r][4 * ch + 2], v[r][4 * ch + 3]);
                } else {
#pragma unroll
                    for (int ch = 0; ch < 2; ++ch) { u32x2 w; w.x = pg8::pk_fp8x4(v[r][8 * ch + 0], v[r][8 * ch + 1], v[r][8 * ch + 2], v[r][8 * ch + 3]);
                        w.y = pg8::pk_fp8x4(v[r][8 * ch + 4], v[r][8 * ch + 5], v[r][8 * ch + 6], v[r][8 * ch + 7]); *(u32x2*)(qp + 512 * ch) = w; } } }
            if (!HP32 && fout) { float* op = fout + (size_t)(row0 + r) * 1024 + 8 * lane;
#pragma unroll
                for (int ch = 0; ch < 2; ++ch)
#pragma unroll
                    for (int q = 0; q < 2; ++q) *(f32x4*)(op + 512 * ch + 4 * q) = (f32x4){v[r][ch * 8 + q * 4 + 0], v[r][ch * 8 + q * 4 + 1], v[r][ch * 8 + q * 4 + 2], v[r][ch * 8 + q * 4 + 3]}; }
            if (GATES) {
                float mine = 0.f;
#pragma unroll
                for (int j = 0; j < 12; ++j) { float p = 0.f;
#pragma unroll
                    for (int ch = 0; ch < 2; ++ch)
#pragma unroll
                        for (int q = 0; q < 2; ++q) { const f32x4 w = *(const LAS f32x4*)(gl + j * 1024 + 512 * ch + 8 * lane + 4 * q);
                            p += v[r][ch * 8 + q * 4 + 0] * w[0] + v[r][ch * 8 + q * 4 + 1] * w[1] + v[r][ch * 8 + q * 4 + 2] * w[2] + v[r][ch * 8 + q * 4 + 3] * w[3]; }
                    p = wave_sum(p); if (lane == j) mine = p; }
                if (lane < 12) { const float z = mine + fgate_b[lane]; const float ls = fminf(z, 0.f) - log1pf(expf(-fabsf(z))); glog[(size_t)(row0 + r) * 16 + lane] = ls; }
            }
        }
    }
}

__device__ __forceinline__ void top4_phase(const float* logits, const float* rb, int* tok_e, float* tok_g, int* tok_r, unsigned* wg_hist, LAS unsigned char* lds) {
    const int tid = threadIdx.x;
    LAS unsigned* hist = (LAS unsigned*)lds;
    for (int ch = blockIdx.x; ch < NCHUNK; ch += gridDim.x) {
        __syncthreads();
        if (tid < 32) hist[tid] = 0u;
        __syncthreads();
        if (tid < 256) {
            const int t = ch * 256 + tid; const float* lp = logits + (size_t)t * 32;
            float lg[32];
#pragma unroll
            for (int q = 0; q < 8; ++q) { const f32x4 hv = *(const f32x4*)(lp + 4 * q) + *(const f32x4*)(lp + (size_t)T * 32 + 4 * q), bv = *(const f32x4*)(rb + 4 * q);
#pragma unroll
                for (int j = 0; j < 4; ++j) lg[4 * q + j] = hv[j] + bv[j]; }
            unsigned used = 0u; int sel[4]; float val[4];
#pragma unroll
            for (int k = 0; k < 4; ++k) { float best = -INFINITY; int bi = 0;
#pragma unroll
                for (int e = 0; e < 32; ++e) { const float c = ((used >> e) & 1u) ? -INFINITY : lg[e]; if (c > best) { best = c; bi = e; } }
                sel[k] = bi; val[k] = best; used |= 1u << bi; }
            const float e1 = __expf(val[1] - val[0]), e2 = __expf(val[2] - val[0]), e3 = __expf(val[3] - val[0]); const float inv = 1.0f / (1.0f + e1 + e2 + e3);
            const float gt[4] = {inv, e1 * inv, e2 * inv, e3 * inv};
            int rk[4];
#pragma unroll
            for (int k = 0; k < 4; ++k) rk[k] = (int)atomicAdd((unsigned*)(hist + sel[k]), 1u);
            *(int4*)(tok_e + (size_t)t * 4) = make_int4(sel[0], sel[1], sel[2], sel[3]);
            *(f32x4*)(tok_g + (size_t)t * 4) = (f32x4){gt[0], gt[1], gt[2], gt[3]};
            *(int4*)(tok_r + (size_t)t * 4) = make_int4(rk[0], rk[1], rk[2], rk[3]);
        }
        __syncthreads();
        if (tid < 32) wg_hist[ch * 32 + tid] = hist[tid];
    }
}

__device__ __forceinline__ void assign_phase(const unsigned* wg_hist, const int* tok_e, const float* tok_g, const int* tok_r, int* tok_s, float* slot_g, int* slot_t,
                                             int* tiletab, LAS unsigned char* lds) {
    const int tid = threadIdx.x, lane = tid & 63, wave = tid >> 6;
    LAS unsigned* rtot = (LAS unsigned*)lds;
    LAS unsigned* rpre = rtot + 512;
    LAS unsigned* cnt = rpre + 512;
    LAS unsigned* pstart = cnt + 32;
    LAS unsigned* base = pstart + 40;
    LAS int* sl = (LAS int*)(base + 32);
    for (int ch = blockIdx.x; ch < NCHUNK; ch += gridDim.x) {
        __syncthreads();
        { const int e = tid & 31, part = tid >> 5; unsigned tot = 0u, pre = 0u;
          for (int c = part * 16; c < part * 16 + 16; ++c) { const unsigned hv = wg_hist[c * 32 + e]; tot += hv; if (c < ch) pre += hv; }
          rtot[part * 32 + e] = tot; rpre[part * 32 + e] = pre; }
        __syncthreads();
        if (tid < 32) { unsigned tot = 0u, pre = 0u;
            for (int p = 0; p < 16; ++p) { tot += rtot[p * 32 + tid]; pre += rpre[p * 32 + tid]; }
            cnt[tid] = tot; base[tid] = pre; }
        __syncthreads();
        if (tid == 0) { unsigned acc = 0u; for (int e = 0; e < 32; ++e) { pstart[e] = acc; acc += (cnt[e] + 255u) & ~255u; } pstart[32] = acc; }
        __syncthreads();
        if (tid < 256) { const int t = ch * 256 + tid;
            const int4 e4 = *(const int4*)(tok_e + (size_t)t * 4), r4 = *(const int4*)(tok_r + (size_t)t * 4); const f32x4 g4 = *(const f32x4*)(tok_g + (size_t)t * 4);
            const int es[4] = {e4.x, e4.y, e4.z, e4.w}, rs[4] = {r4.x, r4.y, r4.z, r4.w}; int so[4];
#pragma unroll
            for (int k = 0; k < 4; ++k) { so[k] = (int)(pstart[es[k]] + base[es[k]]) + rs[k]; slot_g[so[k]] = g4[k]; slot_t[so[k]] = t; }
            *(int4*)(tok_s + (size_t)t * 4) = make_int4(so[0], so[1], so[2], so[3]); }
        __syncthreads();
        if (ch == (int)blockIdx.x) {
            for (int e = blockIdx.x; e < NE; e += gridDim.x) {
                const int p0 = (int)(pstart[e] + cnt[e]), p1 = (int)pstart[e + 1];
                for (int s = p0 + tid; s < p1; s += NTHR) { slot_g[s] = 0.f; slot_t[s] = 0; }
                for (int tl = (int)(pstart[e] >> 8) + tid; tl < (int)(pstart[e + 1] >> 8); tl += NTHR) tiletab[16 + tl] = e;
            }
            if (blockIdx.x == 0 && tid == 0) tiletab[0] = (int)(pstart[32] >> 8);
        }
    }
}

__global__ void __launch_bounds__(NTHR, 2) fwd_kernel(Args args) {
    extern __shared__ __attribute__((aligned(16))) unsigned char lds_raw[];
    LAS unsigned char* lds = (LAS unsigned char*)lds_raw;
    volatile LAS unsigned* MISC = (volatile LAS unsigned*)(lds + MISC_OFF);
    const int tid = threadIdx.x, lane = tid & 63, wave = __builtin_amdgcn_readfirstlane(tid >> 6);
    const int G = gridDim.x;
    unsigned char* ws = args.ws;
    unsigned* ctl = (unsigned*)(ws + WS_CTL);
    if (tid < 32) MISC[tid] = 0u;
    __syncthreads();
    XcdBarrier bar; bar.bar = ctl + CW_BAR; bar.x = 0; bar.st = nullptr;
#if !MK_PER_PHASE
    bar = xcd_barrier_post(ctl + CW_BAR, MISC + 8);
#endif
    const int lo = args.ph_lo, hi = args.ph_hi;
#ifndef PH_MASK
#define PH_MASK 0xFFFFFFFFu
#endif
#ifndef PH_TWICE
#define PH_TWICE 0u
#endif
#define TW(k) ((((unsigned)PH_TWICE >> (k)) & 1u) != 0u)
#define IN(k) (((PH_MASK >> (k)) & 1u) && lo <= (k) && (k) < hi)
#if MK_PER_PHASE
#define SEAM(k) do { } while (0)
#else
#define SEAM(k) do { if (IN(k) && IN((k) + 1)) xcd_barrier(bar); } while (0)
#endif
    bf16_t* const R1 = (bf16_t*)(ws + WS_R1); bf16_t* const R2 = (bf16_t*)(ws + WS_R2);
    bf16_t* const PROJ = (bf16_t*)(ws + WS_PROJ); bf16_t* const CAT = (bf16_t*)(ws + WS_CAT); bf16_t* const MIX = (bf16_t*)(ws + WS_MIX); bf16_t* const DBUF = (bf16_t*)(ws + WS_DBUF);
    bf16_t* const KF = (bf16_t*)(ws + WS_KF); bf16_t* const VF = (bf16_t*)(ws + WS_VF);
    bf16_t* const ACT = (bf16_t*)(ws + WS_ACT); bf16_t* const YB = (bf16_t*)(ws + WS_Y);
    unsigned char* const MEMB = ws + WS_MEMB; bf16_t* const KVMEM = (bf16_t*)(ws + WS_KVMEM);
    float* const LOGITS = (float*)(ws + WS_LOGITS); float* const GLOG = (float*)(ws + WS_GLOG);
    int* const TOKE = (int*)(ws + WS_TOKE); float* const TOKG = (float*)(ws + WS_TOKG); int* const TOKR = (int*)(ws + WS_TOKR); int* const TOKS = (int*)(ws + WS_TOKS);
    float* const SLOTG = (float*)(ws + WS_SLOTG); int* const SLOTT = (int*)(ws + WS_SLOTT);
    unsigned* const WGH = (unsigned*)(ws + WS_WGHIST); int* const TILETAB = (int*)(ws + WS_TILETAB);

    if (IN(0)) { p0_prologue(args, lds, wave, lane); } if (TW(0) && IN(0)) { p0_prologue(args, lds, wave, lane); }
    SEAM(0);
    if (IN(1)) {
        { pg8::Gemm g{R1, ws + WS_WINA, T, 1024, 2048}; pg8::StaticOrder So; So.init(T, 1024, G, (int)blockIdx.x);
          pg8::EpiBf16 E{PROJ, 1024, nullptr, 0, 0, 1.0f}; pg8::gemm_phase(lds, g, So, E); }
        { pg8::Gemm g{MEMB, ws + WS_WMKV, NB * MEMT, 1024, 1024}; pg8::StaticOrder So; So.init(NB * MEMT, 1024, G, (int)((blockIdx.x + 128) % G));
          pg8::EpiBf16 E{KVMEM, 1024, nullptr, 0, 0, 1.0f / pg8::W8_SCALE}; pg8::gemm_phase<pg8::EpiBf16, pg8::StaticOrder, true>(lds, g, So, E); }
    }
    SEAM(1);
    if (IN(2)) { pool_d_phase(PROJ, CAT); memattn_mfma(PROJ, KVMEM, 0, CAT, lds); } if (TW(2) && IN(2)) { pool_d_phase(PROJ, CAT); memattn_mfma(PROJ, KVMEM, 0, CAT, lds); }
    SEAM(2);
    if (IN(4)) { pg8::Gemm g{CAT, ws + WS_WOUTA, T, 1024, 2048}; pg8::StaticOrder So; So.init(T, 1024, G, (int)blockIdx.x);
        pg8::EpiBf16 E{MIX, 1024, nullptr, 0, 0, 1.0f}; pg8::gemm_phase(lds, g, So, E); }
    SEAM(4);
    if (IN(5)) ln_phase<false, false, false>(R1, MIX, nullptr, args.in[2], args.in[3], R1, nullptr, nullptr, nullptr, nullptr, lds, ws + WS_H1Q); if (TW(5) && IN(5)) ln_phase<false, false, false>(R1, MIX, nullptr, args.in[2], args.in[3], R1, nullptr, nullptr, nullptr, nullptr, lds, ws + WS_H1Q);
    SEAM(5);
#define MOE_BLOCK(P, L, HIN) \
    if (IN(P)) { pg8::Gemm g{HIN, ws + WS_WR + (size_t)(L) * 256 * 2048, T, 256, 2048}; pg8::StaticOrder So; So.init(T, 256, G, (int)blockIdx.x); \
        if (G == 256) { pg8::EpiRouter E{args.in[17] + (L) * 32, TOKE, TOKG, TOKR, WGH}; pg8::gemm_phase(lds, g, So, E); } \
        else { pg8::EpiLogits E{LOGITS}; pg8::gemm_phase(lds, g, So, E); } } \
    if (G != 256) SEAM(P); \
    if (G != 256 && IN((P) + 1)) top4_phase(LOGITS, args.in[17] + (L) * 32, TOKE, TOKG, TOKR, WGH, lds); \
    SEAM((P) + 1); \
    if (IN((P) + 2)) assign_phase(WGH, TOKE, TOKG, TOKR, TOKS, SLOTG, SLOTT, TILETAB, lds); if (TW((P) + 2) && IN((P) + 2)) assign_phase(WGH, TOKE, TOKG, TOKR, TOKS, SLOTG, SLOTT, TILETAB, lds); \
    SEAM((P) + 2); \
    if (IN((P) + 3)) { LAS int* tab = (LAS int*)(lds + TAB_OFF); const int ntl = (int)__hip_atomic_load((unsigned*)TILETAB, RLX_AGENT); \
        for (int i = tid; i < NTILE_MAX; i += NTHR) tab[i] = (i < ntl) ? TILETAB[16 + i] : 0; __syncthreads(); \
        pg8::Gemm g{ws + WS_H1Q, ws + WS_W1 + (size_t)(L) * 32 * 2048 * 1024, NSLOT_MAX, 2048, 1024}; pg8::MoeOrder Mo{ntl, 8, G, (int)blockIdx.x, tab}; \
        pg8::EpiSwiglu E{(unsigned char*)ACT, (const float*)(ws + WS_B1P) + (size_t)(L) * 32 * 2048}; pg8::gemm_phase<pg8::EpiSwiglu, pg8::MoeOrder, true, true>(lds, g, Mo, E, SLOTT); } \
    SEAM((P) + 3); \
    if (IN((P) + 4)) { LAS int* tab = (LAS int*)(lds + TAB_OFF); const int ntl = (int)__hip_atomic_load((unsigned*)TILETAB, RLX_AGENT); \
        for (int i = tid; i < NTILE_MAX; i += NTHR) tab[i] = (i < ntl) ? TILETAB[16 + i] : 0; __syncthreads(); \
        pg8::Gemm g{ACT, ws + WS_W2 + (size_t)(L) * 32 * 1024 * 1024, NSLOT_MAX, 1024, 1024}; pg8::MoeOrder Mo{ntl, 4, G, (int)blockIdx.x, tab}; \
        pg8::EpiMoe2 E{(unsigned char*)YB, args.in[21] + (size_t)(L) * 32 * 1024, SLOTG, Y8_SCALE}; pg8::gemm_phase<pg8::EpiMoe2, pg8::MoeOrder, true>(lds, g, Mo, E); } \
    SEAM((P) + 4);
    MOE_BLOCK(6, 0, R1)
    if (IN(11)) ln_phase<false, true, true>(R1, YB, TOKS, args.in[4], args.in[5], R2, nullptr, (const float*)(ws + WS_GWT), args.in[12], GLOG, lds, ws + WS_H1Q); if (TW(11) && IN(11)) ln_phase<false, true, true>(R1, YB, TOKS, args.in[4], args.in[5], R2, nullptr, (const float*)(ws + WS_GWT), args.in[12], GLOG, lds, ws + WS_H1Q);
    SEAM(11);
    if (IN(12)) {
        { pg8::Gemm g{ws + WS_H1Q, ws + WS_WKV, T, 1536, 1024}; pg8::StaticOrder So; So.init(T, 1536, G, (int)blockIdx.x);
          pg8::EpiMixed8 E{ws + WS_KF, 768, 1.0f / pg8::W8_SCALE, 3, VF, 768, 1, 1.0f / pg8::W8_SCALE}; pg8::gemm_phase<pg8::EpiMixed8, pg8::StaticOrder, true>(lds, g, So, E); }
        { pg8::Gemm g{ws + WS_H1Q, ws + WS_WINB, T, 1024, 1024}; pg8::StaticOrder So; So.init(T, 1024, G, (int)blockIdx.x);
          pg8::EpiMixed8 E{ws + WS_Q8, 768, ATT_C2 * ATT_S8 / pg8::W8_SCALE, 3, PROJ, 1024, 0, 1.0f / pg8::W8_SCALE}; pg8::gemm_phase<pg8::EpiMixed8, pg8::StaticOrder, true>(lds, g, So, E); }
    }
    SEAM(12);
    if (IN(13)) { fox_mfma(ws + WS_Q8, ws + WS_KF, VF, GLOG, CAT, lds); memattn_mfma(PROJ, KVMEM, 512, CAT, lds); } if (TW(13) && IN(13)) { fox_mfma(ws + WS_Q8, ws + WS_KF, VF, GLOG, CAT, lds); memattn_mfma(PROJ, KVMEM, 512, CAT, lds); }
    SEAM(13);
    if (IN(14)) { pg8::Gemm g{CAT, ws + WS_WOUTB, T, 1024, 2048}; pg8::StaticOrder So; So.init(T, 1024, G, (int)blockIdx.x);
        pg8::EpiBf16 E{MIX, 1024, nullptr, 0, 0, 1.0f}; pg8::gemm_phase(lds, g, So, E); }
    SEAM(14);
    if (IN(15)) ln_phase<false, false, false>(R2, MIX, nullptr, args.in[2] + 1024, args.in[3] + 1024, R1, nullptr, nullptr, nullptr, nullptr, lds, ws + WS_H1Q); if (TW(15) && IN(15)) ln_phase<false, false, false>(R2, MIX, nullptr, args.in[2] + 1024, args.in[3] + 1024, R1, nullptr, nullptr, nullptr, nullptr, lds, ws + WS_H1Q);
    SEAM(15);
    MOE_BLOCK(16, 1, R1)
    if (IN(21)) ln_phase<false, true, false>(R1, YB, TOKS, args.in[4] + 1024, args.in[5] + 1024, nullptr, args.out, nullptr, nullptr, nullptr, lds); if (TW(21) && IN(21)) ln_phase<false, true, false>(R1, YB, TOKS, args.in[4] + 1024, args.in[5] + 1024, nullptr, args.out, nullptr, nullptr, nullptr, lds);
#undef IN
#undef SEAM
}

extern "C" void kernel_launch(void* const* d_in, const int* in_sizes, int n_in, void* d_out, int out_size, void* d_ws, size_t ws_size, hipStream_t stream) {
    static int grid = 0;
    if (grid == 0) {
        if (n_in != 22 || out_size != T * D || ws_size < WS_END) { fprintf(stderr, "kernel_launch: unexpected problem (n_in %d out %d ws %zu)\n", n_in, out_size, ws_size); grid = -1; return; }
        int dev = 0, cus = 0;
        if (hipGetDevice(&dev) != hipSuccess || hipDeviceGetAttribute(&cus, hipDeviceAttributeMultiprocessorCount, dev) != hipSuccess) { grid = -1; return; }
        if (hipFuncSetAttribute((const void*)fwd_kernel, hipFuncAttributeMaxDynamicSharedMemorySize, LDS_BYTES) != hipSuccess) { fprintf(stderr, "kernel_launch: hipFuncSetAttribute failed\n"); grid = -1; return; }
        int per_cu = 0;
        if (hipOccupancyMaxActiveBlocksPerMultiprocessor(&per_cu, (const void*)fwd_kernel, NTHR, LDS_BYTES) != hipSuccess || per_cu < 1) fprintf(stderr, "kernel_launch: occupancy query says %d\n", per_cu);
        (void)hipGetLastError();
        grid = cus;
    }
    if (grid < 0) return;
    if (hipMemsetAsync((char*)d_ws + WS_CTL, 0, CTL_ZERO_BYTES, stream) != hipSuccess) return;
    Args a{};
    for (int i = 0; i < 22; ++i) a.in[i] = (const float*)d_in[i];
    a.out = (float*)d_out; a.ws = (unsigned char*)d_ws;
#if MK_PER_PHASE
    for (int p = 0; p < NPH; ++p) { a.ph_lo = p; a.ph_hi = p + 1; hipLaunchKernelGGL(fwd_kernel, dim3(grid), dim3(NTHR), LDS_BYTES, stream, a); }
#else
    a.ph_lo = 0; a.ph_hi = NPH; hipLaunchKernelGGL(fwd_kernel, dim3(grid), dim3(NTHR), LDS_BYTES, stream, a);
#endif
}
```

```cpp
#include <hip/hip_runtime.h>
#include <cstdio>
#include <cstdint>

#ifndef MK_PER_PHASE
#define MK_PER_PHASE 0
#endif

#define LAS __attribute__((address_space(3)))
#define GAS __attribute__((address_space(1)))
typedef unsigned short bf16_t;
typedef short bf16x8 __attribute__((ext_vector_type(8)));
typedef float f32x4 __attribute__((ext_vector_type(4)));
typedef float f32x2 __attribute__((ext_vector_type(2)));
typedef unsigned u32x4 __attribute__((ext_vector_type(4)));
typedef unsigned u32x2 __attribute__((ext_vector_type(2)));

__device__ __forceinline__ unsigned cvt_pk_bf16(float lo, float hi) { unsigned r; asm volatile("v_cvt_pk_bf16_f32 %0, %1, %2" : "=v"(r) : "v"(lo), "v"(hi)); return r; }
__device__ __forceinline__ float bf_lo(unsigned w) { return __uint_as_float(w << 16); }
__device__ __forceinline__ float bf_hi(unsigned w) { return __uint_as_float(w & 0xffff0000u); }

namespace pg8 {
constexpr int BM = 256, BK = 64, HALF = 128, HTB = HALF * BK * 2, STAGE_BYTES = 8 * HTB, NXCD = 8, WGM = 8;
__host__ __device__ __forceinline__ int lds_byte(int r, int c) { const int st = (r >> 4) * 2 + (c >> 5), rr = r & 15, cc = c & 31, ob = rr * 64 + cc * 2; return st * 1024 + (ob ^ (((ob >> 9) & 1) << 5)); }
__host__ __device__ __forceinline__ void stage_rc(int b, int& R, int& C) { const int st = b / 1024, sb = b % 1024, swz = sb ^ (((sb >> 9) & 1) << 5); R = (st >> 1) * 16 + swz / 64; C = (st & 1) * 32 + (swz % 64) / 2; }
__host__ __device__ __forceinline__ int perm32(int rho) { const int n = rho >> 4, i = rho & 15; return 8 * (i >> 2) + 4 * n + (i & 3); }

struct Unit { int pm, pn, e; };
struct Gemm { const void* A; const void* Bt; int M, N, Kb; };

struct StaticOrder {
    int nM, nN, nwg, G, c;
    __device__ void init(int M, int N, int G_, int c_) { nM = M / BM; nN = N / BM; nwg = nM * nN; G = G_; c = c_; }
    __device__ bool next(int i, Unit& u) const {
        const long L = (long)i * G + c; if (L >= nwg) return false;
        int wgid = (int)L; { const int q = nwg / NXCD, r = nwg % NXCD, xcd = wgid % NXCD, off = wgid / NXCD; wgid = (xcd < r ? xcd * (q + 1) : r * (q + 1) + (xcd - r) * q) + off; }
        const int nig = WGM * nN, gid = wgid / nig, fm = gid * WGM, gsz = (nM - fm) < WGM ? (nM - fm) : WGM;
        u.pm = fm + ((wgid % nig) % gsz); u.pn = (wgid % nig) / gsz; u.e = 0; return true;
    }
};
struct MoeOrder {
    int n_tiles, nN, G, c; const LAS int* tab;
    __device__ bool next(int i, Unit& u) const {
        int rt, pn;
        if (G == 256) { const int x = c & 7, r = c >> 3, rpi = 32 / nN, tpx = (n_tiles + 7) >> 3, lt = rpi * i + r / nN;
            if (lt >= tpx) return false; rt = x * tpx + lt; pn = r % nN; }

        else { const long L = (long)i * G + c; rt = (int)(L / nN); pn = (int)(L % nN); }
        if (rt >= n_tiles) return false;
        u.pm = rt; u.pn = pn; u.e = __builtin_amdgcn_readfirstlane(tab[rt]); return true;
    }
};

struct EpiBf16 {
    static constexpr bool PERM = true, AFTER = false, ALIGN = false; static constexpr bool SKIP_B1 = false;
    struct Pre {}; __device__ __forceinline__ Pre preload(const Unit&, int, int, int, int) const { return Pre{}; } static constexpr int NPRE = 0; static constexpr bool HOISTOK = false; static __device__ __forceinline__ void touch(Pre&) {}
    __device__ __forceinline__ const float* stash_ptr(const Unit&, int) const { return nullptr; } __device__ __forceinline__ Pre from_stash(const LAS float*, int, int, int, int) const { return Pre{}; }
    bf16_t* O; int ldc; const float* colscale; int split_cols; size_t split_stride; float scale;
    __device__ __forceinline__ void operator()(const f32x4 (&acc)[2][2][4][2], const Unit& u, int wr, int wc, int fr, int fq, const Pre&) const {
        const int row0 = u.pm * BM + wr * 64 + fr; int colt = u.pn * BM; bf16_t* base = O;
        if (split_cols) { const int t = colt / split_cols; base += (size_t)t * split_stride; colt -= t * split_cols; }
        const int col0 = colt + wc * 32 + 8 * fq, scol0 = u.pn * BM + wc * 32 + 8 * fq;
        f32x4 sv[2][2];
#pragma unroll
        for (int bj = 0; bj < 2; ++bj)
#pragma unroll
            for (int n = 0; n < 2; ++n) sv[bj][n] = colscale ? *(const f32x4*)(colscale + scol0 + bj * HALF + 4 * n) * scale : (f32x4){scale, scale, scale, scale};
#pragma unroll
        for (int ai = 0; ai < 2; ++ai)
#pragma unroll
            for (int m = 0; m < 4; ++m) { bf16_t* rowp = base + (size_t)(row0 + ai * HALF + m * 16) * ldc + col0;
#pragma unroll
                for (int bj = 0; bj < 2; ++bj) { const f32x4 v0 = acc[ai][bj][m][0] * sv[bj][0], v1 = acc[ai][bj][m][1] * sv[bj][1];
                    u32x4 w; w.x = cvt_pk_bf16(v0[0], v0[1]); w.y = cvt_pk_bf16(v0[2], v0[3]); w.z = cvt_pk_bf16(v1[0], v1[1]); w.w = cvt_pk_bf16(v1[2], v1[3]);
                    *(u32x4*)(rowp + bj * HALF) = w; } }
    }
};
__device__ __forceinline__ unsigned pk_fp8x4(float a, float b, float c, float d) { int w = 0; w = __builtin_amdgcn_cvt_pk_fp8_f32(a, b, w, false); w = __builtin_amdgcn_cvt_pk_fp8_f32(c, d, w, true); return (unsigned)w; }
constexpr float W8_SCALE = 64.0f, ACT8_SCALE = 4.0f;
struct EpiMixed8 {
    static constexpr bool PERM = true, AFTER = false, ALIGN = false; static constexpr bool SKIP_B1 = false;
    struct Pre {}; __device__ __forceinline__ Pre preload(const Unit&, int, int, int, int) const { return Pre{}; } static constexpr int NPRE = 0; static constexpr bool HOISTOK = false; static __device__ __forceinline__ void touch(Pre&) {}
    __device__ __forceinline__ const float* stash_ptr(const Unit&, int) const { return nullptr; } __device__ __forceinline__ Pre from_stash(const LAS float*, int, int, int, int) const { return Pre{}; }
    unsigned char* O8; int ld8; float scale8; int ncut8; bf16_t* O16; int ld16; int rebase16; float scale16;
    __device__ __forceinline__ void operator()(const f32x4 (&acc)[2][2][4][2], const Unit& u, int wr, int wc, int fr, int fq, const Pre&) const {
        const int row0 = u.pm * BM + wr * 64 + fr;
        if (u.pn < ncut8) {
            const int col0 = u.pn * BM + wc * 32 + 8 * fq;
#pragma unroll
            for (int ai = 0; ai < 2; ++ai)
#pragma unroll
                for (int m = 0; m < 4; ++m) { unsigned char* rowp = O8 + (size_t)(row0 + ai * HALF + m * 16) * ld8 + col0;
#pragma unroll
                    for (int bj = 0; bj < 2; ++bj) { const f32x4 v0 = acc[ai][bj][m][0] * scale8, v1 = acc[ai][bj][m][1] * scale8;
                        u32x2 w; w.x = pk_fp8x4(v0[0], v0[1], v0[2], v0[3]); w.y = pk_fp8x4(v1[0], v1[1], v1[2], v1[3]); *(u32x2*)(rowp + bj * HALF) = w; } }
        } else {
            const int col0 = (u.pn - (rebase16 ? ncut8 : 0)) * BM + wc * 32 + 8 * fq;
#pragma unroll
            for (int ai = 0; ai < 2; ++ai)
#pragma unroll
                for (int m = 0; m < 4; ++m) { bf16_t* rowp = O16 + (size_t)(row0 + ai * HALF + m * 16) * ld16 + col0;
#pragma unroll
                    for (int bj = 0; bj < 2; ++bj) { const f32x4 v0 = acc[ai][bj][m][0] * scale16, v1 = acc[ai][bj][m][1] * scale16;
                        u32x4 w; w.x = cvt_pk_bf16(v0[0], v0[1]); w.y = cvt_pk_bf16(v0[2], v0[3]); w.z = cvt_pk_bf16(v1[0], v1[1]); w.w = cvt_pk_bf16(v1[2], v1[3]); *(u32x4*)(rowp + bj * HALF) = w; } }
        }
    }
};
struct EpiLogits {
    static constexpr bool PERM = false, AFTER = false, ALIGN = true; static constexpr bool SKIP_B1 = true;
    struct Pre {}; __device__ __forceinline__ Pre preload(const Unit&, int, int, int, int) const { return Pre{}; } static constexpr int NPRE = 0; static constexpr bool HOISTOK = false; static __device__ __forceinline__ void touch(Pre&) {}
    __device__ __forceinline__ const float* stash_ptr(const Unit&, int) const { return nullptr; } __device__ __forceinline__ Pre from_stash(const LAS float*, int, int, int, int) const { return Pre{}; }
    float* L;
    __device__ __forceinline__ void operator()(const f32x4 (&acc)[2][2][4][2], const Unit& u, int wr, int wc, int fr, int fq, const Pre&) const {
        if (wc > 1) return;
        const int row0 = u.pm * BM + wr * 64 + fr;
#pragma unroll
        for (int ai = 0; ai < 2; ++ai)
#pragma unroll
            for (int m = 0; m < 4; ++m) { float* rowp = L + (size_t)wc * 65536 * 32 + (size_t)(row0 + ai * HALF + m * 16) * 32 + 4 * fq;
#pragma unroll
                for (int n = 0; n < 2; ++n) *(f32x4*)(rowp + n * 16) = acc[ai][0][m][n]; }
    }
};
struct EpiRouter {
    static constexpr bool PERM = false, AFTER = true, ALIGN = true; static constexpr bool SKIP_B1 = true;
    struct Pre {}; __device__ __forceinline__ Pre preload(const Unit&, int, int, int, int) const { return Pre{}; } static constexpr int NPRE = 0; static constexpr bool HOISTOK = false; static __device__ __forceinline__ void touch(Pre&) {}
    __device__ __forceinline__ const float* stash_ptr(const Unit&, int) const { return nullptr; } __device__ __forceinline__ Pre from_stash(const LAS float*, int, int, int, int) const { return Pre{}; }
    const float* rb; int* tok_e; float* tok_g; int* tok_r; unsigned* wg_hist;
    __device__ __forceinline__ void operator()(const f32x4 (&)[2][2][4][2], const Unit&, int, int, int, int, const Pre&) const {}
    __device__ __forceinline__ void after(const f32x4 (&acc)[2][2][4][2], const Unit& u, int wr, int wc, int fr, int fq, LAS unsigned char* lds) const {
        LAS float* Lg = (LAS float*)lds;
        LAS unsigned* hist = (LAS unsigned*)(lds + 2 * 256 * 33 * 4);
        const int tid = threadIdx.x;
        if (wc < 2) {
#pragma unroll
            for (int ai = 0; ai < 2; ++ai)
#pragma unroll
                for (int m = 0; m < 4; ++m) { LAS float* rowp = Lg + wc * (256 * 33) + (ai * HALF + wr * 64 + m * 16 + fr) * 33 + 4 * fq;
#pragma unroll
                    for (int n = 0; n < 2; ++n) { const f32x4 v = acc[ai][0][m][n]; rowp[n * 16 + 0] = v[0]; rowp[n * 16 + 1] = v[1]; rowp[n * 16 + 2] = v[2]; rowp[n * 16 + 3] = v[3]; } }
        }
        if (tid < 32) hist[tid] = 0u;
        __syncthreads();
        if (tid < 256) {
            const int t = u.pm * BM + tid; const LAS float* lp = Lg + tid * 33;
            float lg[32];
#pragma unroll
            for (int e = 0; e < 32; ++e) lg[e] = (lp[e] + lp[256 * 33 + e]) + rb[e];
            unsigned used = 0u; int sel[4]; float val[4];
#pragma unroll
            for (int k = 0; k < 4; ++k) { float best = -INFINITY; int bi = 0;
#pragma unroll
                for (int e = 0; e < 32; ++e) { const float c = ((used >> e) & 1u) ? -INFINITY : lg[e]; if (c > best) { best = c; bi = e; } }
                sel[k] = bi; val[k] = best; used |= 1u << bi; }
            const float e1 = __expf(val[1] - val[0]), e2 = __expf(val[2] - val[0]), e3 = __expf(val[3] - val[0]); const float inv = 1.0f / (1.0f + e1 + e2 + e3);
            int rk[4];
#pragma unroll
            for (int k = 0; k < 4; ++k) rk[k] = (int)atomicAdd((unsigned*)(hist + sel[k]), 1u);
            *(int4*)(tok_e + (size_t)t * 4) = make_int4(sel[0], sel[1], sel[2], sel[3]);
            *(f32x4*)(tok_g + (size_t)t * 4) = (f32x4){inv, e1 * inv, e2 * inv, e3 * inv};
            *(int4*)(tok_r + (size_t)t * 4) = make_int4(rk[0], rk[1], rk[2], rk[3]);
        }
        __syncthreads();
        if (tid < 32) wg_hist[u.pm * 32 + tid] = hist[tid];
    }
};
struct EpiSwiglu {
    static constexpr bool PERM = true, AFTER = false, ALIGN = true; static constexpr bool SKIP_B1 = false;
    unsigned char* O; const float* b1p;
    struct Pre { f32x4 bg[2], bl[2]; }; static constexpr bool HOISTOK = true; static constexpr int NPRE = 4;
    __device__ __forceinline__ const float* stash_ptr(const Unit& u, int tid) const { return b1p + (size_t)u.e * 2048 + u.pn * BM + (tid & 255); }
    __device__ __forceinline__ Pre from_stash(const LAS float* st, int wr, int wc, int fr, int fq) const { Pre p; const LAS float* bp = st + wc * 32 + 8 * fq;
        p.bg[0] = *(const LAS f32x4*)bp; p.bg[1] = *(const LAS f32x4*)(bp + 4); p.bl[0] = *(const LAS f32x4*)(bp + HALF); p.bl[1] = *(const LAS f32x4*)(bp + HALF + 4); return p; }
    static __device__ __forceinline__ void touch(Pre& p) { asm volatile("" : "+v"(p.bg[0]), "+v"(p.bg[1]), "+v"(p.bl[0]), "+v"(p.bl[1])); }
    __device__ __forceinline__ Pre preload(const Unit& u, int wr, int wc, int fr, int fq) const {
        Pre p; const float* bp = b1p + (size_t)u.e * 2048 + u.pn * BM + wc * 32 + 8 * fq;
#pragma unroll
        for (int n = 0; n < 2; ++n) { p.bg[n] = *(const f32x4*)(bp + 4 * n); p.bl[n] = *(const f32x4*)(bp + HALF + 4 * n); }
        return p; }
    __device__ __forceinline__ void operator()(const f32x4 (&acc)[2][2][4][2], const Unit& u, int wr, int wc, int fr, int fq, const Pre& pre) const {
        const int row0 = u.pm * BM + wr * 64 + fr, ocol0 = u.pn * HALF + wc * 32 + 8 * fq;
#pragma unroll
        for (int ai = 0; ai < 2; ++ai)
#pragma unroll
            for (int m = 0; m < 4; ++m) { unsigned char* rowp = O + (size_t)(row0 + ai * HALF + m * 16) * 1024 + ocol0; float r[8];
#pragma unroll
                for (int n = 0; n < 2; ++n) { const f32x4 g = acc[ai][0][m][n] * (1.0f / W8_SCALE) + pre.bg[n], l = acc[ai][1][m][n] * (1.0f / W8_SCALE) + pre.bl[n];
#pragma unroll
                    for (int j = 0; j < 4; j += 2) {
                        const f32x2 xg = {fminf(g[j], 7.0f), fminf(g[j + 1], 7.0f)}, xl = {__builtin_amdgcn_fmed3f(l[j], -7.0f, 7.0f), __builtin_amdgcn_fmed3f(l[j + 1], -7.0f, 7.0f)};
                        const f32x2 t = xg * (-1.702f * 1.4426950408889634f);
                        const f32x2 d = (f32x2){__builtin_amdgcn_exp2f(t[0]), __builtin_amdgcn_exp2f(t[1])} + 1.0f;
                        const f32x2 sg = {__builtin_amdgcn_rcpf(d[0]), __builtin_amdgcn_rcpf(d[1])};
                        const f32x2 o = (xg * sg) * (xl * ACT8_SCALE + ACT8_SCALE);
                        r[4 * n + j] = o[0]; r[4 * n + j + 1] = o[1]; } }
                u32x2 w; w.x = pk_fp8x4(r[0], r[1], r[2], r[3]); w.y = pk_fp8x4(r[4], r[5], r[6], r[7]);
                *(u32x2*)rowp = w; }
    }
};
struct EpiMoe2 {
    static constexpr bool PERM = true, AFTER = false, ALIGN = true; static constexpr bool SKIP_B1 = false;
    unsigned char* O; const float* b2; const float* gate; float yscale;
    struct Pre { f32x4 bv[2][2]; float gts[2][4]; }; static constexpr bool HOISTOK = true; static constexpr int NPRE = 12;
    __device__ __forceinline__ const float* stash_ptr(const Unit& u, int tid) const { return tid < 256 ? gate + u.pm * BM + tid : b2 + (size_t)u.e * 1024 + u.pn * BM + (tid - 256); }
    __device__ __forceinline__ Pre from_stash(const LAS float* st, int wr, int wc, int fr, int fq) const { Pre p; const LAS float* bp = st + 256 + wc * 32 + 8 * fq;
#pragma unroll
        for (int bj = 0; bj < 2; ++bj) { p.bv[bj][0] = *(const LAS f32x4*)(bp + bj * HALF); p.bv[bj][1] = *(const LAS f32x4*)(bp + bj * HALF + 4); }
#pragma unroll
        for (int ai = 0; ai < 2; ++ai)
#pragma unroll
            for (int m = 0; m < 4; ++m) p.gts[ai][m] = st[ai * HALF + wr * 64 + m * 16 + fr];
        return p; }

    static __device__ __forceinline__ void touch(Pre& p) { asm volatile("" : "+v"(p.bv[0][0]), "+v"(p.bv[0][1]), "+v"(p.bv[1][0]), "+v"(p.bv[1][1]));
        asm volatile("" : "+v"(p.gts[0][0]), "+v"(p.gts[0][1]), "+v"(p.gts[0][2]), "+v"(p.gts[0][3]), "+v"(p.gts[1][0]), "+v"(p.gts[1][1]), "+v"(p.gts[1][2]), "+v"(p.gts[1][3])); }
    __device__ __forceinline__ Pre preload(const Unit& u, int wr, int wc, int fr, int fq) const {
        Pre p; const int row0 = u.pm * BM + wr * 64 + fr; const float* bp = b2 + (size_t)u.e * 1024 + u.pn * BM + wc * 32 + 8 * fq;
#pragma unroll
        for (int bj = 0; bj < 2; ++bj)
#pragma unroll
            for (int n = 0; n < 2; ++n) p.bv[bj][n] = *(const f32x4*)(bp + bj * HALF + 4 * n);
#pragma unroll
        for (int ai = 0; ai < 2; ++ai)
#pragma unroll
            for (int m = 0; m < 4; ++m) p.gts[ai][m] = gate[row0 + ai * HALF + m * 16];
        return p; }
    __device__ __forceinline__ void operator()(const f32x4 (&acc)[2][2][4][2], const Unit& u, int wr, int wc, int fr, int fq, const Pre& pre) const {
        const int row0 = u.pm * BM + wr * 64 + fr, col0 = u.pn * BM + wc * 32 + 8 * fq;
#pragma unroll
        for (int ai = 0; ai < 2; ++ai)
#pragma unroll
            for (int m = 0; m < 4; ++m) { const int row = row0 + ai * HALF + m * 16; const float gt = pre.gts[ai][m] * yscale; unsigned char* rowp = O + (size_t)row * 1024 + col0;
#pragma unroll
                for (int bj = 0; bj < 2; ++bj) { const f32x4 v0 = (acc[ai][bj][m][0] * (1.0f / (W8_SCALE * ACT8_SCALE)) + pre.bv[bj][0]) * gt, v1 = (acc[ai][bj][m][1] * (1.0f / (W8_SCALE * ACT8_SCALE)) + pre.bv[bj][1]) * gt;
#define Y8C(x) __builtin_amdgcn_fmed3f((x), -448.0f, 448.0f)
                    u32x2 w; w.x = pk_fp8x4(Y8C(v0[0]), Y8C(v0[1]), Y8C(v0[2]), Y8C(v0[3])); w.y = pk_fp8x4(Y8C(v1[0]), Y8C(v1[1]), Y8C(v1[2]), Y8C(v1[3]));
#undef Y8C
                    *(u32x2*)(rowp + bj * HALF) = w; } }
    }
};

#ifndef F8_SCALE
#define F8_SCALE 0
#endif
constexpr int STASH_OFF = 8 * HTB + 4608 + 128;
typedef int i32x8 __attribute__((ext_vector_type(8)));
typedef int i32x4 __attribute__((ext_vector_type(4)));
__device__ __forceinline__ i32x8 cat8(bf16x8 a, bf16x8 b) { const i32x4 x = __builtin_bit_cast(i32x4, a), y = __builtin_bit_cast(i32x4, b); return __builtin_shufflevector(x, y, 0, 1, 2, 3, 4, 5, 6, 7); }
template <class Epi, class Sched, bool F8 = false, bool GATHER = false>
__device__ __forceinline__ void gemm_phase(LAS unsigned char* lds, const Gemm g, const Sched& S, const Epi& E, const int* rowidx = nullptr) {
    const int tid = threadIdx.x, wid = __builtin_amdgcn_readfirstlane(tid >> 6), lane = tid & 63, wr = wid >> 2, wc = wid & 3, fr = lane & 15, fq = lane >> 4;
    const int Kb = g.Kb, nt = Kb / (BK * 2);
    int Ri[2], Ci2[2]; unsigned voffB[2];
#pragma unroll
    for (int i = 0; i < 2; ++i) { int R, C; stage_rc(tid * 16 + i * 8192, R, C); const int Rb = Epi::PERM ? ((R & ~31) + perm32(R & 31)) : R;
        Ri[i] = R; Ci2[i] = C * 2; voffB[i] = (unsigned)(Rb * Kb + C * 2); }
    const size_t kstep = (size_t)(BK * 2);
    const size_t hstep = (size_t)HALF * Kb;
    const size_t tstep = 2 * hstep;
    const size_t estep = (size_t)g.N * Kb;
    const unsigned ldsw = (unsigned)wid * 1024u;
    const int aoff = lds_byte(wr * 64 + fr, fq * 8), boff = lds_byte(wc * 32 + fr, fq * 8);
#define PG8_SA(b, h) (((b) * 2 + (h)) * HTB)
#define PG8_SB(b, h) ((4 + (b) * 2 + (h)) * HTB)
#define PG8_STAGE(bufoff, gbase, voff) do { _Pragma("unroll") for (int _i = 0; _i < 2; ++_i) \
        __builtin_amdgcn_global_load_lds((const unsigned*)((const char*)(gbase) + (voff)[_i]), (LAS unsigned*)(lds + (bufoff) + ldsw + _i * 8192), 16, 0, 0); } while (0)
#define PG8_LDA(dst, b, h) do { _Pragma("unroll") for (int m = 0; m < 4; ++m) _Pragma("unroll") for (int k = 0; k < 2; ++k) dst[m][k] = *(const LAS bf16x8*)(lds + PG8_SA(b, h) + aoff + m * 2048 + k * 1024); } while (0)
#define PG8_LDB(dst, b, h) do { _Pragma("unroll") for (int n = 0; n < 2; ++n) _Pragma("unroll") for (int k = 0; k < 2; ++k) dst[n][k] = *(const LAS bf16x8*)(lds + PG8_SB(b, h) + boff + n * 2048 + k * 1024); } while (0)
#define PG8_MMA(ai, bj, At, Bt) do { __builtin_amdgcn_s_setprio(1); _Pragma("unroll") for (int m = 0; m < 4; ++m) _Pragma("unroll") for (int n = 0; n < 2; ++n) { \
        if constexpr (F8) { const i32x8 b8_ = cat8(Bt[n][0], Bt[n][1]), a8_ = cat8(At[m][0], At[m][1]); \
            asm volatile("v_mfma_f32_16x16x128_f8f6f4 %0, %1, %2, %0" : "+v"(acc[ai][bj][m][n]) : "v"(b8_), "v"(a8_)); }   \
        else { _Pragma("unroll") for (int k = 0; k < 2; ++k) acc[ai][bj][m][n] = __builtin_amdgcn_mfma_f32_16x16x32_bf16(Bt[n][k], At[m][k], acc[ai][bj][m][n], 0, 0, 0); } } \
        __builtin_amdgcn_s_setprio(0); } while (0)
#define PG8_WAIT_V_(n) asm volatile("s_waitcnt vmcnt(" #n ")" ::: "memory")
#define PG8_WAIT_V(n) PG8_WAIT_V_(n)
#define PG8_WAIT_L(n) asm volatile("s_waitcnt lgkmcnt(" #n ")" ::: "memory")
#define PG8_BAR __builtin_amdgcn_s_barrier()
#define PG8_SCHED __builtin_amdgcn_sched_barrier(0)
#define PG8_AOFF(dst, u) do { _Pragma("unroll") for (int h_ = 0; h_ < 2; ++h_) _Pragma("unroll") for (int i_ = 0; i_ < 2; ++i_) { const int r_ = (u).pm * BM + h_ * HALF + Ri[i_]; \
        dst[h_][i_] = (unsigned)(GATHER ? rowidx[r_] : r_) * (unsigned)Kb + (unsigned)Ci2[i_]; } } while (0)
    Unit cur, nxt, nn; int ui = 0; bool has_nn = false;
    typename Epi::Pre pre{}; unsigned offNN[2][2] = {{0u, 0u}, {0u, 0u}}; float stash_v = 0.f;
    if (!S.next(0, cur)) return;
    bool has_next = S.next(1, nxt);
    unsigned offC[2][2], offN[2][2];
    PG8_AOFF(offC, cur);
    if (has_next) PG8_AOFF(offN, nxt); else PG8_AOFF(offN, cur);
    f32x4 acc[2][2][4][2];
#pragma unroll
    for (int a = 0; a < 2; ++a)
#pragma unroll
        for (int b = 0; b < 2; ++b)
#pragma unroll
            for (int m = 0; m < 4; ++m)
#pragma unroll
                for (int n = 0; n < 2; ++n) acc[a][b][m][n] = (f32x4){0.f, 0.f, 0.f, 0.f};
    bf16x8 At[4][2], B0[2][2], B1[2][2];
    const char* const gA = (const char*)g.A;
    const char* cB = (const char*)g.Bt + (size_t)cur.e * estep + (size_t)cur.pn * tstep;
    PG8_STAGE(PG8_SB(0, 0), cB, voffB); PG8_STAGE(PG8_SB(0, 1), cB + hstep, voffB); PG8_STAGE(PG8_SA(0, 0), gA, offC[0]); PG8_STAGE(PG8_SA(0, 1), gA, offC[1]);
    if (wr == 1) PG8_BAR;
    PG8_WAIT_V(2); PG8_BAR;
    PG8_STAGE(PG8_SB(1, 0), cB + kstep, voffB); PG8_STAGE(PG8_SA(1, 0), gA + kstep, offC[0]); PG8_STAGE(PG8_SB(1, 1), cB + hstep + kstep, voffB);
    PG8_WAIT_V(6); PG8_BAR;
    for (;;) {
        const char* nB = has_next ? (const char*)g.Bt + (size_t)nxt.e * estep + (size_t)nxt.pn * tstep : cB;
#pragma nounroll
        for (int t = 0; t < nt; t += 2) {
            const bool last = (t == nt - 2);
            const char* a1 = gA + (size_t)(t + 1) * kstep;
            const char* a2 = last ? gA : gA + (size_t)(t + 2) * kstep; const char* b2 = last ? nB : cB + (size_t)(t + 2) * kstep;
            const char* a3 = a2 + kstep; const char* b3 = b2 + kstep;
            unsigned o2[2][2];
#pragma unroll
            for (int h = 0; h < 2; ++h)
#pragma unroll
                for (int i = 0; i < 2; ++i) o2[h][i] = last ? offN[h][i] : offC[h][i];
            constexpr int HOIST = Epi::HOISTOK ? 1 + (GATHER ? 4 : 0) : 0;
#define PG8_WAIT_H() do { if (HOIST > 0 && last) { if constexpr (HOIST == 5) PG8_WAIT_V(13); else if constexpr (HOIST == 1) PG8_WAIT_V(9); else PG8_WAIT_V(8); } else PG8_WAIT_V(8); } while (0)
            static_assert(HOIST == 0 || HOIST == 1 || HOIST == 5, "add the matching wait count");
            PG8_LDB(B0, 0, 0); if constexpr (!Epi::SKIP_B1) PG8_LDB(B1, 0, 1); PG8_SCHED; PG8_LDA(At, 0, 0); PG8_STAGE(PG8_SA(1, 1), a1, offC[1]);
            if (HOIST > 0 && last) { PG8_SCHED;
                { const float* sp_ = E.stash_ptr(cur, tid); asm volatile("global_load_dword %0, %1, off" : "=v"(stash_v) : "v"(sp_) : "memory"); }
                has_nn = has_next && S.next(ui + 2, nn);
                if constexpr (GATHER) { const int pmn = has_nn ? nn.pm : cur.pm;
#pragma unroll
                    for (int h_ = 0; h_ < 2; ++h_)
#pragma unroll
                        for (int i_ = 0; i_ < 2; ++i_) { const int* ip_ = rowidx + (pmn * BM + h_ * HALF + Ri[i_]); asm volatile("global_load_dword %0, %1, off" : "=v"(offNN[h_][i_]) : "v"(ip_) : "memory"); } }
                else { if (has_nn) PG8_AOFF(offNN, nn); else PG8_AOFF(offNN, cur); }
                PG8_SCHED; }
            PG8_WAIT_H(); PG8_WAIT_L(0); PG8_BAR; PG8_MMA(0, 0, At, B0); if constexpr (!Epi::SKIP_B1) PG8_MMA(0, 1, At, B1); PG8_BAR; PG8_SCHED;
            PG8_LDA(At, 0, 1); PG8_STAGE(PG8_SB(0, 0), b2, voffB); PG8_STAGE(PG8_SB(0, 1), b2 + hstep, voffB); PG8_STAGE(PG8_SA(0, 0), a2, o2[0]);
            PG8_WAIT_H(); PG8_WAIT_L(0); PG8_BAR; PG8_MMA(1, 0, At, B0); if constexpr (!Epi::SKIP_B1) PG8_MMA(1, 1, At, B1); PG8_BAR; PG8_SCHED;
            PG8_LDB(B0, 1, 0); if constexpr (!Epi::SKIP_B1) PG8_LDB(B1, 1, 1); PG8_SCHED; PG8_LDA(At, 1, 0); PG8_STAGE(PG8_SA(0, 1), a2, o2[1]);
            PG8_WAIT_V(8);
            if (HOIST > 0 && last) { ((LAS float*)(lds + STASH_OFF))[tid] = stash_v;
                if constexpr (GATHER) {
#pragma unroll
                    for (int h_ = 0; h_ < 2; ++h_)
#pragma unroll
                        for (int i_ = 0; i_ < 2; ++i_) offNN[h_][i_] = offNN[h_][i_] * (unsigned)Kb + (unsigned)Ci2[i_]; } }
            PG8_WAIT_L(0); PG8_BAR; PG8_MMA(0, 0, At, B0); if constexpr (!Epi::SKIP_B1) PG8_MMA(0, 1, At, B1); PG8_BAR; PG8_SCHED;
            PG8_LDA(At, 1, 1); PG8_STAGE(PG8_SB(1, 0), b3, voffB); PG8_STAGE(PG8_SB(1, 1), b3 + hstep, voffB); PG8_STAGE(PG8_SA(1, 0), a3, o2[0]);
            PG8_WAIT_V(8); PG8_WAIT_L(0); PG8_BAR; PG8_MMA(1, 0, At, B0); if constexpr (!Epi::SKIP_B1) PG8_MMA(1, 1, At, B1); PG8_BAR; PG8_SCHED;
#undef PG8_WAIT_H
        }
        if constexpr (Epi::ALIGN) { if (wr == 0) PG8_BAR; }
        if constexpr (F8) asm volatile("s_nop 7\n\ts_nop 7\n\ts_nop 7" ::: "memory");
        if constexpr (!Epi::HOISTOK) {
            has_nn = has_next && S.next(ui + 2, nn);
            pre = E.preload(cur, wr, wc, fr, fq);
            if (has_nn) PG8_AOFF(offNN, nn); else PG8_AOFF(offNN, cur);
            if constexpr (GATHER) asm volatile("" : "+v"(offNN[0][0]), "+v"(offNN[0][1]), "+v"(offNN[1][0]), "+v"(offNN[1][1])); }
        if constexpr (Epi::HOISTOK) pre = E.from_stash((const LAS float*)(lds + STASH_OFF), wr, wc, fr, fq);
        E(acc, cur, wr, wc, fr, fq, pre);
        if (!has_next) break;
#pragma unroll
        for (int a = 0; a < 2; ++a)
#pragma unroll
            for (int b = 0; b < 2; ++b)
#pragma unroll
                for (int m = 0; m < 4; ++m)
#pragma unroll
                    for (int n = 0; n < 2; ++n) acc[a][b][m][n] = (f32x4){0.f, 0.f, 0.f, 0.f};
#pragma unroll
        for (int h = 0; h < 2; ++h)
#pragma unroll
            for (int i = 0; i < 2; ++i) { offC[h][i] = offN[h][i]; if (has_nn) offN[h][i] = offNN[h][i]; }
        cur = nxt; cB = nB; nxt = nn; has_next = has_nn; ++ui;
        if constexpr (Epi::ALIGN) { if (wr == 1) PG8_BAR; }
    }
    PG8_WAIT_V(0);
    if constexpr (!Epi::ALIGN) { if (wr == 0) PG8_BAR; }
    PG8_BAR;
    if constexpr (Epi::AFTER) E.after(acc, cur, wr, wc, fr, fq, lds);
#undef PG8_SA
#undef PG8_SB
#undef PG8_STAGE
#undef PG8_LDA
#undef PG8_LDB
#undef PG8_MMA
#undef PG8_WAIT_V
#undef PG8_WAIT_V_
#undef PG8_WAIT_L
#undef PG8_BAR
#undef PG8_SCHED
#undef PG8_AOFF
}
}

constexpr int NWAVES = 8, NTHR = 512;
constexpr int T = 65536, D = 1024, NB = 32, S = 2048, MEMT = 256;
constexpr int NE = 32, TOPK = 4;
constexpr int NSLOT_MAX = T * TOPK + NE * 256;
constexpr int NTILE_MAX = NSLOT_MAX / 256;
constexpr int NCHUNK = T / 256;
constexpr float LN_EPS = 1e-5f;
constexpr float DN_ALPHA = 1.4142135623730951f;
constexpr int NPH = 22;

constexpr size_t MiB = 1u << 20;
constexpr size_t WS_CTL = 0, CTL_ZERO_BYTES = 1 * MiB;
constexpr size_t WS_WGHIST = 1 * MiB;
constexpr size_t WS_TILETAB = 1 * MiB + 256 * 1024;
constexpr size_t WS_B1P = 1 * MiB + 512 * 1024;
constexpr size_t WS_GWT = 2 * MiB;
constexpr size_t WS_TOKE = 3 * MiB, WS_TOKG = 4 * MiB, WS_TOKR = 5 * MiB, WS_TOKS = 6 * MiB;
constexpr size_t WS_SLOTG = 7 * MiB, WS_SLOTT = 9 * MiB;
constexpr size_t WS_GLOG = 11 * MiB;
constexpr size_t WS_LOGITS = 16 * MiB;
constexpr size_t WS_WINA = 32 * MiB, WS_WOUTA = 34 * MiB, WS_WINB = 36 * MiB, WS_WOUTB = 38 * MiB, WS_WMKV = 40 * MiB, WS_WKV = 42 * MiB, WS_WPOOL = 45 * MiB, WS_WR = 47 * MiB;
constexpr size_t WS_MEMB = 48 * MiB, WS_KVMEM = 64 * MiB;
constexpr size_t WS_W1 = 80 * MiB, WS_W2 = 336 * MiB;
constexpr size_t WS_R1 = 464 * MiB, WS_R2 = 592 * MiB;
constexpr size_t WS_ACT = 720 * MiB, WS_Y = 1248 * MiB, WS_H1Q = 1776 * MiB, WS_END = 1840 * MiB;
constexpr size_t WS_PROJ = 720 * MiB, WS_CAT = 848 * MiB, WS_MIX = 976 * MiB, WS_DBUF = 1104 * MiB, WS_KF = 1200 * MiB  , WS_Q8 = 1248 * MiB  , WS_VF = 1296 * MiB;
static_assert(WS_ACT + (size_t)NSLOT_MAX * 2048 <= WS_Y && WS_Y + (size_t)NSLOT_MAX * 2048 <= WS_END, "ws map");
constexpr int CW_BAR = 4096;

constexpr int RING_BYTES = 131072;
constexpr int TAB_OFF = RING_BYTES;
constexpr int MISC_OFF = TAB_OFF + 4608;
constexpr int LDS_BYTES = 147456;
static_assert(MISC_OFF + 128 == pg8::STASH_OFF && pg8::STASH_OFF + 2048 <= LDS_BYTES, "LDS map");

#define RLX_AGENT __ATOMIC_RELAXED, __HIP_MEMORY_SCOPE_AGENT
#define LDS_WAIT() asm volatile("s_waitcnt lgkmcnt(0)" ::: "memory")
#define VM_WAIT() asm volatile("s_waitcnt vmcnt(0)" ::: "memory")

#define XB_TMO      128
#define XB_XCNT(j)  (256  + 64 * (j))
#define XB_XSUB(j)  (1280 + 64 * (j))
#define XB_XGEN(j)  (2304 + 64 * (j))
#define XB_TOP      3328
#define XB_TOPGEN   3392
#define XCD_BAR_WORDS 3456
#define XB_SPIN_CAP (1u << 18)
__device__ __forceinline__ unsigned xb_ld(unsigned* p)              { return __hip_atomic_load(p, __ATOMIC_RELAXED, __HIP_MEMORY_SCOPE_AGENT); }
__device__ __forceinline__ unsigned xb_add(unsigned* p, unsigned v) { return __hip_atomic_fetch_add(p, v, __ATOMIC_RELAXED, __HIP_MEMORY_SCOPE_AGENT); }
__device__ __forceinline__ unsigned xb_xcc_id() { return (unsigned)__builtin_amdgcn_s_getreg((3 << 11) | 20) & 0xFu; }
#define XB_SPIN(cond, bar) do { unsigned _sp = 0; while (cond) { __builtin_amdgcn_s_sleep(1); \
    if ((++_sp & 255u) == 0u) { if (xb_ld(&(bar)[XB_TMO])) break; if (_sp > XB_SPIN_CAP) { atomicAdd(&(bar)[XB_TMO], 1u); break; } } } } while (0)
struct XcdBarrier { unsigned* bar; unsigned x; volatile LAS unsigned* st; };
__device__ __forceinline__ XcdBarrier xcd_barrier_post(unsigned* bar, volatile LAS unsigned* st) {
    XcdBarrier b; b.bar = bar; b.x = xb_xcc_id(); b.st = st;
    if (threadIdx.x == 0) (void)xb_add(&bar[XB_XCNT(b.x)], 1u);
    return b;
}
__device__ __forceinline__ void xcd_barrier_complete(unsigned* bar, unsigned x, unsigned& nloc, unsigned& nx) {
    const unsigned G = gridDim.x * gridDim.y * gridDim.z;
    unsigned sum, cnt, mine, sp = 0u;
    for (;;) {
        sum = 0u; cnt = 0u; mine = 0u;
#pragma unroll
        for (unsigned j = 0; j < 16; ++j) { const unsigned c = xb_ld(&bar[XB_XCNT(j)]); sum += c; cnt += (c > 0u) ? 1u : 0u; mine = (j == x) ? c : mine; }
        if (sum == G) break;
        __builtin_amdgcn_s_sleep(1);
        if ((++sp & 255u) == 0u) { if (xb_ld(&bar[XB_TMO])) break; if (sp > XB_SPIN_CAP) { atomicAdd(&bar[XB_TMO], 1u); break; } }
    }
    nloc = mine > 0u ? mine : 1u; nx = cnt > 0u ? cnt : 1u;
}
__device__ __forceinline__ void xcd_barrier(const XcdBarrier& b) {
    asm volatile("s_waitcnt vmcnt(0)" ::: "memory");
    __syncthreads();
    if (threadIdx.x == 0) {
        unsigned* bar = b.bar;
        __builtin_amdgcn_s_waitcnt(0);
        unsigned nloc = b.st[0], nx = b.st[1];
        if (nloc == 0u) { xcd_barrier_complete(bar, b.x, nloc, nx); b.st[0] = nloc; b.st[1] = nx; }
        const unsigned old = xb_add(&bar[XB_XSUB(b.x)], 1u);
        const unsigned gen = old / nloc;
        if (old + 1u == (gen + 1u) * nloc) {
            __builtin_amdgcn_fence(__ATOMIC_RELEASE, "agent");
            asm volatile("s_waitcnt vmcnt(0)" ::: "memory");
            const unsigned og = xb_add(&bar[XB_TOP], 1u);
            const unsigned tg = og / nx;
            if (og + 1u == (tg + 1u) * nx) xb_add(&bar[XB_TOPGEN], 1u);
            else XB_SPIN(xb_ld(&bar[XB_TOPGEN]) == tg, bar);
            __builtin_amdgcn_fence(__ATOMIC_ACQUIRE, "agent");
            xb_add(&bar[XB_XGEN(b.x)], 1u);
            asm volatile("s_waitcnt vmcnt(0)" ::: "memory");
        } else {
            XB_SPIN(xb_ld(&bar[XB_XGEN(b.x)]) == gen, bar);
            __builtin_amdgcn_fence(__ATOMIC_ACQUIRE, "agent");
            asm volatile("s_waitcnt vmcnt(0)" ::: "memory");
        }
    }
    __syncthreads();
}

__device__ __forceinline__ float wave_sum(float v) {
#define WS_DPP(x, ctrl) __int_as_float(__builtin_amdgcn_update_dpp(0, __float_as_int(x), (ctrl), 0xf, 0xf, false))
    v += WS_DPP(v, 0x128); v += WS_DPP(v, 0x124); v += WS_DPP(v, 0x122); v += WS_DPP(v, 0x121);
#undef WS_DPP
    { const auto rr = __builtin_amdgcn_permlane16_swap(__float_as_uint(v), __float_as_uint(v), false, false); v = __uint_as_float(rr[0]) + __uint_as_float(rr[1]); }
    { const auto rr = __builtin_amdgcn_permlane32_swap(__float_as_uint(v), __float_as_uint(v), false, false); v = __uint_as_float(rr[0]) + __uint_as_float(rr[1]); }
    return v;
}

template <int MODE>
__device__ __forceinline__ void tr_item(const float* W, int ldn, bf16_t* WT, int dld, int row_off, int col_off, LAS float* scr, int k0, int n0, int lane) {
    {
        f32x4 t[8];
#pragma unroll
        for (int i = 0; i < 8; ++i) t[i] = *(const f32x4*)(W + (size_t)(k0 + 8 * i + (lane >> 3)) * ldn + n0 + 4 * (lane & 7));
#pragma unroll
        for (int i = 0; i < 8; ++i) { LAS float* d = scr + (8 * i + (lane >> 3)) * 33 + 4 * (lane & 7); d[0] = t[i][0]; d[1] = t[i][1]; d[2] = t[i][2]; d[3] = t[i][3]; }
    }
    LDS_WAIT(); asm volatile("" ::: "memory");
    const int c = lane & 7;
#pragma unroll
    for (int j = 0; j < 4; ++j) { const int n = (lane >> 3) + 8 * j; const LAS float* s = scr + (8 * c) * 33 + n;
        float f[8];
#pragma unroll
        for (int q = 0; q < 8; ++q) f[q] = s[q * 33];
        u32x4 o; o.x = cvt_pk_bf16(f[0], f[1]); o.y = cvt_pk_bf16(f[2], f[3]); o.z = cvt_pk_bf16(f[4], f[5]); o.w = cvt_pk_bf16(f[6], f[7]);
        const int nn = n0 + n;
        const int drow = (MODE == 1) ? ((nn & ~255) + 128 * (nn & 1) + ((nn & 255) >> 1)) : (row_off + nn);
        *(u32x4*)(WT + (size_t)drow * dld + col_off + k0 + 8 * c) = o;
        if (MODE == 2) {
            u32x4 l; l.x = cvt_pk_bf16(f[0] - bf_lo(o.x), f[1] - bf_hi(o.x)); l.y = cvt_pk_bf16(f[2] - bf_lo(o.y), f[3] - bf_hi(o.y));
            l.z = cvt_pk_bf16(f[4] - bf_lo(o.z), f[5] - bf_hi(o.z)); l.w = cvt_pk_bf16(f[6] - bf_lo(o.w), f[7] - bf_hi(o.w));
            *(u32x4*)(WT + (size_t)(drow + 32) * dld + col_off + k0 + 8 * c) = l;
        }
    }
    LDS_WAIT(); asm volatile("" ::: "memory");
}

template <bool PERMW>
__device__ __forceinline__ void tr_item8(const float* W, int ldn, unsigned char* WT, int dld, LAS float* scr, int k0, int n0, int lane) {
    {
        f32x4 t[8];
#pragma unroll
        for (int i = 0; i < 8; ++i) t[i] = *(const f32x4*)(W + (size_t)(k0 + 8 * i + (lane >> 3)) * ldn + n0 + 4 * (lane & 7));
#pragma unroll
        for (int i = 0; i < 8; ++i) { LAS float* d = scr + (8 * i + (lane >> 3)) * 33 + 4 * (lane & 7); d[0] = t[i][0]; d[1] = t[i][1]; d[2] = t[i][2]; d[3] = t[i][3]; }
    }
    LDS_WAIT(); asm volatile("" ::: "memory");
    const int c = lane & 3;
#pragma unroll
    for (int j = 0; j < 2; ++j) { const int n = (lane >> 2) + 16 * j; const LAS float* s = scr + (16 * c) * 33 + n;
        float f[16];
#pragma unroll
        for (int q = 0; q < 16; ++q) f[q] = s[q * 33] * pg8::W8_SCALE;
        u32x4 o; o.x = pg8::pk_fp8x4(f[0], f[1], f[2], f[3]); o.y = pg8::pk_fp8x4(f[4], f[5], f[6], f[7]); o.z = pg8::pk_fp8x4(f[8], f[9], f[10], f[11]); o.w = pg8::pk_fp8x4(f[12], f[13], f[14], f[15]);
        const int nn = n0 + n;
        const int drow = PERMW ? ((nn & ~255) + 128 * (nn & 1) + ((nn & 255) >> 1)) : nn;
        *(u32x4*)(WT + (size_t)drow * dld + k0 + 16 * c) = o;
    }
    LDS_WAIT(); asm volatile("" ::: "memory");
}

struct Args {
    const float* in[22]; float* out; unsigned char* ws; int ph_lo, ph_hi;
};

__device__ __forceinline__ void f32_to_bf16_rows(const float* __restrict__ src, bf16_t* __restrict__ dst, size_t n4, size_t gt, size_t ngt) {
    size_t i = gt;
    for (; i + 7 * ngt < n4; i += 8 * ngt) { f32x4 a[8];
#pragma unroll
        for (int u = 0; u < 8; ++u) a[u] = *(const f32x4*)(src + (i + u * ngt) * 4);
#pragma unroll
        for (int u = 0; u < 8; ++u) { u32x2 o; o.x = cvt_pk_bf16(a[u][0], a[u][1]); o.y = cvt_pk_bf16(a[u][2], a[u][3]); *(u32x2*)(dst + (i + u * ngt) * 4) = o; } }
    for (; i < n4; i += ngt) { const f32x4 a = *(const f32x4*)(src + i * 4); u32x2 o; o.x = cvt_pk_bf16(a[0], a[1]); o.y = cvt_pk_bf16(a[2], a[3]); *(u32x2*)(dst + i * 4) = o; }
}

__device__ __forceinline__ void p0_prologue(const Args& a, LAS unsigned char* lds, int wave, int lane) {
    unsigned char* ws = a.ws;
    LAS float* scr = (LAS float*)(lds + wave * 16384);
    const int G = gridDim.x, gw = blockIdx.x * NWAVES + wave, NGW = G * NWAVES;
    const size_t gt = (size_t)blockIdx.x * NTHR + threadIdx.x, ngt = (size_t)G * NTHR;
    constexpr int I_SQ = 16 * 32, I_MKV = 16 * 16, I_KV = 16 * 48, I_R = 16, I_POOL = 3 * 6, I_W1 = 16 * 64, I_W2 = 16 * 32;
    constexpr int NIT = 4 * I_SQ + 2 * I_MKV + I_KV + 2 * I_R + 4 * I_POOL + 64 * I_W1 + 64 * I_W2;
    for (int it = gw; it < NIT; it += NGW) {
        int r = it;
        if (r < 4 * I_SQ) { const int w = r / I_SQ; r -= w * I_SQ; const float* src = a.in[w == 0 ? 6 : (w == 1 ? 10 : (w == 2 ? 13 : 15))];
            bf16_t* dst = (bf16_t*)(ws + (w == 0 ? WS_WINA : (w == 1 ? WS_WOUTA : (w == 2 ? WS_WINB : WS_WOUTB))));
            if (w == 1 && r < 12 * 32) continue;
            if (w == 2) { tr_item8<false>(src, 1024, (unsigned char*)dst, 1024, scr, 64 * (r / 32), 32 * (r % 32), lane); continue; }
            tr_item<0>(src, 1024, dst, 1024, 0, 0, scr, 64 * (r / 32), 32 * (r % 32), lane); continue; }
        r -= 4 * I_SQ;
        if (r < 2 * I_MKV) { const int w = r / I_MKV; r -= w * I_MKV;
            tr_item8<false>(a.in[w == 0 ? 9 : 14], 512, ws + WS_WMKV + (size_t)512 * w * 1024, 1024, scr, 64 * (r / 16), 32 * (r % 16), lane); continue; }
        r -= 2 * I_MKV;
        if (r < I_KV) { tr_item8<false>(a.in[11], 1548, ws + WS_WKV, 1024, scr, 64 * (r / 48), 32 * (r % 48), lane); continue; }
        r -= I_KV;
        if (r < 2 * I_R) { const int l = r / I_R; r -= l * I_R;
            tr_item<2>(a.in[16] + (size_t)l * 1024 * 32, 32, (bf16_t*)(ws + WS_WR) + (size_t)l * 256 * 1024, 1024, 0, 0, scr, 64 * r, 0, lane); continue; }
        r -= 2 * I_R;
        if (r < 4 * I_POOL) continue;
        r -= 4 * I_POOL;
        if (r < 64 * I_W1) { const int le = r / I_W1; r -= le * I_W1;
            tr_item8<true>(a.in[18] + (size_t)le * 1024 * 2048, 2048, ws + WS_W1 + (size_t)le * 2048 * 1024, 1024, scr, 64 * (r / 64), 32 * (r % 64), lane); continue; }
        r -= 64 * I_W1;
        { const int le = r / I_W2; r -= le * I_W2;
            tr_item8<false>(a.in[20] + (size_t)le * 1024 * 1024, 1024, ws + WS_W2 + (size_t)le * 1024 * 1024, 1024, scr, 64 * (r / 32), 32 * (r % 32), lane); }
    }
    f32_to_bf16_rows(a.in[0], (bf16_t*)(ws + WS_R1), (size_t)T * D / 4, gt, ngt);
    for (size_t i = gt; i < (size_t)NB * MEMT * D / 4; i += ngt) { const f32x4 v = *(const f32x4*)(a.in[1] + i * 4); *(unsigned*)(ws + WS_MEMB + i * 4) = pg8::pk_fp8x4(v[0], v[1], v[2], v[3]); }
    {
      bf16_t* wo = (bf16_t*)(ws + WS_WOUTA); const float* pw = a.in[7]; const float* psc = a.in[8]; const float* wout = a.in[10];
      for (size_t i = gt; i < (size_t)4 * 96 * 256; i += ngt) { const int n4 = (int)(i & 255), kk = (int)(i >> 8), g = kk / 96, c2 = kk % 96;
          const float* p0 = pw + ((size_t)g * 192 + 2 * c2) * 192; const float* p1 = p0 + 192; const float* sr = psc + g * 192; const float* wc = wout + (size_t)g * 192 * 1024 + 4 * n4;
          f32x4 a0 = {0.f, 0.f, 0.f, 0.f}, a1 = {0.f, 0.f, 0.f, 0.f};
#pragma unroll 4
          for (int j = 0; j < 192; j += 4) { const f32x4 q0 = *(const f32x4*)(p0 + j), q1 = *(const f32x4*)(p1 + j), sv = *(const f32x4*)(sr + j);
#pragma unroll
              for (int r = 0; r < 4; ++r) { const f32x4 w = *(const f32x4*)(wc + (size_t)(j + r) * 1024); a0 += w * (q0[r] * sv[r]); a1 += w * (q1[r] * sv[r]); } }
          const int k = g * 192 + 2 * c2;
#pragma unroll
          for (int r = 0; r < 4; ++r) *(unsigned*)(wo + (size_t)(4 * n4 + r) * 1024 + k) = cvt_pk_bf16(a0[r], a1[r]); }
      bf16_t* wr = (bf16_t*)(ws + WS_WR);
      for (size_t i = gt; i < (size_t)2 * 64 * 128; i += ngt) { const int l = (int)(i / (64 * 128)), rr = (int)((i / 128) % 64), ch = (int)(i % 128);
          const int row = 64 + rr;
          *(u32x4*)(wr + ((size_t)l * 256 + row) * 1024 + ch * 8) = (u32x4){0u, 0u, 0u, 0u}; } }
    { float* b1p = (float*)(ws + WS_B1P); const float* b1 = a.in[19];
      for (size_t i = gt; i < (size_t)2 * 32 * 2048; i += ngt) { const int np = (int)(i & 2047); const size_t le = i >> 11;
          const int orig = 2 * (128 * (np >> 8) + (np & 127)) + ((np >> 7) & 1); b1p[i] = b1[le * 2048 + orig]; }
      float* gwt = (float*)(ws + WS_GWT); const float* kvw = a.in[11];
      for (size_t i = gt; i < (size_t)12 * 1024; i += ngt) { const int j = (int)(i / 1024), k = (int)(i % 1024); gwt[i] = kvw[(size_t)k * 1548 + 1536 + j]; } }
}

__device__ __forceinline__ void pool_d_phase(const bf16_t* proj, bf16_t* dbuf) {
    const size_t gt = (size_t)blockIdx.x * NTHR + threadIdx.x, ngt = (size_t)gridDim.x * NTHR;
    for (size_t id = gt; id < (size_t)1024 * 96; id += ngt) {
        const int cc = (int)(id % 96), seg = (int)(id / 96), b = seg >> 5, s0 = (seg & 31) * 64, g = cc / 24, w = 2 << g;
        const bf16_t* up = proj + (size_t)b * S * 1024 + cc * 8; bf16_t* dp = dbuf + (size_t)b * S * 1024 + cc * 8;
        float sum[8];
#pragma unroll
        for (int q = 0; q < 8; ++q) sum[q] = 0.f;
        for (int r = s0 - w; r < s0; ++r) if (r >= 0) { const u32x4 v = *(const u32x4*)(up + (size_t)r * 1024);
            sum[0] += bf_lo(v.x); sum[1] += bf_hi(v.x); sum[2] += bf_lo(v.y); sum[3] += bf_hi(v.y); sum[4] += bf_lo(v.z); sum[5] += bf_hi(v.z); sum[6] += bf_lo(v.w); sum[7] += bf_hi(v.w); }
        for (int t = s0; t < s0 + 64; ++t) {
            const u32x4 v = *(const u32x4*)(up + (size_t)t * 1024);
            float ut[8] = {bf_lo(v.x), bf_hi(v.x), bf_lo(v.y), bf_hi(v.y), bf_lo(v.z), bf_hi(v.z), bf_lo(v.w), bf_hi(v.w)};
#pragma unroll
            for (int q = 0; q < 8; ++q) sum[q] += ut[q];
            if (t - w >= 0) { const u32x4 o = *(const u32x4*)(up + (size_t)(t - w) * 1024);
                sum[0] -= bf_lo(o.x); sum[1] -= bf_hi(o.x); sum[2] -= bf_lo(o.y); sum[3] -= bf_hi(o.y); sum[4] -= bf_lo(o.z); sum[5] -= bf_hi(o.z); sum[6] -= bf_lo(o.w); sum[7] -= bf_hi(o.w); }
            const float inv = 1.0f / (float)((t + 1) < w ? (t + 1) : w);
            float d[8];
#pragma unroll
            for (int q = 0; q < 8; ++q) d[q] = sum[q] * inv - ut[q];
            u32x4 o; o.x = cvt_pk_bf16(d[0], d[1]); o.y = cvt_pk_bf16(d[2], d[3]); o.z = cvt_pk_bf16(d[4], d[5]); o.w = cvt_pk_bf16(d[6], d[7]);
            *(u32x4*)(dp + (size_t)t * 1024) = o;
        }
    }
}

typedef float f32x16 __attribute__((ext_vector_type(16)));
typedef short v4i16_t __attribute__((ext_vector_type(4)));
constexpr int ATT_SLOT = 16384, ATT_NSLOT = 4, ATT_C_OFF = ATT_NSLOT * ATT_SLOT  , ATT_W_OFF = ATT_C_OFF + 8192  , ATT_LDS = ATT_W_OFF + 64;
static_assert(ATT_LDS <= RING_BYTES, "attention LDS map");
constexpr float ATT_L2E = 1.4426950408889634f, ATT_C2 = 0.125f * 1.4426950408889634f, ATT_THR = 8.0f;

template <bool FOX>
__device__ __forceinline__ void att_tile(const LAS unsigned char* sb, f32x16& s0, f32x16& s1, const bf16x8 (&qf)[4], f32x16& O0, f32x16& O1, float& m, float& l,
                                         int kt, int qrow, bool diag, int h2, int kfo, int vfo) {
    __builtin_amdgcn_sched_barrier(0);
#pragma unroll
    for (int ks = 0; ks < 4; ++ks) {
        const bf16x8 k0 = *(const LAS bf16x8*)(sb + kfo + ks * 2048), k1 = *(const LAS bf16x8*)(sb + kfo + ks * 2048 + 512);
        s0 = __builtin_amdgcn_mfma_f32_32x32x16_bf16(k0, qf[ks], s0, 0, 0, 0); s1 = __builtin_amdgcn_mfma_f32_32x32x16_bf16(k1, qf[ks], s1, 0, 0, 0); }
    __builtin_amdgcn_sched_barrier(0);
    const unsigned va_ = (unsigned)(unsigned long)(sb + vfo);
    v4i16_t tv[2][4][2];
#define ATT_TR(dst, off) asm volatile("ds_read_b64_tr_b16 %0, %1 offset:%2" : "=v"(dst) : "v"(va_), "i"(off) : "memory")
    ATT_TR(tv[0][0][0], 0 * 4096 + 0 * 1024);    ATT_TR(tv[0][0][1], 0 * 4096 + 0 * 1024 + 512);
    ATT_TR(tv[0][1][0], 0 * 4096 + 1 * 1024);    ATT_TR(tv[0][1][1], 0 * 4096 + 1 * 1024 + 512);
    ATT_TR(tv[0][2][0], 0 * 4096 + 2 * 1024);    ATT_TR(tv[0][2][1], 0 * 4096 + 2 * 1024 + 512);
    ATT_TR(tv[0][3][0], 0 * 4096 + 3 * 1024);    ATT_TR(tv[0][3][1], 0 * 4096 + 3 * 1024 + 512);
    ATT_TR(tv[1][0][0], 1 * 4096 + 0 * 1024);    ATT_TR(tv[1][0][1], 1 * 4096 + 0 * 1024 + 512);
    ATT_TR(tv[1][1][0], 1 * 4096 + 1 * 1024);    ATT_TR(tv[1][1][1], 1 * 4096 + 1 * 1024 + 512);
    ATT_TR(tv[1][2][0], 1 * 4096 + 2 * 1024);    ATT_TR(tv[1][2][1], 1 * 4096 + 2 * 1024 + 512);
    ATT_TR(tv[1][3][0], 1 * 4096 + 3 * 1024);    ATT_TR(tv[1][3][1], 1 * 4096 + 3 * 1024 + 512);
#undef ATT_TR
    if (FOX && diag) {
#pragma unroll
        for (int r = 0; r < 16; ++r) { const int key = kt * 64 + (r & 3) + 8 * (r >> 2) + 4 * h2;
            s0[r] = (key > qrow) ? -INFINITY : s0[r]; s1[r] = (key + 32 > qrow) ? -INFINITY : s1[r]; }
    }
    float ta = fmaxf(fmaxf(s0[0], s0[1]), s1[0]), tb = fmaxf(fmaxf(s0[2], s0[3]), s1[1]); ta = fmaxf(fmaxf(ta, s1[2]), s1[3]);
#pragma unroll
    for (int r = 4; r < 16; r += 4) { ta = fmaxf(fmaxf(ta, s0[r]), s0[r + 1]); tb = fmaxf(fmaxf(tb, s0[r + 2]), s0[r + 3]); ta = fmaxf(fmaxf(ta, s1[r]), s1[r + 1]); tb = fmaxf(fmaxf(tb, s1[r + 2]), s1[r + 3]); }
    float tmax = fmaxf(ta, tb);
    { const auto rr = __builtin_amdgcn_permlane32_swap(__float_as_uint(tmax), __float_as_uint(tmax), false, false); tmax = fmaxf(__uint_as_float(rr[0]), __uint_as_float(rr[1])); }
    if (__any(tmax > m + ATT_THR)) {
        const float mn = fmaxf(m, tmax), alpha = __builtin_amdgcn_exp2f(m - mn); m = mn; l *= alpha;
#pragma unroll
        for (int r = 0; r < 16; ++r) { O0[r] *= alpha; O1[r] *= alpha; }
    }
    float ps = 0.f;
#pragma unroll
    for (int r = 0; r < 16; ++r) { s0[r] = __builtin_amdgcn_exp2f(s0[r] - m); s1[r] = __builtin_amdgcn_exp2f(s1[r] - m); ps += s0[r] + s1[r]; }
    l += ps;
    bf16x8 pf[2][2];
#pragma unroll
    for (int sp = 0; sp < 2; ++sp) { u32x4 a, b;
        a.x = cvt_pk_bf16(s0[8 * sp + 0], s0[8 * sp + 1]); a.y = cvt_pk_bf16(s0[8 * sp + 2], s0[8 * sp + 3]); a.z = cvt_pk_bf16(s0[8 * sp + 4], s0[8 * sp + 5]); a.w = cvt_pk_bf16(s0[8 * sp + 6], s0[8 * sp + 7]);
        b.x = cvt_pk_bf16(s1[8 * sp + 0], s1[8 * sp + 1]); b.y = cvt_pk_bf16(s1[8 * sp + 2], s1[8 * sp + 3]); b.z = cvt_pk_bf16(s1[8 * sp + 4], s1[8 * sp + 5]); b.w = cvt_pk_bf16(s1[8 * sp + 6], s1[8 * sp + 7]);
        pf[0][sp] = __builtin_bit_cast(bf16x8, a); pf[1][sp] = __builtin_bit_cast(bf16x8, b); }
    __builtin_amdgcn_sched_barrier(0);
    asm volatile("s_waitcnt lgkmcnt(0)" ::: "memory");
    __builtin_amdgcn_sched_barrier(0);
#pragma unroll
    for (int kb = 0; kb < 2; ++kb)
#pragma unroll
        for (int sp = 0; sp < 2; ++sp) { const int ki = 2 * kb + sp;
            const v4i16_t a0 = tv[0][ki][0], a1 = tv[0][ki][1], b0 = tv[1][ki][0], b1 = tv[1][ki][1];
            const bf16x8 va = (bf16x8){a0[0], a0[1], a0[2], a0[3], a1[0], a1[1], a1[2], a1[3]}, vb = (bf16x8){b0[0], b0[1], b0[2], b0[3], b1[0], b1[1], b1[2], b1[3]};
            O0 = __builtin_amdgcn_mfma_f32_32x32x16_bf16(va, pf[kb][sp], O0, 0, 0, 0); O1 = __builtin_amdgcn_mfma_f32_32x32x16_bf16(vb, pf[kb][sp], O1, 0, 0, 0); }
    __builtin_amdgcn_sched_barrier(0);
}
__device__ __forceinline__ void att_load_q(bf16x8 (&qf)[4], const bf16_t* Qrow, int h2) {
    u32x4 qraw[4];
#pragma unroll
    for (int ks = 0; ks < 4; ++ks) qraw[ks] = *(const u32x4*)(Qrow + 16 * ks + 8 * h2);
#pragma unroll
    for (int ks = 0; ks < 4; ++ks) { const u32x4 w = qraw[ks];
        u32x4 o; o.x = cvt_pk_bf16(ATT_C2 * bf_lo(w.x), ATT_C2 * bf_hi(w.x)); o.y = cvt_pk_bf16(ATT_C2 * bf_lo(w.y), ATT_C2 * bf_hi(w.y));
        o.z = cvt_pk_bf16(ATT_C2 * bf_lo(w.z), ATT_C2 * bf_hi(w.z)); o.w = cvt_pk_bf16(ATT_C2 * bf_lo(w.w), ATT_C2 * bf_hi(w.w)); qf[ks] = __builtin_bit_cast(bf16x8, o); }
}
__device__ __forceinline__ void att_store_o(bf16_t* op, const f32x16& O0, const f32x16& O1, float l) {
    { const auto rr = __builtin_amdgcn_permlane32_swap(__float_as_uint(l), __float_as_uint(l), false, false); l = __uint_as_float(rr[0]) + __uint_as_float(rr[1]); }
    const float il = 1.0f / l;
#pragma unroll
    for (int g = 0; g < 4; ++g) { u32x2 w0, w1;
        w0.x = cvt_pk_bf16(O0[4 * g + 0] * il, O0[4 * g + 1] * il); w0.y = cvt_pk_bf16(O0[4 * g + 2] * il, O0[4 * g + 3] * il);
        w1.x = cvt_pk_bf16(O1[4 * g + 0] * il, O1[4 * g + 1] * il); w1.y = cvt_pk_bf16(O1[4 * g + 2] * il, O1[4 * g + 3] * il);
        *(u32x2*)(op + 8 * g) = w0; *(u32x2*)(op + 32 + 8 * g) = w1; }
}
constexpr float ATT_S8 = 16.0f;
typedef int i32x8a __attribute__((ext_vector_type(8)));
typedef int i32x4a __attribute__((ext_vector_type(4)));
__device__ __forceinline__ void att_tile8(const LAS unsigned char* sb, f32x16& s0, f32x16& s1, const i32x8a qf8, f32x16& O0, f32x16& O1, float& m, float& l,
                                          int kt, int qrow, bool diag, int h2, int ql, int vfo) {
    __builtin_amdgcn_sched_barrier(0);
    {   const int sw = (ql >> 2) & 3;
        const LAS unsigned char* k0p = sb + ql * 64; const LAS unsigned char* k1p = k0p + 32 * 64;
        const int c0 = ((2 * h2) ^ sw) * 16, c1 = ((2 * h2 + 1) ^ sw) * 16;
        const i32x4a a00 = *(const LAS i32x4a*)(k0p + c0), a01 = *(const LAS i32x4a*)(k0p + c1), a10 = *(const LAS i32x4a*)(k1p + c0), a11 = *(const LAS i32x4a*)(k1p + c1);
        const i32x8a ka = __builtin_shufflevector(a00, a01, 0, 1, 2, 3, 4, 5, 6, 7), kb = __builtin_shufflevector(a10, a11, 0, 1, 2, 3, 4, 5, 6, 7);
        s0 = __builtin_amdgcn_mfma_scale_f32_32x32x64_f8f6f4(ka, qf8, s0, 0, 0, 0, 0, 0, 0);
        s1 = __builtin_amdgcn_mfma_scale_f32_32x32x64_f8f6f4(kb, qf8, s1, 0, 0, 0, 0, 0, 0); }
    __builtin_amdgcn_sched_barrier(0);
    const unsigned va_ = (unsigned)(unsigned long)(sb + vfo);
    v4i16_t tv[2][4][2];
#define ATT_TR(dst, off) asm volatile("ds_read_b64_tr_b16 %0, %1 offset:%2" : "=v"(dst) : "v"(va_), "i"(off) : "memory")
    ATT_TR(tv[0][0][0], 0 * 4096 + 0 * 1024);    ATT_TR(tv[0][0][1], 0 * 4096 + 0 * 1024 + 512);
    ATT_TR(tv[0][1][0], 0 * 4096 + 1 * 1024);    ATT_TR(tv[0][1][1], 0 * 4096 + 1 * 1024 + 512);
    ATT_TR(tv[0][2][0], 0 * 4096 + 2 * 1024);    ATT_TR(tv[0][2][1], 0 * 4096 + 2 * 1024 + 512);
    ATT_TR(tv[0][3][0], 0 * 4096 + 3 * 1024);    ATT_TR(tv[0][3][1], 0 * 4096 + 3 * 1024 + 512);
    ATT_TR(tv[1][0][0], 1 * 4096 + 0 * 1024);    ATT_TR(tv[1][0][1], 1 * 4096 + 0 * 1024 + 512);
    ATT_TR(tv[1][1][0], 1 * 4096 + 1 * 1024);    ATT_TR(tv[1][1][1], 1 * 4096 + 1 * 1024 + 512);
    ATT_TR(tv[1][2][0], 1 * 4096 + 2 * 1024);    ATT_TR(tv[1][2][1], 1 * 4096 + 2 * 1024 + 512);
    ATT_TR(tv[1][3][0], 1 * 4096 + 3 * 1024);    ATT_TR(tv[1][3][1], 1 * 4096 + 3 * 1024 + 512);
#undef ATT_TR
    if (diag) {
#pragma unroll
        for (int r = 0; r < 16; ++r) { const int key = kt * 64 + (r & 3) + 8 * (r >> 2) + 4 * h2;
            s0[r] = (key > qrow) ? -INFINITY : s0[r]; s1[r] = (key + 32 > qrow) ? -INFINITY : s1[r]; }
    }
    float ta = fmaxf(fmaxf(s0[0], s0[1]), s1[0]), tb = fmaxf(fmaxf(s0[2], s0[3]), s1[1]); ta = fmaxf(fmaxf(ta, s1[2]), s1[3]);
#pragma unroll
    for (int r = 4; r < 16; r += 4) { ta = fmaxf(fmaxf(ta, s0[r]), s0[r + 1]); tb = fmaxf(fmaxf(tb, s0[r + 2]), s0[r + 3]); ta = fmaxf(fmaxf(ta, s1[r]), s1[r + 1]); tb = fmaxf(fmaxf(tb, s1[r + 2]), s1[r + 3]); }
    float tmax = fmaxf(ta, tb);
    { const auto rr = __builtin_amdgcn_permlane32_swap(__float_as_uint(tmax), __float_as_uint(tmax), false, false); tmax = fmaxf(__uint_as_float(rr[0]), __uint_as_float(rr[1])); }
    if (__any(tmax > m + ATT_THR * ATT_S8)) {
        const float mn = fmaxf(m, tmax), alpha = __builtin_amdgcn_exp2f((m - mn) * (1.0f / ATT_S8)); m = mn; l *= alpha;
#pragma unroll
        for (int r = 0; r < 16; ++r) { O0[r] *= alpha; O1[r] *= alpha; }
    }
    const float nm = -m * (1.0f / ATT_S8);
    float ps = 0.f;
#pragma unroll
    for (int r = 0; r < 16; ++r) { s0[r] = __builtin_amdgcn_exp2f(fmaf(s0[r], 1.0f / ATT_S8, nm)); s1[r] = __builtin_amdgcn_exp2f(fmaf(s1[r], 1.0f / ATT_S8, nm)); ps += s0[r] + s1[r]; }
    l += ps;
    bf16x8 pf[2][2];
#pragma unroll
    for (int sp = 0; sp < 2; ++sp) { u32x4 a, b;
        a.x = cvt_pk_bf16(s0[8 * sp + 0], s0[8 * sp + 1]); a.y = cvt_pk_bf16(s0[8 * sp + 2], s0[8 * sp + 3]); a.z = cvt_pk_bf16(s0[8 * sp + 4], s0[8 * sp + 5]); a.w = cvt_pk_bf16(s0[8 * sp + 6], s0[8 * sp + 7]);
        b.x = cvt_pk_bf16(s1[8 * sp + 0], s1[8 * sp + 1]); b.y = cvt_pk_bf16(s1[8 * sp + 2], s1[8 * sp + 3]); b.z = cvt_pk_bf16(s1[8 * sp + 4], s1[8 * sp + 5]); b.w = cvt_pk_bf16(s1[8 * sp + 6], s1[8 * sp + 7]);
        pf[0][sp] = __builtin_bit_cast(bf16x8, a); pf[1][sp] = __builtin_bit_cast(bf16x8, b); }
    __builtin_amdgcn_sched_barrier(0);
    asm volatile("s_waitcnt lgkmcnt(0)" ::: "memory");
    __builtin_amdgcn_sched_barrier(0);
#pragma unroll
    for (int kb = 0; kb < 2; ++kb)
#pragma unroll
        for (int sp = 0; sp < 2; ++sp) { const int ki = 2 * kb + sp;
            const v4i16_t a0 = tv[0][ki][0], a1 = tv[0][ki][1], b0 = tv[1][ki][0], b1 = tv[1][ki][1];
            const bf16x8 va = (bf16x8){a0[0], a0[1], a0[2], a0[3], a1[0], a1[1], a1[2], a1[3]}, vb = (bf16x8){b0[0], b0[1], b0[2], b0[3], b1[0], b1[1], b1[2], b1[3]};
            O0 = __builtin_amdgcn_mfma_f32_32x32x16_bf16(va, pf[kb][sp], O0, 0, 0, 0); O1 = __builtin_amdgcn_mfma_f32_32x32x16_bf16(vb, pf[kb][sp], O1, 0, 0, 0); }
    __builtin_amdgcn_sched_barrier(0);
}
__device__ __forceinline__ void attn_unit_fox2(const unsigned char* Q8, const unsigned char* K8, const bf16_t* Vp, bf16_t* Op, int qA, int qB, LAS unsigned char* lds) {
    int tid = threadIdx.x; asm volatile("" : "+v"(tid));
    const int lane = tid & 63, wave = __builtin_amdgcn_readfirstlane(tid >> 6), ql = lane & 31, h2 = lane >> 5;
    const LAS float* ncl = (const LAS float*)(lds + ATT_C_OFF);
    const int q0A = 256 * qA, q0B = 256 * qB, nkt = 4 * qA + 4, nktB = 4 * qB + 4;
    const int qrowA = q0A + 32 * wave + ql, qrowB = q0B + 32 * wave + ql;
    const int kkey = 16 * (wave & 3) + (lane >> 2);
    const unsigned char* ksrc = K8 + (size_t)kkey * 768 + 16 * ((lane & 3) ^ ((kkey >> 2) & 3));
    const bf16_t* vsrc = Vp + (size_t)(16 * (wave & 3) + (lane >> 2)) * 768 + 32 * (wave >> 2) + 8 * (lane & 3);
    const bool kwave = wave < 4;
#define ATT_DMA(t, slot) do { if (kwave) __builtin_amdgcn_global_load_lds((const unsigned*)(ksrc + (size_t)(t) * 64 * 768), (LAS unsigned*)(lds + (slot) * ATT_SLOT + wave * 1024), 16, 0, 0); \
                              __builtin_amdgcn_global_load_lds((const unsigned*)(vsrc + (size_t)(t) * 64 * 768), (LAS unsigned*)(lds + (slot) * ATT_SLOT + 8192 + wave * 1024), 16, 0, 0); } while (0)
    i32x8a qfA, qfB;
    { const i32x4a a0 = *(const i32x4a*)(Q8 + (size_t)qrowA * 768 + 32 * h2), a1 = *(const i32x4a*)(Q8 + (size_t)qrowA * 768 + 32 * h2 + 16);
      const i32x4a b0 = *(const i32x4a*)(Q8 + (size_t)qrowB * 768 + 32 * h2), b1 = *(const i32x4a*)(Q8 + (size_t)qrowB * 768 + 32 * h2 + 16);
      qfA = __builtin_shufflevector(a0, a1, 0, 1, 2, 3, 4, 5, 6, 7); qfB = __builtin_shufflevector(b0, b1, 0, 1, 2, 3, 4, 5, 6, 7); }
    ATT_DMA(0, 0);
    ATT_DMA(1, 1);
    f32x16 OA0, OA1, OB0, OB1;
#pragma unroll
    for (int r = 0; r < 16; ++r) { OA0[r] = 0.f; OA1[r] = 0.f; OB0[r] = 0.f; OB1[r] = 0.f; }
    float mA = -1e30f, lA = 0.f, mB = -1e30f, lB = 0.f;
    const int vfo = 8192 + (4 * h2 + ((lane & 15) >> 2)) * 64 + ((lane >> 4) & 1) * 32 + (lane & 3) * 8;
    const int lastA = (q0A + 32 * wave + 31) >> 6, lastB = (q0B + 32 * wave + 31) >> 6;
    int pair = 0;
    for (int kt0 = 0; kt0 < nkt; kt0 += 2) {
        asm volatile("s_waitcnt vmcnt(0)" ::: "memory");
        __builtin_amdgcn_s_barrier();
        asm volatile("" ::: "memory");
        if (kt0 + 2 < nkt) { ATT_DMA(kt0 + 2, 2 * (pair ^ 1)); ATT_DMA(kt0 + 3, 2 * (pair ^ 1) + 1); }
#pragma unroll 1
        for (int sub = 0; sub < 2; ++sub) { const int kt = kt0 + sub; const LAS unsigned char* sb = lds + (2 * pair + sub) * ATT_SLOT;
            if (kt <= lastA) { f32x16 s0, s1;
#pragma unroll
                for (int g = 0; g < 4; ++g) { const f32x4 c0 = *(const LAS f32x4*)(ncl + kt * 64 + 8 * g + 4 * h2), c1 = *(const LAS f32x4*)(ncl + kt * 64 + 32 + 8 * g + 4 * h2);
#pragma unroll
                    for (int j = 0; j < 4; ++j) { s0[4 * g + j] = c0[j]; s1[4 * g + j] = c1[j]; } }
                att_tile8(sb, s0, s1, qfA, OA0, OA1, mA, lA, kt, qrowA, kt * 64 + 63 > q0A + 32 * wave, h2, ql, vfo); }
            if (kt < nktB && kt <= lastB) { f32x16 s0, s1;
#pragma unroll
                for (int g = 0; g < 4; ++g) { const f32x4 c0 = *(const LAS f32x4*)(ncl + kt * 64 + 8 * g + 4 * h2), c1 = *(const LAS f32x4*)(ncl + kt * 64 + 32 + 8 * g + 4 * h2);
#pragma unroll
                    for (int j = 0; j < 4; ++j) { s0[4 * g + j] = c0[j]; s1[4 * g + j] = c1[j]; } }
                att_tile8(sb, s0, s1, qfB, OB0, OB1, mB, lB, kt, qrowB, kt * 64 + 63 > q0B + 32 * wave, h2, ql, vfo); }
        }
        pair ^= 1;
    }
#undef ATT_DMA
    att_store_o(Op + (size_t)qrowA * 1024 + 4 * h2, OA0, OA1, lA);
    att_store_o(Op + (size_t)qrowB * 1024 + 4 * h2, OB0, OB1, lB);
    asm volatile("s_waitcnt lgkmcnt(0)" ::: "memory"); __builtin_amdgcn_s_barrier(); asm volatile("" ::: "memory");
}
__device__ __forceinline__ void memattn_mfma(const bf16_t* proj, const bf16_t* kvmem, int koff, bf16_t* cat, LAS unsigned char* lds) {
    const int tid = threadIdx.x, lane = tid & 63, wave = __builtin_amdgcn_readfirstlane(tid >> 6), ql = lane & 31, h2 = lane >> 5;
    const int kfo = h2 * 1024 + ql * 16, vfo = 8192 + (4 * h2 + ((lane & 15) >> 2)) * 64 + ((lane >> 4) & 1) * 32 + (lane & 3) * 8;
    for (int u = blockIdx.x; u < NB * 4 * 2; u += gridDim.x) {
        const int half = u & 1, h = (u >> 1) & 3, b = u >> 3;
        const bf16_t* Kp = kvmem + (size_t)b * MEMT * 1024 + koff + 64 * h; const bf16_t* Vp = Kp + 256;
        const bf16_t* ksrc = Kp + (size_t)lane * 1024 + 8 * wave;
        const bf16_t* vsrc = Vp + (size_t)(16 * (wave & 3) + (lane >> 2)) * 1024 + 32 * (wave >> 2) + 8 * (lane & 3);
        __syncthreads();
#pragma unroll
        for (int t = 0; t < 4; ++t) { __builtin_amdgcn_global_load_lds((const unsigned*)(ksrc + (size_t)t * 64 * 1024), (LAS unsigned*)(lds + t * ATT_SLOT + wave * 1024), 16, 0, 0);
                                       __builtin_amdgcn_global_load_lds((const unsigned*)(vsrc + (size_t)t * 64 * 1024), (LAS unsigned*)(lds + t * ATT_SLOT + 8192 + wave * 1024), 16, 0, 0); }
        const bf16_t* Qb = proj + (size_t)b * S * 1024 + 768 + 64 * h; bf16_t* Ob = cat + (size_t)b * S * 1024 + 768 + 64 * h;
        bf16x8 qf[4];
        att_load_q(qf, Qb + (size_t)(half * 1024 + 32 * wave + ql) * 1024, h2);
        asm volatile("s_waitcnt vmcnt(0)" ::: "memory");
        __builtin_amdgcn_s_barrier();
        asm volatile("" ::: "memory");
        for (int qb = 0; qb < 4; ++qb) {
            const int qrow = half * 1024 + qb * 256 + 32 * wave + ql;
            f32x16 O0, O1;
#pragma unroll
            for (int r = 0; r < 16; ++r) { O0[r] = 0.f; O1[r] = 0.f; }
            float m = -1e30f, l = 0.f;
            bf16x8 qn[4];
            if (qb + 1 < 4) att_load_q(qn, Qb + (size_t)(qrow + 256) * 1024, h2);
#pragma unroll 1
            for (int kt = 0; kt < 4; ++kt) { f32x16 s0, s1;
#pragma unroll
                for (int r = 0; r < 16; ++r) { s0[r] = 0.f; s1[r] = 0.f; }
                att_tile<false>(lds + kt * ATT_SLOT, s0, s1, qf, O0, O1, m, l, kt, qrow, false, h2, kfo, vfo); }
            att_store_o(Ob + (size_t)qrow * 1024 + 4 * h2, O0, O1, l);
            if (qb + 1 < 4) {
#pragma unroll
                for (int ks = 0; ks < 4; ++ks) qf[ks] = qn[ks]; }
        }
    }
}
__device__ __forceinline__ void fox_mfma(const unsigned char* Q8, const unsigned char* K8, const bf16_t* Vf, const float* glog, bf16_t* cat, LAS unsigned char* lds) {
    const int tid = threadIdx.x, lane = tid & 63, wave = tid >> 6;
    LAS float* cl = (LAS float*)(lds + ATT_C_OFF); LAS float* wtot = (LAS float*)(lds + ATT_W_OFF);
    const int G = gridDim.x, vcu = (G % 8 == 0) ? ((int)(blockIdx.x % 8) * (G / 8) + (int)(blockIdx.x / 8)) : (int)blockIdx.x;
    const int npair = NB * 12 * 4, npp = (npair + G - 1) / G; int last_bh = -1;
    for (int ip = 0; ip < npp; ++ip) {
        const int p = vcu * npp + ip; if (p >= npair) break;
        const int bh = p >> 2, j = p & 3, b = bh / 12, h = bh % 12;
        if (bh != last_bh) {
            last_bh = bh;
            float v[4];
#pragma unroll
            for (int k = 0; k < 4; ++k) v[k] = glog[((size_t)b * S + 4 * tid + k) * 16 + h];
            v[1] += v[0]; v[2] += v[1]; v[3] += v[2];
            float inc = v[3];
#pragma unroll
            for (int off = 1; off < 64; off <<= 1) { const float n = __shfl_up(inc, off); if (lane >= off) inc += n; }
            if (lane == 63) wtot[wave] = inc;
            __syncthreads();
            float base = inc - v[3];
            for (int w = 0; w < wave; ++w) base += wtot[w];
#pragma unroll
            for (int k = 0; k < 4; ++k) cl[4 * tid + k] = -(base + v[k]) * (ATT_L2E * ATT_S8);
            __syncthreads();
        }
        attn_unit_fox2(Q8 + (size_t)b * S * 768 + 64 * h, K8 + (size_t)b * S * 768 + 64 * h, Vf + (size_t)b * S * 768 + 64 * h,
                       cat + (size_t)b * S * 1024 + 64 * h, 7 - j, j, lds);
    }
}

constexpr float Y8_SCALE = 32.0f;
__device__ __forceinline__ void add_fp8x16(float (&v)[16], const u32x4 w, float sc) {
    const unsigned ww[4] = {w.x, w.y, w.z, w.w};
#pragma unroll
    for (int q = 0; q < 4; ++q) { const f32x2 lo = __builtin_amdgcn_cvt_pk_f32_fp8((int)ww[q], false), hi = __builtin_amdgcn_cvt_pk_f32_fp8((int)ww[q], true);
        v[4 * q + 0] += sc * lo[0]; v[4 * q + 1] += sc * lo[1]; v[4 * q + 2] += sc * hi[0]; v[4 * q + 3] += sc * hi[1]; }
}
__device__ __forceinline__ void unpack_bf16x8(float* v, const u32x4 x, float sc) {
    v[0] = sc * bf_lo(x.x); v[1] = sc * bf_hi(x.x); v[2] = sc * bf_lo(x.y); v[3] = sc * bf_hi(x.y); v[4] = sc * bf_lo(x.z); v[5] = sc * bf_hi(x.z); v[6] = sc * bf_lo(x.w); v[7] = sc * bf_hi(x.w);
}
template <bool HP32, bool COMBINE, bool GATES>
__device__ __forceinline__ void ln_phase(const void* hprev, const void* add, const int* tok_slot, const float* gam, const float* bet, bf16_t* hout, float* fout,
                                         const float* gwt, const float* fgate_b, float* glog, LAS unsigned char* lds, unsigned char* qout = nullptr) {
    static_assert(!(HP32 && (COMBINE || GATES)), "the f32-input form is the plain LN1 of layer 0");
    constexpr int NCH = HP32 ? 4 : 2, CW = 16 / NCH, CS = 1024 / NCH;
    const int tid = threadIdx.x, lane = tid & 63, wave = tid >> 6;
    const int gw = blockIdx.x * NWAVES + wave, NGW = gridDim.x * NWAVES;
    LAS float* gl = (LAS float*)lds;
    if (GATES) { for (int i = tid; i < 12 * 1024; i += NTHR) gl[i] = gwt[i]; __syncthreads(); }
    float g[16], bb[16];
#pragma unroll
    for (int ch = 0; ch < NCH; ++ch)
#pragma unroll
        for (int q = 0; q < CW / 4; ++q) { const f32x4 gv = *(const f32x4*)(gam + CS * ch + CW * lane + 4 * q), bv = *(const f32x4*)(bet + CS * ch + CW * lane + 4 * q);
#pragma unroll
            for (int j = 0; j < 4; ++j) { g[ch * CW + q * 4 + j] = gv[j]; bb[ch * CW + q * 4 + j] = bv[j]; } }
    for (int rp = gw; rp < T / 2; rp += NGW) {
        const int row0 = 2 * rp;
        float v[2][16];
        f32x4 xf[2][4]; u32x4 xh[2][2], am[2][2]; u32x2 am2[2][4], ay[2][4][2];
        int myslot = 0;
        if (COMBINE) myslot = tok_slot[(size_t)row0 * 4 + (lane & 7)];
#pragma unroll
        for (int r = 0; r < 2; ++r) {
            if (HP32) { const float* hp = (const float*)hprev + (size_t)(row0 + r) * 1024 + 4 * lane; const bf16_t* ap = (const bf16_t*)add + (size_t)(row0 + r) * 1024 + 4 * lane;
#pragma unroll
                for (int ch = 0; ch < 4; ++ch) { xf[r][ch] = *(const f32x4*)(hp + 256 * ch); am2[r][ch] = *(const u32x2*)(ap + 256 * ch); }
            } else { const bf16_t* hp = (const bf16_t*)hprev + (size_t)(row0 + r) * 1024 + 8 * lane; xh[r][0] = *(const u32x4*)hp; xh[r][1] = *(const u32x4*)(hp + 512);
                if (!COMBINE) { const bf16_t* ap = (const bf16_t*)add + (size_t)(row0 + r) * 1024 + 8 * lane; am[r][0] = *(const u32x4*)ap; am[r][1] = *(const u32x4*)(ap + 512); } }
        }
        if (COMBINE) {
#pragma unroll
            for (int r = 0; r < 2; ++r)
#pragma unroll
                for (int k = 0; k < 4; ++k) { const int sl = __builtin_amdgcn_readlane(myslot, 4 * r + k); const unsigned char* yp = (const unsigned char*)add + (size_t)sl * 1024 + 8 * lane;
                    ay[r][k][0] = *(const u32x2*)yp; ay[r][k][1] = *(const u32x2*)(yp + 512); }
        }
#pragma unroll
        for (int r = 0; r < 2; ++r) {
            if (HP32) {
#pragma unroll
                for (int ch = 0; ch < 4; ++ch) { const u32x2 mw = am2[r][ch];
                    v[r][4 * ch + 0] = DN_ALPHA * xf[r][ch][0] + bf_lo(mw.x); v[r][4 * ch + 1] = DN_ALPHA * xf[r][ch][1] + bf_hi(mw.x);
                    v[r][4 * ch + 2] = DN_ALPHA * xf[r][ch][2] + bf_lo(mw.y); v[r][4 * ch + 3] = DN_ALPHA * xf[r][ch][3] + bf_hi(mw.y); }
            } else {
                unpack_bf16x8(&v[r][0], xh[r][0], DN_ALPHA); unpack_bf16x8(&v[r][8], xh[r][1], DN_ALPHA);
                if (COMBINE) {
                    float acc[16];
#pragma unroll
                    for (int i = 0; i < 16; ++i) acc[i] = 0.f;
#pragma unroll
                    for (int k = 0; k < 4; ++k)
#pragma unroll
                        for (int ch = 0; ch < 2; ++ch) { const unsigned ww[2] = {ay[r][k][ch].x, ay[r][k][ch].y};
#pragma unroll
                            for (int q = 0; q < 2; ++q) { const f32x2 lo = __builtin_amdgcn_cvt_pk_f32_fp8((int)ww[q], false), hi = __builtin_amdgcn_cvt_pk_f32_fp8((int)ww[q], true);
                                acc[8 * ch + 4 * q + 0] += lo[0]; acc[8 * ch + 4 * q + 1] += lo[1]; acc[8 * ch + 4 * q + 2] += hi[0]; acc[8 * ch + 4 * q + 3] += hi[1]; } }
#pragma unroll
                    for (int i = 0; i < 16; ++i) v[r][i] += acc[i] * (1.0f / Y8_SCALE);
                } else { float t[16]; unpack_bf16x8(&t[0], am[r][0], 1.0f); unpack_bf16x8(&t[8], am[r][1], 1.0f);
#pragma unroll
                    for (int i = 0; i < 16; ++i) v[r][i] += t[i]; }
            }
        }
        float s[2] = {0.f, 0.f};
#pragma unroll
        for (int r = 0; r < 2; ++r)
#pragma unroll
            for (int i = 0; i < 16; ++i) s[r] += v[r][i];
        float mean[2], s2[2] = {0.f, 0.f};
#pragma unroll
        for (int r = 0; r < 2; ++r) { mean[r] = wave_sum(s[r]) * (1.0f / 1024.0f);
#pragma unroll
            for (int i = 0; i < 16; ++i) { v[r][i] -= mean[r]; s2[r] += v[r][i] * v[r][i]; } }
#pragma unroll
        for (int r = 0; r < 2; ++r) { const float rstd = 1.0f / sqrtf(wave_sum(s2[r]) * (1.0f / 1024.0f) + LN_EPS);
#pragma unroll
            for (int i = 0; i < 16; ++i) v[r][i] = v[r][i] * rstd * g[i] + bb[i]; }
#pragma unroll
        for (int r = 0; r < 2; ++r) {
            if (hout) { bf16_t* op = hout + (size_t)(row0 + r) * 1024 + CW * lane;
                if (HP32) {
#pragma unroll
                    for (int ch = 0; ch < 4; ++ch) { u32x2 w; w.x = cvt_pk_bf16(v[r][4 * ch + 0], v[r][4 * ch + 1]); w.y = cvt_pk_bf16(v[r][4 * ch + 2], v[r][4 * ch + 3]); *(u32x2*)(op + 256 * ch) = w; }
                } else {
#pragma unroll
                    for (int ch = 0; ch < 2; ++ch) { u32x4 w; w.x = cvt_pk_bf16(v[r][ch * 8 + 0], v[r][ch * 8 + 1]); w.y = cvt_pk_bf16(v[r][ch * 8 + 2], v[r][ch * 8 + 3]);
                        w.z = cvt_pk_bf16(v[r][ch * 8 + 4], v[r][ch * 8 + 5]); w.w = cvt_pk_bf16(v[r][ch * 8 + 6], v[r][ch * 8 + 7]); *(u32x4*)(op + 512 * ch) = w; } } }
            if (qout) { unsigned char* qp = qout + (size_t)(row0 + r) * 1024 + CW * lane;
                if (HP32) {
#pragma unroll
                    for (int ch = 0; ch < 4; ++ch) *(unsigned*)(qp + 256 * ch) = pg8::pk_fp8x4(v[r][4 * ch + 0], v[r][4 * ch + 1], v[r][4 * ch + 2], v[r][4 * ch + 3]);
                } else {
#pragma unroll
                    for (int ch = 0; ch < 2; ++ch) { u32x2 w; w.x = pg8::pk_fp8x4(v[r][8 * ch + 0], v[r][8 * ch + 1], v[r][8 * ch + 2], v[r][8 * ch + 3]);
                        w.y = pg8::pk_fp8x4(v[r][8 * ch + 4], v[r][8 * ch + 5], v[r][8 * ch + 6], v[r][8 * ch + 7]); *(u32x2*)(qp + 512 * ch) = w; } } }
            if (!HP32 && fout) { float* op = fout + (size_t)(row0 + r) * 1024 + 8 * lane;
#pragma unroll
                for (int ch = 0; ch < 2; ++ch)
#pragma unroll
                    for (int q = 0; q < 2; ++q) *(f32x4*)(op + 512 * ch + 4 * q) = (f32x4){v[r][ch * 8 + q * 4 + 0], v[r][ch * 8 + q * 4 + 1], v[r][ch * 8 + q * 4 + 2], v[r][ch * 8 + q * 4 + 3]}; }
        }
        if (GATES) {
            f32x2 P[12];
#pragma unroll
            for (int j = 0; j < 12; ++j) { f32x2 p = {0.f, 0.f};
#pragma unroll
                for (int ch = 0; ch < 2; ++ch)
#pragma unroll
                    for (int q = 0; q < 2; ++q) { const f32x4 w = *(const LAS f32x4*)(gl + j * 1024 + 512 * ch + 8 * lane + 4 * q);
#pragma unroll
                        for (int e = 0; e < 4; ++e) p += (f32x2){v[0][ch * 8 + q * 4 + e], v[1][ch * 8 + q * 4 + e]} * w[e]; }
                P[j] = p; }
            float Q[12];
#pragma unroll
            for (int j = 0; j < 12; ++j) { const auto rr = __builtin_amdgcn_permlane32_swap(__float_as_uint(P[j][0]), __float_as_uint(P[j][1]), false, false); Q[j] = __uint_as_float(rr[0]) + __uint_as_float(rr[1]); }
            float R[6];
#pragma unroll
            for (int j = 0; j < 6; ++j) { const auto rr = __builtin_amdgcn_permlane16_swap(__float_as_uint(Q[j]), __float_as_uint(Q[j + 6]), false, false); R[j] = __uint_as_float(rr[0]) + __uint_as_float(rr[1]); }
#define LN_DPP(x, ctrl) __int_as_float(__builtin_amdgcn_update_dpp(0, __float_as_int(x), (ctrl), 0xf, 0xf, false))
#pragma unroll
            for (int j = 0; j < 6; ++j) { float t = R[j]; t += LN_DPP(t, 0x128); t += LN_DPP(t, 0x124); t += LN_DPP(t, 0x122); t += LN_DPP(t, 0x121); R[j] = t; }
#undef LN_DPP
            const int l16 = lane & 15, jj = l16 + 6 * ((lane >> 4) & 1), rr_ = lane >> 5;
            float mine = R[0];
#pragma unroll
            for (int j = 1; j < 6; ++j) mine = (l16 == j) ? R[j] : mine;
            if (l16 < 6) { const float z = mine + fgate_b[jj]; const float ls = fminf(z, 0.f) - log1pf(expf(-fabsf(z))); glog[(size_t)(row0 + rr_) * 16 + jj] = ls; }
        }
    }
}

__device__ __forceinline__ void top4_phase(const float* logits, const float* rb, int* tok_e, float* tok_g, int* tok_r, unsigned* wg_hist, LAS unsigned char* lds) {
    const int tid = threadIdx.x;
    LAS unsigned* hist = (LAS unsigned*)lds;
    for (int ch = blockIdx.x; ch < NCHUNK; ch += gridDim.x) {
        __syncthreads();
        if (tid < 32) hist[tid] = 0u;
        __syncthreads();
        if (tid < 256) {
            const int t = ch * 256 + tid; const float* lp = logits + (size_t)t * 32;
            float lg[32];
#pragma unroll
            for (int q = 0; q < 8; ++q) { const f32x4 hv = *(const f32x4*)(lp + 4 * q) + *(const f32x4*)(lp + (size_t)T * 32 + 4 * q), bv = *(const f32x4*)(rb + 4 * q);
#pragma unroll
                for (int j = 0; j < 4; ++j) lg[4 * q + j] = hv[j] + bv[j]; }
            unsigned used = 0u; int sel[4]; float val[4];
#pragma unroll
            for (int k = 0; k < 4; ++k) { float best = -INFINITY; int bi = 0;
#pragma unroll
                for (int e = 0; e < 32; ++e) { const float c = ((used >> e) & 1u) ? -INFINITY : lg[e]; if (c > best) { best = c; bi = e; } }
                sel[k] = bi; val[k] = best; used |= 1u << bi; }
            const float e1 = __expf(val[1] - val[0]), e2 = __expf(val[2] - val[0]), e3 = __expf(val[3] - val[0]); const float inv = 1.0f / (1.0f + e1 + e2 + e3);
            const float gt[4] = {inv, e1 * inv, e2 * inv, e3 * inv};
            int rk[4];
#pragma unroll
            for (int k = 0; k < 4; ++k) rk[k] = (int)atomicAdd((unsigned*)(hist + sel[k]), 1u);
            *(int4*)(tok_e + (size_t)t * 4) = make_int4(sel[0], sel[1], sel[2], sel[3]);
            *(f32x4*)(tok_g + (size_t)t * 4) = (f32x4){gt[0], gt[1], gt[2], gt[3]};
            *(int4*)(tok_r + (size_t)t * 4) = make_int4(rk[0], rk[1], rk[2], rk[3]);
        }
        __syncthreads();
        if (tid < 32) wg_hist[ch * 32 + tid] = hist[tid];
    }
}

__device__ __forceinline__ void assign_phase(const unsigned* wg_hist, const int* tok_e, const float* tok_g, const int* tok_r, int* tok_s, float* slot_g, int* slot_t,
                                             int* tiletab, LAS unsigned char* lds) {
    const int tid = threadIdx.x, lane = tid & 63, wave = tid >> 6;
    LAS unsigned* rtot = (LAS unsigned*)lds;
    LAS unsigned* rpre = rtot + 512;
    LAS unsigned* cnt = rpre + 512;
    LAS unsigned* pstart = cnt + 32;
    LAS unsigned* base = pstart + 40;
    LAS int* sl = (LAS int*)(base + 32);
    for (int ch = blockIdx.x; ch < NCHUNK; ch += gridDim.x) {
        __syncthreads();
        { const int e = tid & 31, part = tid >> 5; unsigned tot = 0u, pre = 0u;
          for (int c = part * 16; c < part * 16 + 16; ++c) { const unsigned hv = wg_hist[c * 32 + e]; tot += hv; if (c < ch) pre += hv; }
          rtot[part * 32 + e] = tot; rpre[part * 32 + e] = pre; }
        __syncthreads();
        if (tid < 32) { unsigned tot = 0u, pre = 0u;
            for (int p = 0; p < 16; ++p) { tot += rtot[p * 32 + tid]; pre += rpre[p * 32 + tid]; }
            cnt[tid] = tot; base[tid] = pre; }
        __syncthreads();
        if (tid == 0) { unsigned acc = 0u; for (int e = 0; e < 32; ++e) { pstart[e] = acc; acc += (cnt[e] + 255u) & ~255u; } pstart[32] = acc; }
        __syncthreads();
        if (tid < 256) { const int t = ch * 256 + tid;
            const int4 e4 = *(const int4*)(tok_e + (size_t)t * 4), r4 = *(const int4*)(tok_r + (size_t)t * 4); const f32x4 g4 = *(const f32x4*)(tok_g + (size_t)t * 4);
            const int es[4] = {e4.x, e4.y, e4.z, e4.w}, rs[4] = {r4.x, r4.y, r4.z, r4.w}; int so[4];
#pragma unroll
            for (int k = 0; k < 4; ++k) { so[k] = (int)(pstart[es[k]] + base[es[k]]) + rs[k]; slot_g[so[k]] = g4[k]; slot_t[so[k]] = t; }
            *(int4*)(tok_s + (size_t)t * 4) = make_int4(so[0], so[1], so[2], so[3]); }
        __syncthreads();
        if (ch == (int)blockIdx.x) {
            for (int e = blockIdx.x; e < NE; e += gridDim.x) {
                const int p0 = (int)(pstart[e] + cnt[e]), p1 = (int)pstart[e + 1];
                for (int s = p0 + tid; s < p1; s += NTHR) { slot_g[s] = 0.f; slot_t[s] = 0; }
                for (int tl = (int)(pstart[e] >> 8) + tid; tl < (int)(pstart[e + 1] >> 8); tl += NTHR) tiletab[16 + tl] = e;
            }
            if (blockIdx.x == 0 && tid == 0) tiletab[0] = (int)(pstart[32] >> 8);
        }
    }
}

__global__ void __launch_bounds__(NTHR, 2) fwd_kernel(Args args) {
    extern __shared__ __attribute__((aligned(16))) unsigned char lds_raw[];
    LAS unsigned char* lds = (LAS unsigned char*)lds_raw;
    volatile LAS unsigned* MISC = (volatile LAS unsigned*)(lds + MISC_OFF);
    const int tid = threadIdx.x, lane = tid & 63, wave = __builtin_amdgcn_readfirstlane(tid >> 6);
    const int G = gridDim.x;
    unsigned char* ws = args.ws;
    unsigned* ctl = (unsigned*)(ws + WS_CTL);
    if (tid < 32) MISC[tid] = 0u;
    __syncthreads();
    XcdBarrier bar; bar.bar = ctl + CW_BAR; bar.x = 0; bar.st = nullptr;
#if !MK_PER_PHASE
    bar = xcd_barrier_post(ctl + CW_BAR, MISC + 8);
#endif
    const int lo = args.ph_lo, hi = args.ph_hi;
#ifndef PH_MASK
#define PH_MASK 0xFFFFFFFFu
#endif
#ifndef PH_TWICE
#define PH_TWICE 0u
#endif
#define TW(k) ((((unsigned)PH_TWICE >> (k)) & 1u) != 0u)
#define IN(k) (((PH_MASK >> (k)) & 1u) && lo <= (k) && (k) < hi)
#if MK_PER_PHASE
#define SEAM(k) do { } while (0)
#else
#define SEAM(k) do { if (IN(k) && IN((k) + 1)) xcd_barrier(bar); } while (0)
#endif
    bf16_t* const R1 = (bf16_t*)(ws + WS_R1); bf16_t* const R2 = (bf16_t*)(ws + WS_R2);
    bf16_t* const PROJ = (bf16_t*)(ws + WS_PROJ); bf16_t* const CAT = (bf16_t*)(ws + WS_CAT); bf16_t* const MIX = (bf16_t*)(ws + WS_MIX); bf16_t* const DBUF = (bf16_t*)(ws + WS_DBUF);
    bf16_t* const KF = (bf16_t*)(ws + WS_KF); bf16_t* const VF = (bf16_t*)(ws + WS_VF);
    bf16_t* const ACT = (bf16_t*)(ws + WS_ACT); bf16_t* const YB = (bf16_t*)(ws + WS_Y);
    unsigned char* const MEMB = ws + WS_MEMB; bf16_t* const KVMEM = (bf16_t*)(ws + WS_KVMEM);
    float* const LOGITS = (float*)(ws + WS_LOGITS); float* const GLOG = (float*)(ws + WS_GLOG);
    int* const TOKE = (int*)(ws + WS_TOKE); float* const TOKG = (float*)(ws + WS_TOKG); int* const TOKR = (int*)(ws + WS_TOKR); int* const TOKS = (int*)(ws + WS_TOKS);
    float* const SLOTG = (float*)(ws + WS_SLOTG); int* const SLOTT = (int*)(ws + WS_SLOTT);
    unsigned* const WGH = (unsigned*)(ws + WS_WGHIST); int* const TILETAB = (int*)(ws + WS_TILETAB);

    if (IN(0)) { p0_prologue(args, lds, wave, lane); } if (TW(0) && IN(0)) { p0_prologue(args, lds, wave, lane); }
    SEAM(0);
    if (IN(1)) {
        { pg8::Gemm g{R1, ws + WS_WINA, T, 1024, 2048}; pg8::StaticOrder So; So.init(T, 1024, G, (int)blockIdx.x);
          pg8::EpiBf16 E{PROJ, 1024, nullptr, 0, 0, 1.0f}; pg8::gemm_phase(lds, g, So, E); }
        { pg8::Gemm g{MEMB, ws + WS_WMKV, NB * MEMT, 1024, 1024}; pg8::StaticOrder So; So.init(NB * MEMT, 1024, G, (int)((blockIdx.x + 128) % G));
          pg8::EpiBf16 E{KVMEM, 1024, nullptr, 0, 0, 1.0f / pg8::W8_SCALE}; pg8::gemm_phase<pg8::EpiBf16, pg8::StaticOrder, true>(lds, g, So, E); }
    }
    SEAM(1);
    if (IN(2)) { pool_d_phase(PROJ, CAT); memattn_mfma(PROJ, KVMEM, 0, CAT, lds); } if (TW(2) && IN(2)) { pool_d_phase(PROJ, CAT); memattn_mfma(PROJ, KVMEM, 0, CAT, lds); }
    SEAM(2);
    if (IN(4)) { pg8::Gemm g{CAT, ws + WS_WOUTA, T, 1024, 2048}; pg8::StaticOrder So; So.init(T, 1024, G, (int)blockIdx.x);
        pg8::EpiBf16 E{MIX, 1024, nullptr, 0, 0, 1.0f}; pg8::gemm_phase(lds, g, So, E); }
    SEAM(4);
    if (IN(5)) ln_phase<false, false, false>(R1, MIX, nullptr, args.in[2], args.in[3], R1, nullptr, nullptr, nullptr, nullptr, lds, ws + WS_H1Q); if (TW(5) && IN(5)) ln_phase<false, false, false>(R1, MIX, nullptr, args.in[2], args.in[3], R1, nullptr, nullptr, nullptr, nullptr, lds, ws + WS_H1Q);
    SEAM(5);
#define MOE_BLOCK(P, L, HIN) \
    if (IN(P)) { pg8::Gemm g{HIN, ws + WS_WR + (size_t)(L) * 256 * 2048, T, 256, 2048}; pg8::StaticOrder So; So.init(T, 256, G, (int)blockIdx.x); \
        if (G == 256) { pg8::EpiRouter E{args.in[17] + (L) * 32, TOKE, TOKG, TOKR, WGH}; pg8::gemm_phase(lds, g, So, E); } \
        else { pg8::EpiLogits E{LOGITS}; pg8::gemm_phase(lds, g, So, E); } } \
    if (G != 256) SEAM(P); \
    if (G != 256 && IN((P) + 1)) top4_phase(LOGITS, args.in[17] + (L) * 32, TOKE, TOKG, TOKR, WGH, lds); \
    SEAM((P) + 1); \
    if (IN((P) + 2)) assign_phase(WGH, TOKE, TOKG, TOKR, TOKS, SLOTG, SLOTT, TILETAB, lds); if (TW((P) + 2) && IN((P) + 2)) assign_phase(WGH, TOKE, TOKG, TOKR, TOKS, SLOTG, SLOTT, TILETAB, lds); \
    SEAM((P) + 2); \
    if (IN((P) + 3)) { LAS int* tab = (LAS int*)(lds + TAB_OFF); const int ntl = (int)__hip_atomic_load((unsigned*)TILETAB, RLX_AGENT); \
        for (int i = tid; i < NTILE_MAX; i += NTHR) tab[i] = (i < ntl) ? TILETAB[16 + i] : 0; __syncthreads(); \
        pg8::Gemm g{ws + WS_H1Q, ws + WS_W1 + (size_t)(L) * 32 * 2048 * 1024, NSLOT_MAX, 2048, 1024}; pg8::MoeOrder Mo{ntl, 8, G, (int)blockIdx.x, tab}; \
        pg8::EpiSwiglu E{(unsigned char*)ACT, (const float*)(ws + WS_B1P) + (size_t)(L) * 32 * 2048}; pg8::gemm_phase<pg8::EpiSwiglu, pg8::MoeOrder, true, true>(lds, g, Mo, E, SLOTT); } \
    SEAM((P) + 3); \
    if (IN((P) + 4)) { LAS int* tab = (LAS int*)(lds + TAB_OFF); const int ntl = (int)__hip_atomic_load((unsigned*)TILETAB, RLX_AGENT); \
        for (int i = tid; i < NTILE_MAX; i += NTHR) tab[i] = (i < ntl) ? TILETAB[16 + i] : 0; __syncthreads(); \
        pg8::Gemm g{ACT, ws + WS_W2 + (size_t)(L) * 32 * 1024 * 1024, NSLOT_MAX, 1024, 1024}; pg8::MoeOrder Mo{ntl, 4, G, (int)blockIdx.x, tab}; \
        pg8::EpiMoe2 E{(unsigned char*)YB, args.in[21] + (size_t)(L) * 32 * 1024, SLOTG, Y8_SCALE}; pg8::gemm_phase<pg8::EpiMoe2, pg8::MoeOrder, true>(lds, g, Mo, E); } \
    SEAM((P) + 4);
    MOE_BLOCK(6, 0, R1)
    if (IN(11)) ln_phase<false, true, true>(R1, YB, TOKS, args.in[4], args.in[5], R2, nullptr, (const float*)(ws + WS_GWT), args.in[12], GLOG, lds, ws + WS_H1Q); if (TW(11) && IN(11)) ln_phase<false, true, true>(R1, YB, TOKS, args.in[4], args.in[5], R2, nullptr, (const float*)(ws + WS_GWT), args.in[12], GLOG, lds, ws + WS_H1Q);
    SEAM(11);
    if (IN(12)) {
        { pg8::Gemm g{ws + WS_H1Q, ws + WS_WKV, T, 1536, 1024}; pg8::StaticOrder So; So.init(T, 1536, G, (int)blockIdx.x);
          pg8::EpiMixed8 E{ws + WS_KF, 768, 1.0f / pg8::W8_SCALE, 3, VF, 768, 1, 1.0f / pg8::W8_SCALE}; pg8::gemm_phase<pg8::EpiMixed8, pg8::StaticOrder, true>(lds, g, So, E); }
        { pg8::Gemm g{ws + WS_H1Q, ws + WS_WINB, T, 1024, 1024}; pg8::StaticOrder So; So.init(T, 1024, G, (int)blockIdx.x);
          pg8::EpiMixed8 E{ws + WS_Q8, 768, ATT_C2 * ATT_S8 / pg8::W8_SCALE, 3, PROJ, 1024, 0, 1.0f / pg8::W8_SCALE}; pg8::gemm_phase<pg8::EpiMixed8, pg8::StaticOrder, true>(lds, g, So, E); }
    }
    SEAM(12);
    if (IN(13)) { fox_mfma(ws + WS_Q8, ws + WS_KF, VF, GLOG, CAT, lds); memattn_mfma(PROJ, KVMEM, 512, CAT, lds); } if (TW(13) && IN(13)) { fox_mfma(ws + WS_Q8, ws + WS_KF, VF, GLOG, CAT, lds); memattn_mfma(PROJ, KVMEM, 512, CAT, lds); }
    SEAM(13);
    if (IN(14)) { pg8::Gemm g{CAT, ws + WS_WOUTB, T, 1024, 2048}; pg8::StaticOrder So; So.init(T, 1024, G, (int)blockIdx.x);
        pg8::EpiBf16 E{MIX, 1024, nullptr, 0, 0, 1.0f}; pg8::gemm_phase(lds, g, So, E); }
    SEAM(14);
    if (IN(15)) ln_phase<false, false, false>(R2, MIX, nullptr, args.in[2] + 1024, args.in[3] + 1024, R1, nullptr, nullptr, nullptr, nullptr, lds, ws + WS_H1Q); if (TW(15) && IN(15)) ln_phase<false, false, false>(R2, MIX, nullptr, args.in[2] + 1024, args.in[3] + 1024, R1, nullptr, nullptr, nullptr, nullptr, lds, ws + WS_H1Q);
    SEAM(15);
    MOE_BLOCK(16, 1, R1)
    if (IN(21)) ln_phase<false, true, false>(R1, YB, TOKS, args.in[4] + 1024, args.in[5] + 1024, nullptr, args.out, nullptr, nullptr, nullptr, lds); if (TW(21) && IN(21)) ln_phase<false, true, false>(R1, YB, TOKS, args.in[4] + 1024, args.in[5] + 1024, nullptr, args.out, nullptr, nullptr, nullptr, lds);
#undef IN
#undef SEAM
}

extern "C" void kernel_launch(void* const* d_in, const int* in_sizes, int n_in, void* d_out, int out_size, void* d_ws, size_t ws_size, hipStream_t stream) {
    static int grid = 0;
    if (grid == 0) {
        if (n_in != 22 || out_size != T * D || ws_size < WS_END) { fprintf(stderr, "kernel_launch: unexpected problem (n_in %d out %d ws %zu)\n", n_in, out_size, ws_size); grid = -1; return; }
        int dev = 0, cus = 0;
        if (hipGetDevice(&dev) != hipSuccess || hipDeviceGetAttribute(&cus, hipDeviceAttributeMultiprocessorCount, dev) != hipSuccess) { grid = -1; return; }
        if (hipFuncSetAttribute((const void*)fwd_kernel, hipFuncAttributeMaxDynamicSharedMemorySize, LDS_BYTES) != hipSuccess) { fprintf(stderr, "kernel_launch: hipFuncSetAttribute failed\n"); grid = -1; return; }
        int per_cu = 0;
        if (hipOccupancyMaxActiveBlocksPerMultiprocessor(&per_cu, (const void*)fwd_kernel, NTHR, LDS_BYTES) != hipSuccess || per_cu < 1) fprintf(stderr, "kernel_launch: occupancy query says %d\n", per_cu);
        (void)hipGetLastError();
        grid = cus;
    }
    if (grid < 0) return;
    if (hipMemsetAsync((char*)d_ws + WS_CTL, 0, CTL_ZERO_BYTES, stream) != hipSuccess) return;
    Args a{};
    for (int i = 0; i < 22; ++i) a.in[i] = (const float*)d_in[i];
    a.out = (float*)d_out; a.ws = (unsigned char*)d_ws;
#if MK_PER_PHASE
    for (int p = 0; p < NPH; ++p) { a.ph_lo = p; a.ph_hi = p + 1; hipLaunchKernelGGL(fwd_kernel, dim3(grid), dim3(NTHR), LDS_BYTES, stream, a); }
#else
    a.ph_lo = 0; a.ph_hi = NPH; hipLaunchKernelGGL(fwd_kernel, dim3(grid), dim3(NTHR), LDS_BYTES, stream, a);
#endif
}
```

```cpp
#include <hip/hip_runtime.h>
#include <cstdio>
#include <cstdint>

#ifndef MK_PER_PHASE
#define MK_PER_PHASE 0
#endif

#define LAS __attribute__((address_space(3)))
#define GAS __attribute__((address_space(1)))
typedef unsigned short bf16_t;
typedef short bf16x8 __attribute__((ext_vector_type(8)));
typedef float f32x4 __attribute__((ext_vector_type(4)));
typedef float f32x2 __attribute__((ext_vector_type(2)));
typedef unsigned u32x4 __attribute__((ext_vector_type(4)));
typedef unsigned u32x2 __attribute__((ext_vector_type(2)));

__device__ __forceinline__ unsigned cvt_pk_bf16(float lo, float hi) { unsigned r; asm volatile("v_cvt_pk_bf16_f32 %0, %1, %2" : "=v"(r) : "v"(lo), "v"(hi)); return r; }
__device__ __forceinline__ float bf_lo(unsigned w) { return __uint_as_float(w << 16); }
__device__ __forceinline__ float bf_hi(unsigned w) { return __uint_as_float(w & 0xffff0000u); }

namespace pg8 {
constexpr int BM = 256, BK = 64, HALF = 128, HTB = HALF * BK * 2, STAGE_BYTES = 8 * HTB, NXCD = 8, WGM = 8;
__host__ __device__ __forceinline__ int lds_byte(int r, int c) { const int st = (r >> 4) * 2 + (c >> 5), rr = r & 15, cc = c & 31, ob = rr * 64 + cc * 2; return st * 1024 + (ob ^ (((ob >> 9) & 1) << 5)); }
__host__ __device__ __forceinline__ void stage_rc(int b, int& R, int& C) { const int st = b / 1024, sb = b % 1024, swz = sb ^ (((sb >> 9) & 1) << 5); R = (st >> 1) * 16 + swz / 64; C = (st & 1) * 32 + (swz % 64) / 2; }
__host__ __device__ __forceinline__ int perm32(int rho) { const int n = rho >> 4, i = rho & 15; return 8 * (i >> 2) + 4 * n + (i & 3); }

struct Unit { int pm, pn, e; };
struct Gemm { const void* A; const void* Bt; int M, N, Kb; };

struct StaticOrder {
    int nM, nN, nwg, G, c;
    __device__ void init(int M, int N, int G_, int c_) { nM = M / BM; nN = N / BM; nwg = nM * nN; G = G_; c = c_; }
    __device__ bool next(int i, Unit& u) const {
        const long L = (long)i * G + c; if (L >= nwg) return false;
        int wgid = (int)L; { const int q = nwg / NXCD, r = nwg % NXCD, xcd = wgid % NXCD, off = wgid / NXCD; wgid = (xcd < r ? xcd * (q + 1) : r * (q + 1) + (xcd - r) * q) + off; }
        const int nig = WGM * nN, gid = wgid / nig, fm = gid * WGM, gsz = (nM - fm) < WGM ? (nM - fm) : WGM;
        u.pm = fm + ((wgid % nig) % gsz); u.pn = (wgid % nig) / gsz; u.e = 0; return true;
    }
};
struct MoeOrder {
    int n_tiles, nN, G, c; const LAS int* tab;
    __device__ bool next(int i, Unit& u) const {
        int rt, pn;
        if (G == 256) { const int x = c & 7, r = c >> 3, rpi = 32 / nN, tpx = (n_tiles + 7) >> 3, lt = rpi * i + r / nN;
            if (lt >= tpx) return false; rt = x * tpx + lt; pn = r % nN; }

        else { const long L = (long)i * G + c; rt = (int)(L / nN); pn = (int)(L % nN); }
        if (rt >= n_tiles) return false;
        u.pm = rt; u.pn = pn; u.e = __builtin_amdgcn_readfirstlane(tab[rt]); return true;
    }
};

struct EpiBf16 {
    static constexpr bool PERM = true, AFTER = false, ALIGN = false; static constexpr bool SKIP_B1 = false;
    struct Pre {}; __device__ __forceinline__ Pre preload(const Unit&, int, int, int, int) const { return Pre{}; } static constexpr int NPRE = 0; static constexpr bool HOISTOK = false; static __device__ __forceinline__ void touch(Pre&) {}
    __device__ __forceinline__ const float* stash_ptr(const Unit&, int) const { return nullptr; } __device__ __forceinline__ Pre from_stash(const LAS float*, int, int, int, int) const { return Pre{}; }
    bf16_t* O; int ldc; const float* colscale; int split_cols; size_t split_stride; float scale;
    __device__ __forceinline__ void operator()(const f32x4 (&acc)[2][2][4][2], const Unit& u, int wr, int wc, int fr, int fq, const Pre&) const {
        const int row0 = u.pm * BM + wr * 64 + fr; int colt = u.pn * BM; bf16_t* base = O;
        if (split_cols) { const int t = colt / split_cols; base += (size_t)t * split_stride; colt -= t * split_cols; }
        const int col0 = colt + wc * 32 + 8 * fq, scol0 = u.pn * BM + wc * 32 + 8 * fq;
        f32x4 sv[2][2];
#pragma unroll
        for (int bj = 0; bj < 2; ++bj)
#pragma unroll
            for (int n = 0; n < 2; ++n) sv[bj][n] = colscale ? *(const f32x4*)(colscale + scol0 + bj * HALF + 4 * n) * scale : (f32x4){scale, scale, scale, scale};
#pragma unroll
        for (int ai = 0; ai < 2; ++ai)
#pragma unroll
            for (int m = 0; m < 4; ++m) { bf16_t* rowp = base + (size_t)(row0 + ai * HALF + m * 16) * ldc + col0;
#pragma unroll
                for (int bj = 0; bj < 2; ++bj) { const f32x4 v0 = acc[ai][bj][m][0] * sv[bj][0], v1 = acc[ai][bj][m][1] * sv[bj][1];
                    u32x4 w; w.x = cvt_pk_bf16(v0[0], v0[1]); w.y = cvt_pk_bf16(v0[2], v0[3]); w.z = cvt_pk_bf16(v1[0], v1[1]); w.w = cvt_pk_bf16(v1[2], v1[3]);
                    *(u32x4*)(rowp + bj * HALF) = w; } }
    }
};
__device__ __forceinline__ unsigned pk_fp8x4(float a, float b, float c, float d) { int w = 0; w = __builtin_amdgcn_cvt_pk_fp8_f32(a, b, w, false); w = __builtin_amdgcn_cvt_pk_fp8_f32(c, d, w, true); return (unsigned)w; }
constexpr float W8_SCALE = 64.0f, ACT8_SCALE = 4.0f;
struct EpiMixed8 {
    static constexpr bool PERM = true, AFTER = false, ALIGN = false; static constexpr bool SKIP_B1 = false;
    struct Pre {}; __device__ __forceinline__ Pre preload(const Unit&, int, int, int, int) const { return Pre{}; } static constexpr int NPRE = 0; static constexpr bool HOISTOK = false; static __device__ __forceinline__ void touch(Pre&) {}
    __device__ __forceinline__ const float* stash_ptr(const Unit&, int) const { return nullptr; } __device__ __forceinline__ Pre from_stash(const LAS float*, int, int, int, int) const { return Pre{}; }
    unsigned char* O8; int ld8; float scale8; int ncut8; bf16_t* O16; int ld16; int rebase16; float scale16;
    __device__ __forceinline__ void operator()(const f32x4 (&acc)[2][2][4][2], const Unit& u, int wr, int wc, int fr, int fq, const Pre&) const {
        const int row0 = u.pm * BM + wr * 64 + fr;
        if (u.pn < ncut8) {
            const int col0 = u.pn * BM + wc * 32 + 8 * fq;
#pragma unroll
            for (int ai = 0; ai < 2; ++ai)
#pragma unroll
                for (int m = 0; m < 4; ++m) { unsigned char* rowp = O8 + (size_t)(row0 + ai * HALF + m * 16) * ld8 + col0;
#pragma unroll
                    for (int bj = 0; bj < 2; ++bj) { const f32x4 v0 = acc[ai][bj][m][0] * scale8, v1 = acc[ai][bj][m][1] * scale8;
                        u32x2 w; w.x = pk_fp8x4(v0[0], v0[1], v0[2], v0[3]); w.y = pk_fp8x4(v1[0], v1[1], v1[2], v1[3]); *(u32x2*)(rowp + bj * HALF) = w; } }
        } else {
            const int col0 = (u.pn - (rebase16 ? ncut8 : 0)) * BM + wc * 32 + 8 * fq;
#pragma unroll
            for (int ai = 0; ai < 2; ++ai)
#pragma unroll
                for (int m = 0; m < 4; ++m) { bf16_t* rowp = O16 + (size_t)(row0 + ai * HALF + m * 16) * ld16 + col0;
#pragma unroll
                    for (int bj = 0; bj < 2; ++bj) { const f32x4 v0 = acc[ai][bj][m][0] * scale16, v1 = acc[ai][bj][m][1] * scale16;
                        u32x4 w; w.x = cvt_pk_bf16(v0[0], v0[1]); w.y = cvt_pk_bf16(v0[2], v0[3]); w.z = cvt_pk_bf16(v1[0], v1[1]); w.w = cvt_pk_bf16(v1[2], v1[3]); *(u32x4*)(rowp + bj * HALF) = w; } }
        }
    }
};
struct EpiLogits {
    static constexpr bool PERM = false, AFTER = false, ALIGN = true; static constexpr bool SKIP_B1 = true;
    struct Pre {}; __device__ __forceinline__ Pre preload(const Unit&, int, int, int, int) const { return Pre{}; } static constexpr int NPRE = 0; static constexpr bool HOISTOK = false; static __device__ __forceinline__ void touch(Pre&) {}
    __device__ __forceinline__ const float* stash_ptr(const Unit&, int) const { return nullptr; } __device__ __forceinline__ Pre from_stash(const LAS float*, int, int, int, int) const { return Pre{}; }
    float* L;
    __device__ __forceinline__ void operator()(const f32x4 (&acc)[2][2][4][2], const Unit& u, int wr, int wc, int fr, int fq, const Pre&) const {
        if (wc > 1) return;
        const int row0 = u.pm * BM + wr * 64 + fr;
#pragma unroll
        for (int ai = 0; ai < 2; ++ai)
#pragma unroll
            for (int m = 0; m < 4; ++m) { float* rowp = L + (size_t)wc * 65536 * 32 + (size_t)(row0 + ai * HALF + m * 16) * 32 + 4 * fq;
#pragma unroll
                for (int n = 0; n < 2; ++n) *(f32x4*)(rowp + n * 16) = acc[ai][0][m][n]; }
    }
};
struct EpiRouter {
    static constexpr bool PERM = false, AFTER = true, ALIGN = true; static constexpr bool SKIP_B1 = true;
    struct Pre {}; __device__ __forceinline__ Pre preload(const Unit&, int, int, int, int) const { return Pre{}; } static constexpr int NPRE = 0; static constexpr bool HOISTOK = false; static __device__ __forceinline__ void touch(Pre&) {}
    __device__ __forceinline__ const float* stash_ptr(const Unit&, int) const { return nullptr; } __device__ __forceinline__ Pre from_stash(const LAS float*, int, int, int, int) const { return Pre{}; }
    const float* rb; int* tok_e; float* tok_g; int* tok_r; unsigned* wg_hist;
    __device__ __forceinline__ void operator()(const f32x4 (&)[2][2][4][2], const Unit&, int, int, int, int, const Pre&) const {}
    __device__ __forceinline__ void after(const f32x4 (&acc)[2][2][4][2], const Unit& u, int wr, int wc, int fr, int fq, LAS unsigned char* lds) const {
        LAS float* Lg = (LAS float*)lds;
        LAS unsigned* hist = (LAS unsigned*)(lds + 2 * 256 * 33 * 4);
        const int tid = threadIdx.x;
        if (wc < 2) {
#pragma unroll
            for (int ai = 0; ai < 2; ++ai)
#pragma unroll
                for (int m = 0; m < 4; ++m) { LAS float* rowp = Lg + wc * (256 * 33) + (ai * HALF + wr * 64 + m * 16 + fr) * 33 + 4 * fq;
#pragma unroll
                    for (int n = 0; n < 2; ++n) { const f32x4 v = acc[ai][0][m][n]; rowp[n * 16 + 0] = v[0]; rowp[n * 16 + 1] = v[1]; rowp[n * 16 + 2] = v[2]; rowp[n * 16 + 3] = v[3]; } }
        }
        if (tid < 32) hist[tid] = 0u;
        __syncthreads();
        if (tid < 256) {
            const int t = u.pm * BM + tid; const LAS float* lp = Lg + tid * 33;
            float lg[32];
#pragma unroll
            for (int e = 0; e < 32; ++e) lg[e] = (lp[e] + lp[256 * 33 + e]) + rb[e];
            unsigned used = 0u; int sel[4]; float val[4];
#pragma unroll
            for (int k = 0; k < 4; ++k) { float best = -INFINITY; int bi = 0;
#pragma unroll
                for (int e = 0; e < 32; ++e) { const float c = ((used >> e) & 1u) ? -INFINITY : lg[e]; if (c > best) { best = c; bi = e; } }
                sel[k] = bi; val[k] = best; used |= 1u << bi; }
            const float e1 = __expf(val[1] - val[0]), e2 = __expf(val[2] - val[0]), e3 = __expf(val[3] - val[0]); const float inv = 1.0f / (1.0f + e1 + e2 + e3);
            int rk[4];
#pragma unroll
            for (int k = 0; k < 4; ++k) rk[k] = (int)atomicAdd((unsigned*)(hist + sel[k]), 1u);
            *(int4*)(tok_e + (size_t)t * 4) = make_int4(sel[0], sel[1], sel[2], sel[3]);
            *(f32x4*)(tok_g + (size_t)t * 4) = (f32x4){inv, e1 * inv, e2 * inv, e3 * inv};
            *(int4*)(tok_r + (size_t)t * 4) = make_int4(rk[0], rk[1], rk[2], rk[3]);
        }
        __syncthreads();
        if (tid < 32) wg_hist[u.pm * 32 + tid] = hist[tid];
    }
};
struct EpiSwiglu {
    static constexpr bool PERM = true, AFTER = false, ALIGN = true; static constexpr bool SKIP_B1 = false;
    unsigned char* O; const float* b1p;
    struct Pre { f32x4 bg[2], bl[2]; }; static constexpr bool HOISTOK = true; static constexpr int NPRE = 4;
    __device__ __forceinline__ const float* stash_ptr(const Unit& u, int tid) const { return b1p + (size_t)u.e * 2048 + u.pn * BM + (tid & 255); }
    __device__ __forceinline__ Pre from_stash(const LAS float* st, int wr, int wc, int fr, int fq) const { Pre p; const LAS float* bp = st + wc * 32 + 8 * fq;
        p.bg[0] = *(const LAS f32x4*)bp; p.bg[1] = *(const LAS f32x4*)(bp + 4); p.bl[0] = *(const LAS f32x4*)(bp + HALF); p.bl[1] = *(const LAS f32x4*)(bp + HALF + 4); return p; }
    static __device__ __forceinline__ void touch(Pre& p) { asm volatile("" : "+v"(p.bg[0]), "+v"(p.bg[1]), "+v"(p.bl[0]), "+v"(p.bl[1])); }
    __device__ __forceinline__ Pre preload(const Unit& u, int wr, int wc, int fr, int fq) const {
        Pre p; const float* bp = b1p + (size_t)u.e * 2048 + u.pn * BM + wc * 32 + 8 * fq;
#pragma unroll
        for (int n = 0; n < 2; ++n) { p.bg[n] = *(const f32x4*)(bp + 4 * n); p.bl[n] = *(const f32x4*)(bp + HALF + 4 * n); }
        return p; }
    __device__ __forceinline__ void operator()(const f32x4 (&acc)[2][2][4][2], const Unit& u, int wr, int wc, int fr, int fq, const Pre& pre) const {
        const int row0 = u.pm * BM + wr * 64 + fr, ocol0 = u.pn * HALF + wc * 32 + 8 * fq;
#pragma unroll
        for (int ai = 0; ai < 2; ++ai)
#pragma unroll
            for (int m = 0; m < 4; ++m) { unsigned char* rowp = O + (size_t)(row0 + ai * HALF + m * 16) * 1024 + ocol0; float r[8];
#pragma unroll
                for (int n = 0; n < 2; ++n) { const f32x4 g = acc[ai][0][m][n] * (1.0f / W8_SCALE) + pre.bg[n], l = acc[ai][1][m][n] * (1.0f / W8_SCALE) + pre.bl[n];
#pragma unroll
                    for (int j = 0; j < 4; j += 2) {
                        const f32x2 xg = {fminf(g[j], 7.0f), fminf(g[j + 1], 7.0f)}, xl = {__builtin_amdgcn_fmed3f(l[j], -7.0f, 7.0f), __builtin_amdgcn_fmed3f(l[j + 1], -7.0f, 7.0f)};
                        const f32x2 t = xg * (-1.702f * 1.4426950408889634f);
                        const f32x2 d = (f32x2){__builtin_amdgcn_exp2f(t[0]), __builtin_amdgcn_exp2f(t[1])} + 1.0f;
                        const f32x2 sg = {__builtin_amdgcn_rcpf(d[0]), __builtin_amdgcn_rcpf(d[1])};
                        const f32x2 o = (xg * sg) * (xl * ACT8_SCALE + ACT8_SCALE);
                        r[4 * n + j] = o[0]; r[4 * n + j + 1] = o[1]; } }
                u32x2 w; w.x = pk_fp8x4(r[0], r[1], r[2], r[3]); w.y = pk_fp8x4(r[4], r[5], r[6], r[7]);
                *(u32x2*)rowp = w; }
    }
};
struct EpiMoe2 {
    static constexpr bool PERM = true, AFTER = false, ALIGN = true; static constexpr bool SKIP_B1 = false;
    unsigned char* O; const float* b2; const float* gate; float yscale;
    struct Pre { f32x4 bv[2][2]; float gts[2][4]; }; static constexpr bool HOISTOK = true; static constexpr int NPRE = 12;
    __device__ __forceinline__ const float* stash_ptr(const Unit& u, int tid) const { return tid < 256 ? gate + u.pm * BM + tid : b2 + (size_t)u.e * 1024 + u.pn * BM + (tid - 256); }
    __device__ __forceinline__ Pre from_stash(const LAS float* st, int wr, int wc, int fr, int fq) const { Pre p; const LAS float* bp = st + 256 + wc * 32 + 8 * fq;
#pragma unroll
        for (int bj = 0; bj < 2; ++bj) { p.bv[bj][0] = *(const LAS f32x4*)(bp + bj * HALF); p.bv[bj][1] = *(const LAS f32x4*)(bp + bj * HALF + 4); }
#pragma unroll
        for (int ai = 0; ai < 2; ++ai)
#pragma unroll
            for (int m = 0; m < 4; ++m) p.gts[ai][m] = st[ai * HALF + wr * 64 + m * 16 + fr];
        return p; }

    static __device__ __forceinline__ void touch(Pre& p) { asm volatile("" : "+v"(p.bv[0][0]), "+v"(p.bv[0][1]), "+v"(p.bv[1][0]), "+v"(p.bv[1][1]));
        asm volatile("" : "+v"(p.gts[0][0]), "+v"(p.gts[0][1]), "+v"(p.gts[0][2]), "+v"(p.gts[0][3]), "+v"(p.gts[1][0]), "+v"(p.gts[1][1]), "+v"(p.gts[1][2]), "+v"(p.gts[1][3])); }
    __device__ __forceinline__ Pre preload(const Unit& u, int wr, int wc, int fr, int fq) const {
        Pre p; const int row0 = u.pm * BM + wr * 64 + fr; const float* bp = b2 + (size_t)u.e * 1024 + u.pn * BM + wc * 32 + 8 * fq;
#pragma unroll
        for (int bj = 0; bj < 2; ++bj)
#pragma unroll
            for (int n = 0; n < 2; ++n) p.bv[bj][n] = *(const f32x4*)(bp + bj * HALF + 4 * n);
#pragma unroll
        for (int ai = 0; ai < 2; ++ai)
#pragma unroll
            for (int m = 0; m < 4; ++m) p.gts[ai][m] = gate[row0 + ai * HALF + m * 16];
        return p; }
    __device__ __forceinline__ void operator()(const f32x4 (&acc)[2][2][4][2], const Unit& u, int wr, int wc, int fr, int fq, const Pre& pre) const {
        const int row0 = u.pm * BM + wr * 64 + fr, col0 = u.pn * BM + wc * 32 + 8 * fq;
#pragma unroll
        for (int ai = 0; ai < 2; ++ai)
#pragma unroll
            for (int m = 0; m < 4; ++m) { const int row = row0 + ai * HALF + m * 16; const float gt = pre.gts[ai][m] * yscale; unsigned char* rowp = O + (size_t)row * 1024 + col0;
#pragma unroll
                for (int bj = 0; bj < 2; ++bj) { const f32x4 v0 = (acc[ai][bj][m][0] * (1.0f / (W8_SCALE * ACT8_SCALE)) + pre.bv[bj][0]) * gt, v1 = (acc[ai][bj][m][1] * (1.0f / (W8_SCALE * ACT8_SCALE)) + pre.bv[bj][1]) * gt;
#define Y8C(x) __builtin_amdgcn_fmed3f((x), -448.0f, 448.0f)
                    u32x2 w; w.x = pk_fp8x4(Y8C(v0[0]), Y8C(v0[1]), Y8C(v0[2]), Y8C(v0[3])); w.y = pk_fp8x4(Y8C(v1[0]), Y8C(v1[1]), Y8C(v1[2]), Y8C(v1[3]));
#undef Y8C
                    *(u32x2*)(rowp + bj * HALF) = w; } }
    }
};

#ifndef F8_SCALE
#define F8_SCALE 0
#endif
constexpr int STASH_OFF = 8 * HTB + 4608 + 128;
typedef int i32x8 __attribute__((ext_vector_type(8)));
typedef int i32x4 __attribute__((ext_vector_type(4)));
__device__ __forceinline__ i32x8 cat8(bf16x8 a, bf16x8 b) { const i32x4 x = __builtin_bit_cast(i32x4, a), y = __builtin_bit_cast(i32x4, b); return __builtin_shufflevector(x, y, 0, 1, 2, 3, 4, 5, 6, 7); }
template <class Epi, class Sched, bool F8 = false, bool GATHER = false>
__device__ __forceinline__ void gemm_phase(LAS unsigned char* lds, const Gemm g, const Sched& S, const Epi& E, const int* rowidx = nullptr) {
    const int tid = threadIdx.x, wid = __builtin_amdgcn_readfirstlane(tid >> 6), lane = tid & 63, wr = wid >> 2, wc = wid & 3, fr = lane & 15, fq = lane >> 4;
    const int Kb = g.Kb, nt = Kb / (BK * 2);
    int Ri[2], Ci2[2]; unsigned voffB[2];
#pragma unroll
    for (int i = 0; i < 2; ++i) { int R, C; stage_rc(tid * 16 + i * 8192, R, C); const int Rb = Epi::PERM ? ((R & ~31) + perm32(R & 31)) : R;
        Ri[i] = R; Ci2[i] = C * 2; voffB[i] = (unsigned)(Rb * Kb + C * 2); }
    const size_t kstep = (size_t)(BK * 2);
    const size_t hstep = (size_t)HALF * Kb;
    const size_t tstep = 2 * hstep;
    const size_t estep = (size_t)g.N * Kb;
    const unsigned ldsw = (unsigned)wid * 1024u;
    const int aoff = lds_byte(wr * 64 + fr, fq * 8), boff = lds_byte(wc * 32 + fr, fq * 8);
#define PG8_SA(b, h) (((b) * 2 + (h)) * HTB)
#define PG8_SB(b, h) ((4 + (b) * 2 + (h)) * HTB)
#define PG8_STAGE(bufoff, gbase, voff) do { _Pragma("unroll") for (int _i = 0; _i < 2; ++_i) \
        __builtin_amdgcn_global_load_lds((const unsigned*)((const char*)(gbase) + (voff)[_i]), (LAS unsigned*)(lds + (bufoff) + ldsw + _i * 8192), 16, 0, 0); } while (0)
#define PG8_LDA(dst, b, h) do { _Pragma("unroll") for (int m = 0; m < 4; ++m) _Pragma("unroll") for (int k = 0; k < 2; ++k) dst[m][k] = *(const LAS bf16x8*)(lds + PG8_SA(b, h) + aoff + m * 2048 + k * 1024); } while (0)
#define PG8_LDB(dst, b, h) do { _Pragma("unroll") for (int n = 0; n < 2; ++n) _Pragma("unroll") for (int k = 0; k < 2; ++k) dst[n][k] = *(const LAS bf16x8*)(lds + PG8_SB(b, h) + boff + n * 2048 + k * 1024); } while (0)
#define PG8_MMA(ai, bj, At, Bt) do { __builtin_amdgcn_s_setprio(1); _Pragma("unroll") for (int m = 0; m < 4; ++m) _Pragma("unroll") for (int n = 0; n < 2; ++n) { \
        if constexpr (F8) { const i32x8 b8_ = cat8(Bt[n][0], Bt[n][1]), a8_ = cat8(At[m][0], At[m][1]); \
            asm volatile("v_mfma_f32_16x16x128_f8f6f4 %0, %1, %2, %0" : "+v"(acc[ai][bj][m][n]) : "v"(b8_), "v"(a8_)); }   \
        else { _Pragma("unroll") for (int k = 0; k < 2; ++k) acc[ai][bj][m][n] = __builtin_amdgcn_mfma_f32_16x16x32_bf16(Bt[n][k], At[m][k], acc[ai][bj][m][n], 0, 0, 0); } } \
        __builtin_amdgcn_s_setprio(0); } while (0)
#define PG8_WAIT_V_(n) asm volatile("s_waitcnt vmcnt(" #n ")" ::: "memory")
#define PG8_WAIT_V(n) PG8_WAIT_V_(n)
#define PG8_WAIT_L(n) asm volatile("s_waitcnt lgkmcnt(" #n ")" ::: "memory")
#define PG8_BAR __builtin_amdgcn_s_barrier()
#define PG8_SCHED __builtin_amdgcn_sched_barrier(0)
#define PG8_AOFF(dst, u) do { _Pragma("unroll") for (int h_ = 0; h_ < 2; ++h_) _Pragma("unroll") for (int i_ = 0; i_ < 2; ++i_) { const int r_ = (u).pm * BM + h_ * HALF + Ri[i_]; \
        dst[h_][i_] = (unsigned)(GATHER ? rowidx[r_] : r_) * (unsigned)Kb + (unsigned)Ci2[i_]; } } while (0)
    Unit cur, nxt, nn; int ui = 0; bool has_nn = false;
    typename Epi::Pre pre{}; unsigned offNN[2][2] = {{0u, 0u}, {0u, 0u}}; float stash_v = 0.f;
    if (!S.next(0, cur)) return;
    bool has_next = S.next(1, nxt);
    unsigned offC[2][2], offN[2][2];
    PG8_AOFF(offC, cur);
    if (has_next) PG8_AOFF(offN, nxt); else PG8_AOFF(offN, cur);
    f32x4 acc[2][2][4][2];
#pragma unroll
    for (int a = 0; a < 2; ++a)
#pragma unroll
        for (int b = 0; b < 2; ++b)
#pragma unroll
            for (int m = 0; m < 4; ++m)
#pragma unroll
                for (int n = 0; n < 2; ++n) acc[a][b][m][n] = (f32x4){0.f, 0.f, 0.f, 0.f};
    bf16x8 At[4][2], B0[2][2], B1[2][2];
    const char* const gA = (const char*)g.A;
    const char* cB = (const char*)g.Bt + (size_t)cur.e * estep + (size_t)cur.pn * tstep;
    PG8_STAGE(PG8_SB(0, 0), cB, voffB); PG8_STAGE(PG8_SB(0, 1), cB + hstep, voffB); PG8_STAGE(PG8_SA(0, 0), gA, offC[0]); PG8_STAGE(PG8_SA(0, 1), gA, offC[1]);
    if (wr == 1) PG8_BAR;
    PG8_WAIT_V(2); PG8_BAR;
    PG8_STAGE(PG8_SB(1, 0), cB + kstep, voffB); PG8_STAGE(PG8_SA(1, 0), gA + kstep, offC[0]); PG8_STAGE(PG8_SB(1, 1), cB + hstep + kstep, voffB);
    PG8_WAIT_V(6); PG8_BAR;
    for (;;) {
        const char* nB = has_next ? (const char*)g.Bt + (size_t)nxt.e * estep + (size_t)nxt.pn * tstep : cB;
#pragma nounroll
        for (int t = 0; t < nt; t += 2) {
            const bool last = (t == nt - 2);
            const char* a1 = gA + (size_t)(t + 1) * kstep;
            const char* a2 = last ? gA : gA + (size_t)(t + 2) * kstep; const char* b2 = last ? nB : cB + (size_t)(t + 2) * kstep;
            const char* a3 = a2 + kstep; const char* b3 = b2 + kstep;
            unsigned o2[2][2];
#pragma unroll
            for (int h = 0; h < 2; ++h)
#pragma unroll
                for (int i = 0; i < 2; ++i) o2[h][i] = last ? offN[h][i] : offC[h][i];
            constexpr int HOIST = Epi::HOISTOK ? 1 + (GATHER ? 4 : 0) : 0;
#define PG8_WAIT_H() do { if (HOIST > 0 && last) { if constexpr (HOIST == 5) PG8_WAIT_V(13); else if constexpr (HOIST == 1) PG8_WAIT_V(9); else PG8_WAIT_V(8); } else PG8_WAIT_V(8); } while (0)
            static_assert(HOIST == 0 || HOIST == 1 || HOIST == 5, "add the matching wait count");
            PG8_LDB(B0, 0, 0); if constexpr (!Epi::SKIP_B1) PG8_LDB(B1, 0, 1); PG8_SCHED; PG8_LDA(At, 0, 0); PG8_STAGE(PG8_SA(1, 1), a1, offC[1]);
            if (HOIST > 0 && last) { PG8_SCHED;
                { const float* sp_ = E.stash_ptr(cur, tid); asm volatile("global_load_dword %0, %1, off" : "=v"(stash_v) : "v"(sp_) : "memory"); }
                has_nn = has_next && S.next(ui + 2, nn);
                if constexpr (GATHER) { const int pmn = has_nn ? nn.pm : cur.pm;
#pragma unroll
                    for (int h_ = 0; h_ < 2; ++h_)
#pragma unroll
                        for (int i_ = 0; i_ < 2; ++i_) { const int* ip_ = rowidx + (pmn * BM + h_ * HALF + Ri[i_]); asm volatile("global_load_dword %0, %1, off" : "=v"(offNN[h_][i_]) : "v"(ip_) : "memory"); } }
                else { if (has_nn) PG8_AOFF(offNN, nn); else PG8_AOFF(offNN, cur); }
                PG8_SCHED; }
            PG8_WAIT_H(); PG8_WAIT_L(0); PG8_BAR; PG8_MMA(0, 0, At, B0); if constexpr (!Epi::SKIP_B1) PG8_MMA(0, 1, At, B1); PG8_BAR; PG8_SCHED;
            PG8_LDA(At, 0, 1); PG8_STAGE(PG8_SB(0, 0), b2, voffB); PG8_STAGE(PG8_SB(0, 1), b2 + hstep, voffB); PG8_STAGE(PG8_SA(0, 0), a2, o2[0]);
            PG8_WAIT_H(); PG8_WAIT_L(0); PG8_BAR; PG8_MMA(1, 0, At, B0); if constexpr (!Epi::SKIP_B1) PG8_MMA(1, 1, At, B1); PG8_BAR; PG8_SCHED;
            PG8_LDB(B0, 1, 0); if constexpr (!Epi::SKIP_B1) PG8_LDB(B1, 1, 1); PG8_SCHED; PG8_LDA(At, 1, 0); PG8_STAGE(PG8_SA(0, 1), a2, o2[1]);
            PG8_WAIT_V(8);
            if (HOIST > 0 && last) { ((LAS float*)(lds + STASH_OFF))[tid] = stash_v;
                if constexpr (GATHER) {
#pragma unroll
                    for (int h_ = 0; h_ < 2; ++h_)
#pragma unroll
                        for (int i_ = 0; i_ < 2; ++i_) offNN[h_][i_] = offNN[h_][i_] * (unsigned)Kb + (unsigned)Ci2[i_]; } }
            PG8_WAIT_L(0); PG8_BAR; PG8_MMA(0, 0, At, B0); if constexpr (!Epi::SKIP_B1) PG8_MMA(0, 1, At, B1); PG8_BAR; PG8_SCHED;
            PG8_LDA(At, 1, 1); PG8_STAGE(PG8_SB(1, 0), b3, voffB); PG8_STAGE(PG8_SB(1, 1), b3 + hstep, voffB); PG8_STAGE(PG8_SA(1, 0), a3, o2[0]);
            PG8_WAIT_V(8); PG8_WAIT_L(0); PG8_BAR; PG8_MMA(1, 0, At, B0); if constexpr (!Epi::SKIP_B1) PG8_MMA(1, 1, At, B1); PG8_BAR; PG8_SCHED;
#undef PG8_WAIT_H
        }
        if constexpr (Epi::ALIGN) { if (wr == 0) PG8_BAR; }
        if constexpr (F8) asm volatile("s_nop 7\n\ts_nop 7\n\ts_nop 7" ::: "memory");
        if constexpr (!Epi::HOISTOK) {
            has_nn = has_next && S.next(ui + 2, nn);
            pre = E.preload(cur, wr, wc, fr, fq);
            if (has_nn) PG8_AOFF(offNN, nn); else PG8_AOFF(offNN, cur);
            if constexpr (GATHER) asm volatile("" : "+v"(offNN[0][0]), "+v"(offNN[0][1]), "+v"(offNN[1][0]), "+v"(offNN[1][1])); }
        if constexpr (Epi::HOISTOK) pre = E.from_stash((const LAS float*)(lds + STASH_OFF), wr, wc, fr, fq);
        E(acc, cur, wr, wc, fr, fq, pre);
        if (!has_next) break;
#pragma unroll
        for (int a = 0; a < 2; ++a)
#pragma unroll
            for (int b = 0; b < 2; ++b)
#pragma unroll
                for (int m = 0; m < 4; ++m)
#pragma unroll
                    for (int n = 0; n < 2; ++n) acc[a][b][m][n] = (f32x4){0.f, 0.f, 0.f, 0.f};
#pragma unroll
        for (int h = 0; h < 2; ++h)
#pragma unroll
            for (int i = 0; i < 2; ++i) { offC[h][i] = offN[h][i]; if (has_nn) offN[h][i] = offNN[h][i]; }
        cur = nxt; cB = nB; nxt = nn; has_next = has_nn; ++ui;
        if constexpr (Epi::ALIGN) { if (wr == 1) PG8_BAR; }
    }
    PG8_WAIT_V(0);
    if constexpr (!Epi::ALIGN) { if (wr == 0) PG8_BAR; }
    PG8_BAR;
    if constexpr (Epi::AFTER) E.after(acc, cur, wr, wc, fr, fq, lds);
#undef PG8_SA
#undef PG8_SB
#undef PG8_STAGE
#undef PG8_LDA
#undef PG8_LDB
#undef PG8_MMA
#undef PG8_WAIT_V
#undef PG8_WAIT_V_
#undef PG8_WAIT_L
#undef PG8_BAR
#undef PG8_SCHED
#undef PG8_AOFF
}
}

constexpr int NWAVES = 8, NTHR = 512;
constexpr int T = 65536, D = 1024, NB = 32, S = 2048, MEMT = 256;
constexpr int NE = 32, TOPK = 4;
constexpr int NSLOT_MAX = T * TOPK + NE * 256;
constexpr int NTILE_MAX = NSLOT_MAX / 256;
constexpr int NCHUNK = T / 256;
constexpr float LN_EPS = 1e-5f;
constexpr float DN_ALPHA = 1.4142135623730951f;
constexpr int NPH = 22;

constexpr size_t MiB = 1u << 20;
constexpr size_t WS_CTL = 0, CTL_ZERO_BYTES = 1 * MiB;
constexpr size_t WS_WGHIST = 1 * MiB;
constexpr size_t WS_TILETAB = 1 * MiB + 256 * 1024;
constexpr size_t WS_B1P = 1 * MiB + 512 * 1024;
constexpr size_t WS_GWT = 2 * MiB;
constexpr size_t WS_TOKE = 3 * MiB, WS_TOKG = 4 * MiB, WS_TOKR = 5 * MiB, WS_TOKS = 6 * MiB;
constexpr size_t WS_SLOTG = 7 * MiB, WS_SLOTT = 9 * MiB;
constexpr size_t WS_GLOG = 11 * MiB;
constexpr size_t WS_LOGITS = 16 * MiB;
constexpr size_t WS_WINA = 32 * MiB, WS_WOUTA = 34 * MiB, WS_WINB = 36 * MiB, WS_WOUTB = 38 * MiB, WS_WMKV = 40 * MiB, WS_WKV = 42 * MiB, WS_WPOOL = 45 * MiB, WS_WR = 47 * MiB;
constexpr size_t WS_MEMB = 48 * MiB, WS_KVMEM = 64 * MiB;
constexpr size_t WS_W1 = 80 * MiB, WS_W2 = 336 * MiB;
constexpr size_t WS_R1 = 464 * MiB, WS_R2 = 592 * MiB;
constexpr size_t WS_ACT = 720 * MiB, WS_Y = 1248 * MiB, WS_H1Q = 1776 * MiB, WS_END = 1840 * MiB;
constexpr size_t WS_PROJ = 720 * MiB, WS_CAT = 848 * MiB, WS_MIX = 976 * MiB, WS_DBUF = 1104 * MiB, WS_KF = 1200 * MiB  , WS_Q8 = 1248 * MiB  , WS_VF = 1296 * MiB;
static_assert(WS_ACT + (size_t)NSLOT_MAX * 2048 <= WS_Y && WS_Y + (size_t)NSLOT_MAX * 2048 <= WS_END, "ws map");
constexpr int CW_BAR = 4096;

constexpr int RING_BYTES = 131072;
constexpr int TAB_OFF = RING_BYTES;
constexpr int MISC_OFF = TAB_OFF + 4608;
constexpr int LDS_BYTES = 147456;
static_assert(MISC_OFF + 128 == pg8::STASH_OFF && pg8::STASH_OFF + 2048 <= LDS_BYTES, "LDS map");

#define RLX_AGENT __ATOMIC_RELAXED, __HIP_MEMORY_SCOPE_AGENT
#define LDS_WAIT() asm volatile("s_waitcnt lgkmcnt(0)" ::: "memory")
#define VM_WAIT() asm volatile("s_waitcnt vmcnt(0)" ::: "memory")

#define XB_TMO      128
#define XB_XCNT(j)  (256  + 64 * (j))
#define XB_XSUB(j)  (1280 + 64 * (j))
#define XB_XGEN(j)  (2304 + 64 * (j))
#define XB_TOP      3328
#define XB_TOPGEN   3392
#define XCD_BAR_WORDS 3456
#define XB_SPIN_CAP (1u << 18)
__device__ __forceinline__ unsigned xb_ld(unsigned* p)              { return __hip_atomic_load(p, __ATOMIC_RELAXED, __HIP_MEMORY_SCOPE_AGENT); }
__device__ __forceinline__ unsigned xb_add(unsigned* p, unsigned v) { return __hip_atomic_fetch_add(p, v, __ATOMIC_RELAXED, __HIP_MEMORY_SCOPE_AGENT); }
__device__ __forceinline__ unsigned xb_xcc_id() { return (unsigned)__builtin_amdgcn_s_getreg((3 << 11) | 20) & 0xFu; }
#define XB_SPIN(cond, bar) do { unsigned _sp = 0; while (cond) { __builtin_amdgcn_s_sleep(1); \
    if ((++_sp & 255u) == 0u) { if (xb_ld(&(bar)[XB_TMO])) break; if (_sp > XB_SPIN_CAP) { atomicAdd(&(bar)[XB_TMO], 1u); break; } } } } while (0)
struct XcdBarrier { unsigned* bar; unsigned x; volatile LAS unsigned* st; };
__device__ __forceinline__ XcdBarrier xcd_barrier_post(unsigned* bar, volatile LAS unsigned* st) {
    XcdBarrier b; b.bar = bar; b.x = xb_xcc_id(); b.st = st;
    if (threadIdx.x == 0) (void)xb_add(&bar[XB_XCNT(b.x)], 1u);
    return b;
}
__device__ __forceinline__ void xcd_barrier_complete(unsigned* bar, unsigned x, unsigned& nloc, unsigned& nx) {
    const unsigned G = gridDim.x * gridDim.y * gridDim.z;
    unsigned sum, cnt, mine, sp = 0u;
    for (;;) {
        sum = 0u; cnt = 0u; mine = 0u;
#pragma unroll
        for (unsigned j = 0; j < 16; ++j) { const unsigned c = xb_ld(&bar[XB_XCNT(j)]); sum += c; cnt += (c > 0u) ? 1u : 0u; mine = (j == x) ? c : mine; }
        if (sum == G) break;
        __builtin_amdgcn_s_sleep(1);
        if ((++sp & 255u) == 0u) { if (xb_ld(&bar[XB_TMO])) break; if (sp > XB_SPIN_CAP) { atomicAdd(&bar[XB_TMO], 1u); break; } }
    }
    nloc = mine > 0u ? mine : 1u; nx = cnt > 0u ? cnt : 1u;
}
__device__ __forceinline__ void xcd_barrier(const XcdBarrier& b) {
    asm volatile("s_waitcnt vmcnt(0)" ::: "memory");
    __syncthreads();
    if (threadIdx.x == 0) {
        unsigned* bar = b.bar;
        __builtin_amdgcn_s_waitcnt(0);
        unsigned nloc = b.st[0], nx = b.st[1];
        if (nloc == 0u) { xcd_barrier_complete(bar, b.x, nloc, nx); b.st[0] = nloc; b.st[1] = nx; }
        const unsigned old = xb_add(&bar[XB_XSUB(b.x)], 1u);
        const unsigned gen = old / nloc;
        if (old + 1u == (gen + 1u) * nloc) {
            __builtin_amdgcn_fence(__ATOMIC_RELEASE, "agent");
            asm volatile("s_waitcnt vmcnt(0)" ::: "memory");
            const unsigned og = xb_add(&bar[XB_TOP], 1u);
            const unsigned tg = og / nx;
            if (og + 1u == (tg + 1u) * nx) xb_add(&bar[XB_TOPGEN], 1u);
            else XB_SPIN(xb_ld(&bar[XB_TOPGEN]) == tg, bar);
            __builtin_amdgcn_fence(__ATOMIC_ACQUIRE, "agent");
            xb_add(&bar[XB_XGEN(b.x)], 1u);
            asm volatile("s_waitcnt vmcnt(0)" ::: "memory");
        } else {
            XB_SPIN(xb_ld(&bar[XB_XGEN(b.x)]) == gen, bar);
            __builtin_amdgcn_fence(__ATOMIC_ACQUIRE, "agent");
            asm volatile("s_waitcnt vmcnt(0)" ::: "memory");
        }
    }
    __syncthreads();
}

__device__ __forceinline__ float wave_sum(float v) {
#define WS_DPP(x, ctrl) __int_as_float(__builtin_amdgcn_update_dpp(0, __float_as_int(x), (ctrl), 0xf, 0xf, false))
    v += WS_DPP(v, 0x128); v += WS_DPP(v, 0x124); v += WS_DPP(v, 0x122); v += WS_DPP(v, 0x121);
#undef WS_DPP
    { const auto rr = __builtin_amdgcn_permlane16_swap(__float_as_uint(v), __float_as_uint(v), false, false); v = __uint_as_float(rr[0]) + __uint_as_float(rr[1]); }
    { const auto rr = __builtin_amdgcn_permlane32_swap(__float_as_uint(v), __float_as_uint(v), false, false); v = __uint_as_float(rr[0]) + __uint_as_float(rr[1]); }
    return v;
}

template <int MODE>
__device__ __forceinline__ void tr_item(const float* W, int ldn, bf16_t* WT, int dld, int row_off, int col_off, LAS float* scr, int k0, int n0, int lane) {
    {
        f32x4 t[8];
#pragma unroll
        for (int i = 0; i < 8; ++i) t[i] = *(const f32x4*)(W + (size_t)(k0 + 8 * i + (lane >> 3)) * ldn + n0 + 4 * (lane & 7));
#pragma unroll
        for (int i = 0; i < 8; ++i) { LAS float* d = scr + (8 * i + (lane >> 3)) * 33 + 4 * (lane & 7); d[0] = t[i][0]; d[1] = t[i][1]; d[2] = t[i][2]; d[3] = t[i][3]; }
    }
    LDS_WAIT(); asm volatile("" ::: "memory");
    const int c = lane & 7;
#pragma unroll
    for (int j = 0; j < 4; ++j) { const int n = (lane >> 3) + 8 * j; const LAS float* s = scr + (8 * c) * 33 + n;
        float f[8];
#pragma unroll
        for (int q = 0; q < 8; ++q) f[q] = s[q * 33];
        u32x4 o; o.x = cvt_pk_bf16(f[0], f[1]); o.y = cvt_pk_bf16(f[2], f[3]); o.z = cvt_pk_bf16(f[4], f[5]); o.w = cvt_pk_bf16(f[6], f[7]);
        const int nn = n0 + n;
        const int drow = (MODE == 1) ? ((nn & ~255) + 128 * (nn & 1) + ((nn & 255) >> 1)) : (row_off + nn);
        *(u32x4*)(WT + (size_t)drow * dld + col_off + k0 + 8 * c) = o;
        if (MODE == 2) {
            u32x4 l; l.x = cvt_pk_bf16(f[0] - bf_lo(o.x), f[1] - bf_hi(o.x)); l.y = cvt_pk_bf16(f[2] - bf_lo(o.y), f[3] - bf_hi(o.y));
            l.z = cvt_pk_bf16(f[4] - bf_lo(o.z), f[5] - bf_hi(o.z)); l.w = cvt_pk_bf16(f[6] - bf_lo(o.w), f[7] - bf_hi(o.w));
            *(u32x4*)(WT + (size_t)(drow + 32) * dld + col_off + k0 + 8 * c) = l;
        }
    }
    LDS_WAIT(); asm volatile("" ::: "memory");
}

template <bool PERMW>
__device__ __forceinline__ void tr_item8(const float* W, int ldn, unsigned char* WT, int dld, LAS float* scr, int k0, int n0, int lane) {
    {
        f32x4 t[8];
#pragma unroll
        for (int i = 0; i < 8; ++i) t[i] = *(const f32x4*)(W + (size_t)(k0 + 8 * i + (lane >> 3)) * ldn + n0 + 4 * (lane & 7));
#pragma unroll
        for (int i = 0; i < 8; ++i) { LAS float* d = scr + (8 * i + (lane >> 3)) * 33 + 4 * (lane & 7); d[0] = t[i][0]; d[1] = t[i][1]; d[2] = t[i][2]; d[3] = t[i][3]; }
    }
    LDS_WAIT(); asm volatile("" ::: "memory");
    const int c = lane & 3;
#pragma unroll
    for (int j = 0; j < 2; ++j) { const int n = (lane >> 2) + 16 * j; const LAS float* s = scr + (16 * c) * 33 + n;
        float f[16];
#pragma unroll
        for (int q = 0; q < 16; ++q) f[q] = s[q * 33] * pg8::W8_SCALE;
        u32x4 o; o.x = pg8::pk_fp8x4(f[0], f[1], f[2], f[3]); o.y = pg8::pk_fp8x4(f[4], f[5], f[6], f[7]); o.z = pg8::pk_fp8x4(f[8], f[9], f[10], f[11]); o.w = pg8::pk_fp8x4(f[12], f[13], f[14], f[15]);
        const int nn = n0 + n;
        const int drow = PERMW ? ((nn & ~255) + 128 * (nn & 1) + ((nn & 255) >> 1)) : nn;
        *(u32x4*)(WT + (size_t)drow * dld + k0 + 16 * c) = o;
    }
    LDS_WAIT(); asm volatile("" ::: "memory");
}

struct Args {
    const float* in[22]; float* out; unsigned char* ws; int ph_lo, ph_hi;
};

__device__ __forceinline__ void f32_to_bf16_rows(const float* __restrict__ src, bf16_t* __restrict__ dst, size_t n4, size_t gt, size_t ngt) {
    size_t i = gt;
    for (; i + 7 * ngt < n4; i += 8 * ngt) { f32x4 a[8];
#pragma unroll
        for (int u = 0; u < 8; ++u) a[u] = *(const f32x4*)(src + (i + u * ngt) * 4);
#pragma unroll
        for (int u = 0; u < 8; ++u) { u32x2 o; o.x = cvt_pk_bf16(a[u][0], a[u][1]); o.y = cvt_pk_bf16(a[u][2], a[u][3]); *(u32x2*)(dst + (i + u * ngt) * 4) = o; } }
    for (; i < n4; i += ngt) { const f32x4 a = *(const f32x4*)(src + i * 4); u32x2 o; o.x = cvt_pk_bf16(a[0], a[1]); o.y = cvt_pk_bf16(a[2], a[3]); *(u32x2*)(dst + i * 4) = o; }
}

__device__ __forceinline__ void p0_prologue(const Args& a, LAS unsigned char* lds, int wave, int lane) {
    unsigned char* ws = a.ws;
    LAS float* scr = (LAS float*)(lds + wave * 16384);
    const int G = gridDim.x, gw = blockIdx.x * NWAVES + wave, NGW = G * NWAVES;
    const size_t gt = (size_t)blockIdx.x * NTHR + threadIdx.x, ngt = (size_t)G * NTHR;
    constexpr int I_SQ = 16 * 32, I_MKV = 16 * 16, I_KV = 16 * 48, I_R = 16, I_POOL = 3 * 6, I_W1 = 16 * 64, I_W2 = 16 * 32;
    constexpr int NIT = 4 * I_SQ + 2 * I_MKV + I_KV + 2 * I_R + 4 * I_POOL + 64 * I_W1 + 64 * I_W2;
    for (int it = gw; it < NIT; it += NGW) {
        int r = it;
        if (r < 4 * I_SQ) { const int w = r / I_SQ; r -= w * I_SQ; const float* src = a.in[w == 0 ? 6 : (w == 1 ? 10 : (w == 2 ? 13 : 15))];
            bf16_t* dst = (bf16_t*)(ws + (w == 0 ? WS_WINA : (w == 1 ? WS_WOUTA : (w == 2 ? WS_WINB : WS_WOUTB))));
            if (w == 1 && r < 12 * 32) continue;
            if (w == 2) { tr_item8<false>(src, 1024, (unsigned char*)dst, 1024, scr, 64 * (r / 32), 32 * (r % 32), lane); continue; }
            tr_item<0>(src, 1024, dst, 1024, 0, 0, scr, 64 * (r / 32), 32 * (r % 32), lane); continue; }
        r -= 4 * I_SQ;
        if (r < 2 * I_MKV) { const int w = r / I_MKV; r -= w * I_MKV;
            tr_item8<false>(a.in[w == 0 ? 9 : 14], 512, ws + WS_WMKV + (size_t)512 * w * 1024, 1024, scr, 64 * (r / 16), 32 * (r % 16), lane); continue; }
        r -= 2 * I_MKV;
        if (r < I_KV) { tr_item8<false>(a.in[11], 1548, ws + WS_WKV, 1024, scr, 64 * (r / 48), 32 * (r % 48), lane); continue; }
        r -= I_KV;
        if (r < 2 * I_R) { const int l = r / I_R; r -= l * I_R;
            tr_item<2>(a.in[16] + (size_t)l * 1024 * 32, 32, (bf16_t*)(ws + WS_WR) + (size_t)l * 256 * 1024, 1024, 0, 0, scr, 64 * r, 0, lane); continue; }
        r -= 2 * I_R;
        if (r < 4 * I_POOL) continue;
        r -= 4 * I_POOL;
        if (r < 64 * I_W1) { const int le = r / I_W1; r -= le * I_W1;
            tr_item8<true>(a.in[18] + (size_t)le * 1024 * 2048, 2048, ws + WS_W1 + (size_t)le * 2048 * 1024, 1024, scr, 64 * (r / 64), 32 * (r % 64), lane); continue; }
        r -= 64 * I_W1;
        { const int le = r / I_W2; r -= le * I_W2;
            tr_item8<false>(a.in[20] + (size_t)le * 1024 * 1024, 1024, ws + WS_W2 + (size_t)le * 1024 * 1024, 1024, scr, 64 * (r / 32), 32 * (r % 32), lane); }
    }
    f32_to_bf16_rows(a.in[0], (bf16_t*)(ws + WS_R1), (size_t)T * D / 4, gt, ngt);
    for (size_t i = gt; i < (size_t)NB * MEMT * D / 4; i += ngt) { const f32x4 v = *(const f32x4*)(a.in[1] + i * 4); *(unsigned*)(ws + WS_MEMB + i * 4) = pg8::pk_fp8x4(v[0], v[1], v[2], v[3]); }
    {
      bf16_t* wo = (bf16_t*)(ws + WS_WOUTA); const float* pw = a.in[7]; const float* psc = a.in[8]; const float* wout = a.in[10];
      for (size_t i = gt; i < (size_t)4 * 96 * 256; i += ngt) { const int n4 = (int)(i & 255), kk = (int)(i >> 8), g = kk / 96, c2 = kk % 96;
          const float* p0 = pw + ((size_t)g * 192 + 2 * c2) * 192; const float* p1 = p0 + 192; const float* sr = psc + g * 192; const float* wc = wout + (size_t)g * 192 * 1024 + 4 * n4;
          f32x4 a0 = {0.f, 0.f, 0.f, 0.f}, a1 = {0.f, 0.f, 0.f, 0.f};
#pragma unroll 4
          for (int j = 0; j < 192; j += 4) { const f32x4 q0 = *(const f32x4*)(p0 + j), q1 = *(const f32x4*)(p1 + j), sv = *(const f32x4*)(sr + j);
#pragma unroll
              for (int r = 0; r < 4; ++r) { const f32x4 w = *(const f32x4*)(wc + (size_t)(j + r) * 1024); a0 += w * (q0[r] * sv[r]); a1 += w * (q1[r] * sv[r]); } }
          const int k = g * 192 + 2 * c2;
#pragma unroll
          for (int r = 0; r < 4; ++r) *(unsigned*)(wo + (size_t)(4 * n4 + r) * 1024 + k) = cvt_pk_bf16(a0[r], a1[r]); }
      bf16_t* wr = (bf16_t*)(ws + WS_WR);
      for (size_t i = gt; i < (size_t)2 * 64 * 128; i += ngt) { const int l = (int)(i / (64 * 128)), rr = (int)((i / 128) % 64), ch = (int)(i % 128);
          const int row = 64 + rr;
          *(u32x4*)(wr + ((size_t)l * 256 + row) * 1024 + ch * 8) = (u32x4){0u, 0u, 0u, 0u}; } }
    { float* b1p = (float*)(ws + WS_B1P); const float* b1 = a.in[19];
      for (size_t i = gt; i < (size_t)2 * 32 * 2048; i += ngt) { const int np = (int)(i & 2047); const size_t le = i >> 11;
          const int orig = 2 * (128 * (np >> 8) + (np & 127)) + ((np >> 7) & 1); b1p[i] = b1[le * 2048 + orig]; }
      float* gwt = (float*)(ws + WS_GWT); const float* kvw = a.in[11];
      for (size_t i = gt; i < (size_t)12 * 1024; i += ngt) { const int j = (int)(i / 1024), k = (int)(i % 1024); gwt[i] = kvw[(size_t)k * 1548 + 1536 + j]; } }
}

__device__ __forceinline__ void pool_d_phase(const bf16_t* proj, bf16_t* dbuf) {
    const size_t gt = (size_t)blockIdx.x * NTHR + threadIdx.x, ngt = (size_t)gridDim.x * NTHR;
    for (size_t id = gt; id < (size_t)1024 * 96; id += ngt) {
        const int cc = (int)(id % 96), seg = (int)(id / 96), b = seg >> 5, s0 = (seg & 31) * 64, g = cc / 24, w = 2 << g;
        const bf16_t* up = proj + (size_t)b * S * 1024 + cc * 8; bf16_t* dp = dbuf + (size_t)b * S * 1024 + cc * 8;
        float sum[8];
#pragma unroll
        for (int q = 0; q < 8; ++q) sum[q] = 0.f;
        {
            u32x4 pre[16];
#pragma unroll
            for (int k = 0; k < 16; ++k) { const int r = s0 - 16 + k; const bool ok = (r >= s0 - w) && (r >= 0); pre[k] = *(const u32x4*)(up + (size_t)(ok ? r : 0) * 1024); }
#pragma unroll
            for (int k = 0; k < 16; ++k) { const int r = s0 - 16 + k; if ((r >= s0 - w) && (r >= 0)) { const u32x4 v = pre[k];
                sum[0] += bf_lo(v.x); sum[1] += bf_hi(v.x); sum[2] += bf_lo(v.y); sum[3] += bf_hi(v.y); sum[4] += bf_lo(v.z); sum[5] += bf_hi(v.z); sum[6] += bf_lo(v.w); sum[7] += bf_hi(v.w); } }
        }
        for (int t0 = s0; t0 < s0 + 64; t0 += 8) {
            u32x4 vt[8], vo[8];
#pragma unroll
            for (int k = 0; k < 8; ++k) vt[k] = *(const u32x4*)(up + (size_t)(t0 + k) * 1024);
#pragma unroll
            for (int k = 0; k < 8; ++k) { const int to = t0 + k - w; vo[k] = *(const u32x4*)(up + (size_t)(to >= 0 ? to : 0) * 1024); }
#pragma unroll
            for (int k = 0; k < 8; ++k) { const int t = t0 + k; const u32x4 v = vt[k];
                float ut[8] = {bf_lo(v.x), bf_hi(v.x), bf_lo(v.y), bf_hi(v.y), bf_lo(v.z), bf_hi(v.z), bf_lo(v.w), bf_hi(v.w)};
#pragma unroll
                for (int q = 0; q < 8; ++q) sum[q] += ut[q];
                if (t - w >= 0) { const u32x4 o = vo[k];
                    sum[0] -= bf_lo(o.x); sum[1] -= bf_hi(o.x); sum[2] -= bf_lo(o.y); sum[3] -= bf_hi(o.y); sum[4] -= bf_lo(o.z); sum[5] -= bf_hi(o.z); sum[6] -= bf_lo(o.w); sum[7] -= bf_hi(o.w); }
                const float inv = 1.0f / (float)((t + 1) < w ? (t + 1) : w);
                float d[8];
#pragma unroll
                for (int q = 0; q < 8; ++q) d[q] = sum[q] * inv - ut[q];
                u32x4 o; o.x = cvt_pk_bf16(d[0], d[1]); o.y = cvt_pk_bf16(d[2], d[3]); o.z = cvt_pk_bf16(d[4], d[5]); o.w = cvt_pk_bf16(d[6], d[7]);
                *(u32x4*)(dp + (size_t)t * 1024) = o; }
        }
    }
}

typedef float f32x16 __attribute__((ext_vector_type(16)));
typedef short v4i16_t __attribute__((ext_vector_type(4)));
constexpr int ATT_SLOT = 16384, ATT_NSLOT = 4, ATT_C_OFF = ATT_NSLOT * ATT_SLOT  , ATT_W_OFF = ATT_C_OFF + 8192  , ATT_LDS = ATT_W_OFF + 64;
static_assert(ATT_LDS <= RING_BYTES, "attention LDS map");
constexpr float ATT_L2E = 1.4426950408889634f, ATT_C2 = 0.125f * 1.4426950408889634f, ATT_THR = 8.0f;

template <bool FOX>
__device__ __forceinline__ void att_tile(const LAS unsigned char* sb, f32x16& s0, f32x16& s1, const bf16x8 (&qf)[4], f32x16& O0, f32x16& O1, float& m, float& l,
                                         int kt, int qrow, bool diag, int h2, int kfo, int vfo) {
    __builtin_amdgcn_sched_barrier(0);
#pragma unroll
    for (int ks = 0; ks < 4; ++ks) {
        const bf16x8 k0 = *(const LAS bf16x8*)(sb + kfo + ks * 2048), k1 = *(const LAS bf16x8*)(sb + kfo + ks * 2048 + 512);
        s0 = __builtin_amdgcn_mfma_f32_32x32x16_bf16(k0, qf[ks], s0, 0, 0, 0); s1 = __builtin_amdgcn_mfma_f32_32x32x16_bf16(k1, qf[ks], s1, 0, 0, 0); }
    __builtin_amdgcn_sched_barrier(0);
    const unsigned va_ = (unsigned)(unsigned long)(sb + vfo);
    v4i16_t tv[2][4][2];
#define ATT_TR(dst, off) asm volatile("ds_read_b64_tr_b16 %0, %1 offset:%2" : "=v"(dst) : "v"(va_), "i"(off) : "memory")
    ATT_TR(tv[0][0][0], 0 * 4096 + 0 * 1024);    ATT_TR(tv[0][0][1], 0 * 4096 + 0 * 1024 + 512);
    ATT_TR(tv[0][1][0], 0 * 4096 + 1 * 1024);    ATT_TR(tv[0][1][1], 0 * 4096 + 1 * 1024 + 512);
    ATT_TR(tv[0][2][0], 0 * 4096 + 2 * 1024);    ATT_TR(tv[0][2][1], 0 * 4096 + 2 * 1024 + 512);
    ATT_TR(tv[0][3][0], 0 * 4096 + 3 * 1024);    ATT_TR(tv[0][3][1], 0 * 4096 + 3 * 1024 + 512);
    ATT_TR(tv[1][0][0], 1 * 4096 + 0 * 1024);    ATT_TR(tv[1][0][1], 1 * 4096 + 0 * 1024 + 512);
    ATT_TR(tv[1][1][0], 1 * 4096 + 1 * 1024);    ATT_TR(tv[1][1][1], 1 * 4096 + 1 * 1024 + 512);
    ATT_TR(tv[1][2][0], 1 * 4096 + 2 * 1024);    ATT_TR(tv[1][2][1], 1 * 4096 + 2 * 1024 + 512);
    ATT_TR(tv[1][3][0], 1 * 4096 + 3 * 1024);    ATT_TR(tv[1][3][1], 1 * 4096 + 3 * 1024 + 512);
#undef ATT_TR
    if (FOX && diag) {
#pragma unroll
        for (int r = 0; r < 16; ++r) { const int key = kt * 64 + (r & 3) + 8 * (r >> 2) + 4 * h2;
            s0[r] = (key > qrow) ? -INFINITY : s0[r]; s1[r] = (key + 32 > qrow) ? -INFINITY : s1[r]; }
    }
    float ta = fmaxf(fmaxf(s0[0], s0[1]), s1[0]), tb = fmaxf(fmaxf(s0[2], s0[3]), s1[1]); ta = fmaxf(fmaxf(ta, s1[2]), s1[3]);
#pragma unroll
    for (int r = 4; r < 16; r += 4) { ta = fmaxf(fmaxf(ta, s0[r]), s0[r + 1]); tb = fmaxf(fmaxf(tb, s0[r + 2]), s0[r + 3]); ta = fmaxf(fmaxf(ta, s1[r]), s1[r + 1]); tb = fmaxf(fmaxf(tb, s1[r + 2]), s1[r + 3]); }
    float tmax = fmaxf(ta, tb);
    { const auto rr = __builtin_amdgcn_permlane32_swap(__float_as_uint(tmax), __float_as_uint(tmax), false, false); tmax = fmaxf(__uint_as_float(rr[0]), __uint_as_float(rr[1])); }
    if (__any(tmax > m + ATT_THR)) {
        const float mn = fmaxf(m, tmax), alpha = __builtin_amdgcn_exp2f(m - mn); m = mn; l *= alpha;
#pragma unroll
        for (int r = 0; r < 16; ++r) { O0[r] *= alpha; O1[r] *= alpha; }
    }
    float ps = 0.f;
#pragma unroll
    for (int r = 0; r < 16; ++r) { s0[r] = __builtin_amdgcn_exp2f(s0[r] - m); s1[r] = __builtin_amdgcn_exp2f(s1[r] - m); ps += s0[r] + s1[r]; }
    l += ps;
    bf16x8 pf[2][2];
#pragma unroll
    for (int sp = 0; sp < 2; ++sp) { u32x4 a, b;
        a.x = cvt_pk_bf16(s0[8 * sp + 0], s0[8 * sp + 1]); a.y = cvt_pk_bf16(s0[8 * sp + 2], s0[8 * sp + 3]); a.z = cvt_pk_bf16(s0[8 * sp + 4], s0[8 * sp + 5]); a.w = cvt_pk_bf16(s0[8 * sp + 6], s0[8 * sp + 7]);
        b.x = cvt_pk_bf16(s1[8 * sp + 0], s1[8 * sp + 1]); b.y = cvt_pk_bf16(s1[8 * sp + 2], s1[8 * sp + 3]); b.z = cvt_pk_bf16(s1[8 * sp + 4], s1[8 * sp + 5]); b.w = cvt_pk_bf16(s1[8 * sp + 6], s1[8 * sp + 7]);
        pf[0][sp] = __builtin_bit_cast(bf16x8, a); pf[1][sp] = __builtin_bit_cast(bf16x8, b); }
    __builtin_amdgcn_sched_barrier(0);
    asm volatile("s_waitcnt lgkmcnt(0)" ::: "memory");
    __builtin_amdgcn_sched_barrier(0);
#pragma unroll
    for (int kb = 0; kb < 2; ++kb)
#pragma unroll
        for (int sp = 0; sp < 2; ++sp) { const int ki = 2 * kb + sp;
            const v4i16_t a0 = tv[0][ki][0], a1 = tv[0][ki][1], b0 = tv[1][ki][0], b1 = tv[1][ki][1];
            const bf16x8 va = (bf16x8){a0[0], a0[1], a0[2], a0[3], a1[0], a1[1], a1[2], a1[3]}, vb = (bf16x8){b0[0], b0[1], b0[2], b0[3], b1[0], b1[1], b1[2], b1[3]};
            O0 = __builtin_amdgcn_mfma_f32_32x32x16_bf16(va, pf[kb][sp], O0, 0, 0, 0); O1 = __builtin_amdgcn_mfma_f32_32x32x16_bf16(vb, pf[kb][sp], O1, 0, 0, 0); }
    __builtin_amdgcn_sched_barrier(0);
}
__device__ __forceinline__ void att_load_q(bf16x8 (&qf)[4], const bf16_t* Qrow, int h2) {
    u32x4 qraw[4];
#pragma unroll
    for (int ks = 0; ks < 4; ++ks) qraw[ks] = *(const u32x4*)(Qrow + 16 * ks + 8 * h2);
#pragma unroll
    for (int ks = 0; ks < 4; ++ks) { const u32x4 w = qraw[ks];
        u32x4 o; o.x = cvt_pk_bf16(ATT_C2 * bf_lo(w.x), ATT_C2 * bf_hi(w.x)); o.y = cvt_pk_bf16(ATT_C2 * bf_lo(w.y), ATT_C2 * bf_hi(w.y));
        o.z = cvt_pk_bf16(ATT_C2 * bf_lo(w.z), ATT_C2 * bf_hi(w.z)); o.w = cvt_pk_bf16(ATT_C2 * bf_lo(w.w), ATT_C2 * bf_hi(w.w)); qf[ks] = __builtin_bit_cast(bf16x8, o); }
}
__device__ __forceinline__ void att_store_o(bf16_t* op, const f32x16& O0, const f32x16& O1, float l) {
    { const auto rr = __builtin_amdgcn_permlane32_swap(__float_as_uint(l), __float_as_uint(l), false, false); l = __uint_as_float(rr[0]) + __uint_as_float(rr[1]); }
    const float il = 1.0f / l;
#pragma unroll
    for (int g = 0; g < 4; ++g) { u32x2 w0, w1;
        w0.x = cvt_pk_bf16(O0[4 * g + 0] * il, O0[4 * g + 1] * il); w0.y = cvt_pk_bf16(O0[4 * g + 2] * il, O0[4 * g + 3] * il);
        w1.x = cvt_pk_bf16(O1[4 * g + 0] * il, O1[4 * g + 1] * il); w1.y = cvt_pk_bf16(O1[4 * g + 2] * il, O1[4 * g + 3] * il);
        *(u32x2*)(op + 8 * g) = w0; *(u32x2*)(op + 32 + 8 * g) = w1; }
}
constexpr float ATT_S8 = 16.0f;
typedef int i32x8a __attribute__((ext_vector_type(8)));
typedef int i32x4a __attribute__((ext_vector_type(4)));
__device__ __forceinline__ void att_tile8(const LAS unsigned char* sb, f32x16& s0, f32x16& s1, const i32x8a qf8, f32x16& O0, f32x16& O1, float& m, float& l,
                                          int kt, int qrow, bool diag, int h2, int ql, int vfo) {
    __builtin_amdgcn_sched_barrier(0);
    {   const int sw = (ql >> 2) & 3;
        const LAS unsigned char* k0p = sb + ql * 64; const LAS unsigned char* k1p = k0p + 32 * 64;
        const int c0 = ((2 * h2) ^ sw) * 16, c1 = ((2 * h2 + 1) ^ sw) * 16;
        const i32x4a a00 = *(const LAS i32x4a*)(k0p + c0), a01 = *(const LAS i32x4a*)(k0p + c1), a10 = *(const LAS i32x4a*)(k1p + c0), a11 = *(const LAS i32x4a*)(k1p + c1);
        const i32x8a ka = __builtin_shufflevector(a00, a01, 0, 1, 2, 3, 4, 5, 6, 7), kb = __builtin_shufflevector(a10, a11, 0, 1, 2, 3, 4, 5, 6, 7);
        s0 = __builtin_amdgcn_mfma_scale_f32_32x32x64_f8f6f4(ka, qf8, s0, 0, 0, 0, 0, 0, 0);
        s1 = __builtin_amdgcn_mfma_scale_f32_32x32x64_f8f6f4(kb, qf8, s1, 0, 0, 0, 0, 0, 0); }
    __builtin_amdgcn_sched_barrier(0);
    const unsigned va_ = (unsigned)(unsigned long)(sb + vfo);
    v4i16_t tv[2][4][2];
#define ATT_TR(dst, off) asm volatile("ds_read_b64_tr_b16 %0, %1 offset:%2" : "=v"(dst) : "v"(va_), "i"(off) : "memory")
    ATT_TR(tv[0][0][0], 0 * 4096 + 0 * 1024);    ATT_TR(tv[0][0][1], 0 * 4096 + 0 * 1024 + 512);
    ATT_TR(tv[0][1][0], 0 * 4096 + 1 * 1024);    ATT_TR(tv[0][1][1], 0 * 4096 + 1 * 1024 + 512);
    ATT_TR(tv[0][2][0], 0 * 4096 + 2 * 1024);    ATT_TR(tv[0][2][1], 0 * 4096 + 2 * 1024 + 512);
    ATT_TR(tv[0][3][0], 0 * 4096 + 3 * 1024);    ATT_TR(tv[0][3][1], 0 * 4096 + 3 * 1024 + 512);
    ATT_TR(tv[1][0][0], 1 * 4096 + 0 * 1024);    ATT_TR(tv[1][0][1], 1 * 4096 + 0 * 1024 + 512);
    ATT_TR(tv[1][1][0], 1 * 4096 + 1 * 1024);    ATT_TR(tv[1][1][1], 1 * 4096 + 1 * 1024 + 512);
    ATT_TR(tv[1][2][0], 1 * 4096 + 2 * 1024);    ATT_TR(tv[1][2][1], 1 * 4096 + 2 * 1024 + 512);
    ATT_TR(tv[1][3][0], 1 * 4096 + 3 * 1024);    ATT_TR(tv[1][3][1], 1 * 4096 + 3 * 1024 + 512);
#undef ATT_TR
    if (diag) {
#pragma unroll
        for (int r = 0; r < 16; ++r) { const int key = kt * 64 + (r & 3) + 8 * (r >> 2) + 4 * h2;
            s0[r] = (key > qrow) ? -INFINITY : s0[r]; s1[r] = (key + 32 > qrow) ? -INFINITY : s1[r]; }
    }
    float ta = fmaxf(fmaxf(s0[0], s0[1]), s1[0]), tb = fmaxf(fmaxf(s0[2], s0[3]), s1[1]); ta = fmaxf(fmaxf(ta, s1[2]), s1[3]);
#pragma unroll
    for (int r = 4; r < 16; r += 4) { ta = fmaxf(fmaxf(ta, s0[r]), s0[r + 1]); tb = fmaxf(fmaxf(tb, s0[r + 2]), s0[r + 3]); ta = fmaxf(fmaxf(ta, s1[r]), s1[r + 1]); tb = fmaxf(fmaxf(tb, s1[r + 2]), s1[r + 3]); }
    float tmax = fmaxf(ta, tb);
    { const auto rr = __builtin_amdgcn_permlane32_swap(__float_as_uint(tmax), __float_as_uint(tmax), false, false); tmax = fmaxf(__uint_as_float(rr[0]), __uint_as_float(rr[1])); }
    if (__any(tmax > m + ATT_THR * ATT_S8)) {
        const float mn = fmaxf(m, tmax), alpha = __builtin_amdgcn_exp2f((m - mn) * (1.0f / ATT_S8)); m = mn; l *= alpha;
#pragma unroll
        for (int r = 0; r < 16; ++r) { O0[r] *= alpha; O1[r] *= alpha; }
    }
    const float nm = -m * (1.0f / ATT_S8);
    float ps = 0.f;
#pragma unroll
    for (int r = 0; r < 16; ++r) { s0[r] = __builtin_amdgcn_exp2f(fmaf(s0[r], 1.0f / ATT_S8, nm)); s1[r] = __builtin_amdgcn_exp2f(fmaf(s1[r], 1.0f / ATT_S8, nm)); ps += s0[r] + s1[r]; }
    l += ps;
    bf16x8 pf[2][2];
#pragma unroll
    for (int sp = 0; sp < 2; ++sp) { u32x4 a, b;
        a.x = cvt_pk_bf16(s0[8 * sp + 0], s0[8 * sp + 1]); a.y = cvt_pk_bf16(s0[8 * sp + 2], s0[8 * sp + 3]); a.z = cvt_pk_bf16(s0[8 * sp + 4], s0[8 * sp + 5]); a.w = cvt_pk_bf16(s0[8 * sp + 6], s0[8 * sp + 7]);
        b.x = cvt_pk_bf16(s1[8 * sp + 0], s1[8 * sp + 1]); b.y = cvt_pk_bf16(s1[8 * sp + 2], s1[8 * sp + 3]); b.z = cvt_pk_bf16(s1[8 * sp + 4], s1[8 * sp + 5]); b.w = cvt_pk_bf16(s1[8 * sp + 6], s1[8 * sp + 7]);
        pf[0][sp] = __builtin_bit_cast(bf16x8, a); pf[1][sp] = __builtin_bit_cast(bf16x8, b); }
    __builtin_amdgcn_sched_barrier(0);
    asm volatile("s_waitcnt lgkmcnt(0)" ::: "memory");
    __builtin_amdgcn_sched_barrier(0);
#pragma unroll
    for (int kb = 0; kb < 2; ++kb)
#pragma unroll
        for (int sp = 0; sp < 2; ++sp) { const int ki = 2 * kb + sp;
            const v4i16_t a0 = tv[0][ki][0], a1 = tv[0][ki][1], b0 = tv[1][ki][0], b1 = tv[1][ki][1];
            const bf16x8 va = (bf16x8){a0[0], a0[1], a0[2], a0[3], a1[0], a1[1], a1[2], a1[3]}, vb = (bf16x8){b0[0], b0[1], b0[2], b0[3], b1[0], b1[1], b1[2], b1[3]};
            O0 = __builtin_amdgcn_mfma_f32_32x32x16_bf16(va, pf[kb][sp], O0, 0, 0, 0); O1 = __builtin_amdgcn_mfma_f32_32x32x16_bf16(vb, pf[kb][sp], O1, 0, 0, 0); }
    __builtin_amdgcn_sched_barrier(0);
}
__device__ __forceinline__ void attn_unit_fox2(const unsigned char* Q8, const unsigned char* K8, const bf16_t* Vp, bf16_t* Op, int qA, int qB, LAS unsigned char* lds) {
    int tid = threadIdx.x; asm volatile("" : "+v"(tid));
    const int lane = tid & 63, wave = __builtin_amdgcn_readfirstlane(tid >> 6), ql = lane & 31, h2 = lane >> 5;
    const LAS float* ncl = (const LAS float*)(lds + ATT_C_OFF);
    const int q0A = 256 * qA, q0B = 256 * qB, nkt = 4 * qA + 4, nktB = 4 * qB + 4;
    const int qrowA = q0A + 32 * wave + ql, qrowB = q0B + 32 * wave + ql;
    const int kkey = 16 * (wave & 3) + (lane >> 2);
    const unsigned char* ksrc = K8 + (size_t)kkey * 768 + 16 * ((lane & 3) ^ ((kkey >> 2) & 3));
    const bf16_t* vsrc = Vp + (size_t)(16 * (wave & 3) + (lane >> 2)) * 768 + 32 * (wave >> 2) + 8 * (lane & 3);
    const bool kwave = wave < 4;
#define ATT_DMA(t, slot) do { if (kwave) __builtin_amdgcn_global_load_lds((const unsigned*)(ksrc + (size_t)(t) * 64 * 768), (LAS unsigned*)(lds + (slot) * ATT_SLOT + wave * 1024), 16, 0, 0); \
                              __builtin_amdgcn_global_load_lds((const unsigned*)(vsrc + (size_t)(t) * 64 * 768), (LAS unsigned*)(lds + (slot) * ATT_SLOT + 8192 + wave * 1024), 16, 0, 0); } while (0)
    i32x8a qfA, qfB;
    { const i32x4a a0 = *(const i32x4a*)(Q8 + (size_t)qrowA * 768 + 32 * h2), a1 = *(const i32x4a*)(Q8 + (size_t)qrowA * 768 + 32 * h2 + 16);
      const i32x4a b0 = *(const i32x4a*)(Q8 + (size_t)qrowB * 768 + 32 * h2), b1 = *(const i32x4a*)(Q8 + (size_t)qrowB * 768 + 32 * h2 + 16);
      qfA = __builtin_shufflevector(a0, a1, 0, 1, 2, 3, 4, 5, 6, 7); qfB = __builtin_shufflevector(b0, b1, 0, 1, 2, 3, 4, 5, 6, 7); }
    ATT_DMA(0, 0);
    ATT_DMA(1, 1);
    f32x16 OA0, OA1, OB0, OB1;
#pragma unroll
    for (int r = 0; r < 16; ++r) { OA0[r] = 0.f; OA1[r] = 0.f; OB0[r] = 0.f; OB1[r] = 0.f; }
    float mA = -1e30f, lA = 0.f, mB = -1e30f, lB = 0.f;
    const int vfo = 8192 + (4 * h2 + ((lane & 15) >> 2)) * 64 + ((lane >> 4) & 1) * 32 + (lane & 3) * 8;
    const int lastA = (q0A + 32 * wave + 31) >> 6, lastB = (q0B + 32 * wave + 31) >> 6;
    int pair = 0;
    for (int kt0 = 0; kt0 < nkt; kt0 += 2) {
        asm volatile("s_waitcnt vmcnt(0)" ::: "memory");
        __builtin_amdgcn_s_barrier();
        asm volatile("" ::: "memory");
        if (kt0 + 2 < nkt) { ATT_DMA(kt0 + 2, 2 * (pair ^ 1)); ATT_DMA(kt0 + 3, 2 * (pair ^ 1) + 1); }
#pragma unroll 1
        for (int sub = 0; sub < 2; ++sub) { const int kt = kt0 + sub; const LAS unsigned char* sb = lds + (2 * pair + sub) * ATT_SLOT;
            if (kt <= lastA) { f32x16 s0, s1;
#pragma unroll
                for (int g = 0; g < 4; ++g) { const f32x4 c0 = *(const LAS f32x4*)(ncl + kt * 64 + 8 * g + 4 * h2), c1 = *(const LAS f32x4*)(ncl + kt * 64 + 32 + 8 * g + 4 * h2);
#pragma unroll
                    for (int j = 0; j < 4; ++j) { s0[4 * g + j] = c0[j]; s1[4 * g + j] = c1[j]; } }
                att_tile8(sb, s0, s1, qfA, OA0, OA1, mA, lA, kt, qrowA, kt * 64 + 63 > q0A + 32 * wave, h2, ql, vfo); }
            if (kt < nktB && kt <= lastB) { f32x16 s0, s1;
#pragma unroll
                for (int g = 0; g < 4; ++g) { const f32x4 c0 = *(const LAS f32x4*)(ncl + kt * 64 + 8 * g + 4 * h2), c1 = *(const LAS f32x4*)(ncl + kt * 64 + 32 + 8 * g + 4 * h2);
#pragma unroll
                    for (int j = 0; j < 4; ++j) { s0[4 * g + j] = c0[j]; s1[4 * g + j] = c1[j]; } }
                att_tile8(sb, s0, s1, qfB, OB0, OB1, mB, lB, kt, qrowB, kt * 64 + 63 > q0B + 32 * wave, h2, ql, vfo); }
        }
        pair ^= 1;
    }
#undef ATT_DMA
    att_store_o(Op + (size_t)qrowA * 1024 + 4 * h2, OA0, OA1, lA);
    att_store_o(Op + (size_t)qrowB * 1024 + 4 * h2, OB0, OB1, lB);
    asm volatile("s_waitcnt lgkmcnt(0)" ::: "memory"); __builtin_amdgcn_s_barrier(); asm volatile("" ::: "memory");
}
__device__ __forceinline__ void memattn_mfma(const bf16_t* proj, const bf16_t* kvmem, int koff, bf16_t* cat, LAS unsigned char* lds) {
    const int tid = threadIdx.x, lane = tid & 63, wave = __builtin_amdgcn_readfirstlane(tid >> 6), ql = lane & 31, h2 = lane >> 5;
    const int kfo = h2 * 1024 + ql * 16, vfo = 8192 + (4 * h2 + ((lane & 15) >> 2)) * 64 + ((lane >> 4) & 1) * 32 + (lane & 3) * 8;
    for (int u = blockIdx.x; u < NB * 4 * 2; u += gridDim.x) {
        const int half = u & 1, h = (u >> 1) & 3, b = u >> 3;
        const bf16_t* Kp = kvmem + (size_t)b * MEMT * 1024 + koff + 64 * h; const bf16_t* Vp = Kp + 256;
        const bf16_t* ksrc = Kp + (size_t)lane * 1024 + 8 * wave;
        const bf16_t* vsrc = Vp + (size_t)(16 * (wave & 3) + (lane >> 2)) * 1024 + 32 * (wave >> 2) + 8 * (lane & 3);
        __syncthreads();
#pragma unroll
        for (int t = 0; t < 4; ++t) { __builtin_amdgcn_global_load_lds((const unsigned*)(ksrc + (size_t)t * 64 * 1024), (LAS unsigned*)(lds + t * ATT_SLOT + wave * 1024), 16, 0, 0);
                                       __builtin_amdgcn_global_load_lds((const unsigned*)(vsrc + (size_t)t * 64 * 1024), (LAS unsigned*)(lds + t * ATT_SLOT + 8192 + wave * 1024), 16, 0, 0); }
        const bf16_t* Qb = proj + (size_t)b * S * 1024 + 768 + 64 * h; bf16_t* Ob = cat + (size_t)b * S * 1024 + 768 + 64 * h;
        bf16x8 qf[4];
        att_load_q(qf, Qb + (size_t)(half * 1024 + 32 * wave + ql) * 1024, h2);
        asm volatile("s_waitcnt vmcnt(0)" ::: "memory");
        __builtin_amdgcn_s_barrier();
        asm volatile("" ::: "memory");
        for (int qb = 0; qb < 4; ++qb) {
            const int qrow = half * 1024 + qb * 256 + 32 * wave + ql;
            f32x16 O0, O1;
#pragma unroll
            for (int r = 0; r < 16; ++r) { O0[r] = 0.f; O1[r] = 0.f; }
            float m = -1e30f, l = 0.f;
            bf16x8 qn[4];
            if (qb + 1 < 4) att_load_q(qn, Qb + (size_t)(qrow + 256) * 1024, h2);
#pragma unroll 1
            for (int kt = 0; kt < 4; ++kt) { f32x16 s0, s1;
#pragma unroll
                for (int r = 0; r < 16; ++r) { s0[r] = 0.f; s1[r] = 0.f; }
                att_tile<false>(lds + kt * ATT_SLOT, s0, s1, qf, O0, O1, m, l, kt, qrow, false, h2, kfo, vfo); }
            att_store_o(Ob + (size_t)qrow * 1024 + 4 * h2, O0, O1, l);
            if (qb + 1 < 4) {
#pragma unroll
                for (int ks = 0; ks < 4; ++ks) qf[ks] = qn[ks]; }
        }
    }
}
__device__ __forceinline__ void fox_mfma(const unsigned char* Q8, const unsigned char* K8, const bf16_t* Vf, const float* glog, bf16_t* cat, LAS unsigned char* lds) {
    const int tid = threadIdx.x, lane = tid & 63, wave = tid >> 6;
    LAS float* cl = (LAS float*)(lds + ATT_C_OFF); LAS float* wtot = (LAS float*)(lds + ATT_W_OFF);
    const int G = gridDim.x, vcu = (G % 8 == 0) ? ((int)(blockIdx.x % 8) * (G / 8) + (int)(blockIdx.x / 8)) : (int)blockIdx.x;
    const int npair = NB * 12 * 4, npp = (npair + G - 1) / G; int last_bh = -1;
    for (int ip = 0; ip < npp; ++ip) {
        const int p = vcu * npp + ip; if (p >= npair) break;
        const int bh = p >> 2, j = p & 3, b = bh / 12, h = bh % 12;
        if (bh != last_bh) {
            last_bh = bh;
            float v[4];
#pragma unroll
            for (int k = 0; k < 4; ++k) v[k] = glog[((size_t)b * S + 4 * tid + k) * 16 + h];
            v[1] += v[0]; v[2] += v[1]; v[3] += v[2];
            float inc = v[3];
#pragma unroll
            for (int off = 1; off < 64; off <<= 1) { const float n = __shfl_up(inc, off); if (lane >= off) inc += n; }
            if (lane == 63) wtot[wave] = inc;
            __syncthreads();
            float base = inc - v[3];
            for (int w = 0; w < wave; ++w) base += wtot[w];
#pragma unroll
            for (int k = 0; k < 4; ++k) cl[4 * tid + k] = -(base + v[k]) * (ATT_L2E * ATT_S8);
            __syncthreads();
        }
        attn_unit_fox2(Q8 + (size_t)b * S * 768 + 64 * h, K8 + (size_t)b * S * 768 + 64 * h, Vf + (size_t)b * S * 768 + 64 * h,
                       cat + (size_t)b * S * 1024 + 64 * h, 7 - j, j, lds);
    }
}

constexpr float Y8_SCALE = 32.0f;
__device__ __forceinline__ void add_fp8x16(float (&v)[16], const u32x4 w, float sc) {
    const unsigned ww[4] = {w.x, w.y, w.z, w.w};
#pragma unroll
    for (int q = 0; q < 4; ++q) { const f32x2 lo = __builtin_amdgcn_cvt_pk_f32_fp8((int)ww[q], false), hi = __builtin_amdgcn_cvt_pk_f32_fp8((int)ww[q], true);
        v[4 * q + 0] += sc * lo[0]; v[4 * q + 1] += sc * lo[1]; v[4 * q + 2] += sc * hi[0]; v[4 * q + 3] += sc * hi[1]; }
}
__device__ __forceinline__ void unpack_bf16x8(float* v, const u32x4 x, float sc) {
    v[0] = sc * bf_lo(x.x); v[1] = sc * bf_hi(x.x); v[2] = sc * bf_lo(x.y); v[3] = sc * bf_hi(x.y); v[4] = sc * bf_lo(x.z); v[5] = sc * bf_hi(x.z); v[6] = sc * bf_lo(x.w); v[7] = sc * bf_hi(x.w);
}
template <bool HP32, bool COMBINE, bool GATES>
__device__ __forceinline__ void ln_phase(const void* hprev, const void* add, const int* tok_slot, const float* gam, const float* bet, bf16_t* hout, float* fout,
                                         const float* gwt, const float* fgate_b, float* glog, LAS unsigned char* lds, unsigned char* qout = nullptr) {
    static_assert(!(HP32 && (COMBINE || GATES)), "the f32-input form is the plain LN1 of layer 0");
    constexpr int NCH = HP32 ? 4 : 2, CW = 16 / NCH, CS = 1024 / NCH;
    const int tid = threadIdx.x, lane = tid & 63, wave = tid >> 6;
    const int gw = blockIdx.x * NWAVES + wave, NGW = gridDim.x * NWAVES;
    LAS float* gl = (LAS float*)lds;
    if (GATES) { for (int i = tid; i < 12 * 1024; i += NTHR) gl[i] = gwt[i]; __syncthreads(); }
    float g[16], bb[16];
#pragma unroll
    for (int ch = 0; ch < NCH; ++ch)
#pragma unroll
        for (int q = 0; q < CW / 4; ++q) { const f32x4 gv = *(const f32x4*)(gam + CS * ch + CW * lane + 4 * q), bv = *(const f32x4*)(bet + CS * ch + CW * lane + 4 * q);
#pragma unroll
            for (int j = 0; j < 4; ++j) { g[ch * CW + q * 4 + j] = gv[j]; bb[ch * CW + q * 4 + j] = bv[j]; } }
    for (int rp = gw; rp < T / 2; rp += NGW) {
        const int row0 = 2 * rp;
        float v[2][16];
        f32x4 xf[2][4]; u32x4 xh[2][2], am[2][2]; u32x2 am2[2][4], ay[2][4][2];
        int myslot = 0;
        if (COMBINE) myslot = tok_slot[(size_t)row0 * 4 + (lane & 7)];
#pragma unroll
        for (int r = 0; r < 2; ++r) {
            if (HP32) { const float* hp = (const float*)hprev + (size_t)(row0 + r) * 1024 + 4 * lane; const bf16_t* ap = (const bf16_t*)add + (size_t)(row0 + r) * 1024 + 4 * lane;
#pragma unroll
                for (int ch = 0; ch < 4; ++ch) { xf[r][ch] = *(const f32x4*)(hp + 256 * ch); am2[r][ch] = *(const u32x2*)(ap + 256 * ch); }
            } else { const bf16_t* hp = (const bf16_t*)hprev + (size_t)(row0 + r) * 1024 + 8 * lane; xh[r][0] = *(const u32x4*)hp; xh[r][1] = *(const u32x4*)(hp + 512);
                if (!COMBINE) { const bf16_t* ap = (const bf16_t*)add + (size_t)(row0 + r) * 1024 + 8 * lane; am[r][0] = *(const u32x4*)ap; am[r][1] = *(const u32x4*)(ap + 512); } }
        }
        if (COMBINE) {
#pragma unroll
            for (int r = 0; r < 2; ++r)
#pragma unroll
                for (int k = 0; k < 4; ++k) { const int sl = __builtin_amdgcn_readlane(myslot, 4 * r + k); const unsigned char* yp = (const unsigned char*)add + (size_t)sl * 1024 + 8 * lane;
                    ay[r][k][0] = *(const u32x2*)yp; ay[r][k][1] = *(const u32x2*)(yp + 512); }
        }
#pragma unroll
        for (int r = 0; r < 2; ++r) {
            if (HP32) {
#pragma unroll
                for (int ch = 0; ch < 4; ++ch) { const u32x2 mw = am2[r][ch];
                    v[r][4 * ch + 0] = DN_ALPHA * xf[r][ch][0] + bf_lo(mw.x); v[r][4 * ch + 1] = DN_ALPHA * xf[r][ch][1] + bf_hi(mw.x);
                    v[r][4 * ch + 2] = DN_ALPHA * xf[r][ch][2] + bf_lo(mw.y); v[r][4 * ch + 3] = DN_ALPHA * xf[r][ch][3] + bf_hi(mw.y); }
            } else {
                unpack_bf16x8(&v[r][0], xh[r][0], DN_ALPHA); unpack_bf16x8(&v[r][8], xh[r][1], DN_ALPHA);
                if (COMBINE) {
                    float acc[16];
#pragma unroll
                    for (int i = 0; i < 16; ++i) acc[i] = 0.f;
#pragma unroll
                    for (int k = 0; k < 4; ++k)
#pragma unroll
                        for (int ch = 0; ch < 2; ++ch) { const unsigned ww[2] = {ay[r][k][ch].x, ay[r][k][ch].y};
#pragma unroll
                            for (int q = 0; q < 2; ++q) { const f32x2 lo = __builtin_amdgcn_cvt_pk_f32_fp8((int)ww[q], false), hi = __builtin_amdgcn_cvt_pk_f32_fp8((int)ww[q], true);
                                acc[8 * ch + 4 * q + 0] += lo[0]; acc[8 * ch + 4 * q + 1] += lo[1]; acc[8 * ch + 4 * q + 2] += hi[0]; acc[8 * ch + 4 * q + 3] += hi[1]; } }
#pragma unroll
                    for (int i = 0; i < 16; ++i) v[r][i] += acc[i] * (1.0f / Y8_SCALE);
                } else { float t[16]; unpack_bf16x8(&t[0], am[r][0], 1.0f); unpack_bf16x8(&t[8], am[r][1], 1.0f);
#pragma unroll
                    for (int i = 0; i < 16; ++i) v[r][i] += t[i]; }
            }
        }
        float s[2] = {0.f, 0.f};
#pragma unroll
        for (int r = 0; r < 2; ++r)
#pragma unroll
            for (int i = 0; i < 16; ++i) s[r] += v[r][i];
        float mean[2], s2[2] = {0.f, 0.f};
#pragma unroll
        for (int r = 0; r < 2; ++r) { mean[r] = wave_sum(s[r]) * (1.0f / 1024.0f);
#pragma unroll
            for (int i = 0; i < 16; ++i) { v[r][i] -= mean[r]; s2[r] += v[r][i] * v[r][i]; } }
#pragma unroll
        for (int r = 0; r < 2; ++r) { const float rstd = 1.0f / sqrtf(wave_sum(s2[r]) * (1.0f / 1024.0f) + LN_EPS);
#pragma unroll
            for (int i = 0; i < 16; ++i) v[r][i] = v[r][i] * rstd * g[i] + bb[i]; }
#pragma unroll
        for (int r = 0; r < 2; ++r) {
            if (hout) { bf16_t* op = hout + (size_t)(row0 + r) * 1024 + CW * lane;
                if (HP32) {
#pragma unroll
                    for (int ch = 0; ch < 4; ++ch) { u32x2 w; w.x = cvt_pk_bf16(v[r][4 * ch + 0], v[r][4 * ch + 1]); w.y = cvt_pk_bf16(v[r][4 * ch + 2], v[r][4 * ch + 3]); *(u32x2*)(op + 256 * ch) = w; }
                } else {
#pragma unroll
                    for (int ch = 0; ch < 2; ++ch) { u32x4 w; w.x = cvt_pk_bf16(v[r][ch * 8 + 0], v[r][ch * 8 + 1]); w.y = cvt_pk_bf16(v[r][ch * 8 + 2], v[r][ch * 8 + 3]);
                        w.z = cvt_pk_bf16(v[r][ch * 8 + 4], v[r][ch * 8 + 5]); w.w = cvt_pk_bf16(v[r][ch * 8 + 6], v[r][ch * 8 + 7]); *(u32x4*)(op + 512 * ch) = w; } } }
            if (qout) { unsigned char* qp = qout + (size_t)(row0 + r) * 1024 + CW * lane;
                if (HP32) {
#pragma unroll
                    for (int ch = 0; ch < 4; ++ch) *(unsigned*)(qp + 256 * ch) = pg8::pk_fp8x4(v[r][4 * ch + 0], v[r][4 * ch + 1], v[r][4 * ch + 2], v[r][4 * ch + 3]);
                } else {
#pragma unroll
                    for (int ch = 0; ch < 2; ++ch) { u32x2 w; w.x = pg8::pk_fp8x4(v[r][8 * ch + 0], v[r][8 * ch + 1], v[r][8 * ch + 2], v[r][8 * ch + 3]);
                        w.y = pg8::pk_fp8x4(v[r][8 * ch + 4], v[r][8 * ch + 5], v[r][8 * ch + 6], v[r][8 * ch + 7]); *(u32x2*)(qp + 512 * ch) = w; } } }
            if (!HP32 && fout) { float* op = fout + (size_t)(row0 + r) * 1024 + 8 * lane;
#pragma unroll
                for (int ch = 0; ch < 2; ++ch)
#pragma unroll
                    for (int q = 0; q < 2; ++q) *(f32x4*)(op + 512 * ch + 4 * q) = (f32x4){v[r][ch * 8 + q * 4 + 0], v[r][ch * 8 + q * 4 + 1], v[r][ch * 8 + q * 4 + 2], v[r][ch * 8 + q * 4 + 3]}; }
        }
        if (GATES) {
            f32x2 P[12];
#pragma unroll
            for (int j = 0; j < 12; ++j) { f32x2 p = {0.f, 0.f};
#pragma unroll
                for (int ch = 0; ch < 2; ++ch)
#pragma unroll
                    for (int q = 0; q < 2; ++q) { const f32x4 w = *(const LAS f32x4*)(gl + j * 1024 + 512 * ch + 8 * lane + 4 * q);
#pragma unroll
                        for (int e = 0; e < 4; ++e) p += (f32x2){v[0][ch * 8 + q * 4 + e], v[1][ch * 8 + q * 4 + e]} * w[e]; }
                P[j] = p; }
            float Q[12];
#pragma unroll
            for (int j = 0; j < 12; ++j) { const auto rr = __builtin_amdgcn_permlane32_swap(__float_as_uint(P[j][0]), __float_as_uint(P[j][1]), false, false); Q[j] = __uint_as_float(rr[0]) + __uint_as_float(rr[1]); }
            float R[6];
#pragma unroll
            for (int j = 0; j < 6; ++j) { const auto rr = __builtin_amdgcn_permlane16_swap(__float_as_uint(Q[j]), __float_as_uint(Q[j + 6]), false, false); R[j] = __uint_as_float(rr[0]) + __uint_as_float(rr[1]); }
#define LN_DPP(x, ctrl) __int_as_float(__builtin_amdgcn_update_dpp(0, __float_as_int(x), (ctrl), 0xf, 0xf, false))
#pragma unroll
            for (int j = 0; j < 6; ++j) { float t = R[j]; t += LN_DPP(t, 0x128); t += LN_DPP(t, 0x124); t += LN_DPP(t, 0x122); t += LN_DPP(t, 0x121); R[j] = t; }
#undef LN_DPP
            const int l16 = lane & 15, jj = l16 + 6 * ((lane >> 4) & 1), rr_ = lane >> 5;
            float mine = R[0];
#pragma unroll
            for (int j = 1; j < 6; ++j) mine = (l16 == j) ? R[j] : mine;
            if (l16 < 6) { const float z = mine + fgate_b[jj]; const float ls = fminf(z, 0.f) - log1pf(expf(-fabsf(z))); glog[(size_t)(row0 + rr_) * 16 + jj] = ls; }
        }
    }
}

__device__ __forceinline__ void top4_phase(const float* logits, const float* rb, int* tok_e, float* tok_g, int* tok_r, unsigned* wg_hist, LAS unsigned char* lds) {
    const int tid = threadIdx.x;
    LAS unsigned* hist = (LAS unsigned*)lds;
    for (int ch = blockIdx.x; ch < NCHUNK; ch += gridDim.x) {
        __syncthreads();
        if (tid < 32) hist[tid] = 0u;
        __syncthreads();
        if (tid < 256) {
            const int t = ch * 256 + tid; const float* lp = logits + (size_t)t * 32;
            float lg[32];
#pragma unroll
            for (int q = 0; q < 8; ++q) { const f32x4 hv = *(const f32x4*)(lp + 4 * q) + *(const f32x4*)(lp + (size_t)T * 32 + 4 * q), bv = *(const f32x4*)(rb + 4 * q);
#pragma unroll
                for (int j = 0; j < 4; ++j) lg[4 * q + j] = hv[j] + bv[j]; }
            unsigned used = 0u; int sel[4]; float val[4];
#pragma unroll
            for (int k = 0; k < 4; ++k) { float best = -INFINITY; int bi = 0;
#pragma unroll
                for (int e = 0; e < 32; ++e) { const float c = ((used >> e) & 1u) ? -INFINITY : lg[e]; if (c > best) { best = c; bi = e; } }
                sel[k] = bi; val[k] = best; used |= 1u << bi; }
            const float e1 = __expf(val[1] - val[0]), e2 = __expf(val[2] - val[0]), e3 = __expf(val[3] - val[0]); const float inv = 1.0f / (1.0f + e1 + e2 + e3);
            const float gt[4] = {inv, e1 * inv, e2 * inv, e3 * inv};
            int rk[4];
#pragma unroll
            for (int k = 0; k < 4; ++k) rk[k] = (int)atomicAdd((unsigned*)(hist + sel[k]), 1u);
            *(int4*)(tok_e + (size_t)t * 4) = make_int4(sel[0], sel[1], sel[2], sel[3]);
            *(f32x4*)(tok_g + (size_t)t * 4) = (f32x4){gt[0], gt[1], gt[2], gt[3]};
            *(int4*)(tok_r + (size_t)t * 4) = make_int4(rk[0], rk[1], rk[2], rk[3]);
        }
        __syncthreads();
        if (tid < 32) wg_hist[ch * 32 + tid] = hist[tid];
    }
}

__device__ __forceinline__ void assign_phase(const unsigned* wg_hist, const int* tok_e, const float* tok_g, const int* tok_r, int* tok_s, float* slot_g, int* slot_t,
                                             int* tiletab, LAS unsigned char* lds) {
    const int tid = threadIdx.x, lane = tid & 63, wave = tid >> 6;
    LAS unsigned* rtot = (LAS unsigned*)lds;
    LAS unsigned* rpre = rtot + 512;
    LAS unsigned* cnt = rpre + 512;
    LAS unsigned* pstart = cnt + 32;
    LAS unsigned* base = pstart + 40;
    LAS int* sl = (LAS int*)(base + 32);
    for (int ch = blockIdx.x; ch < NCHUNK; ch += gridDim.x) {
        __syncthreads();
        { const int e = tid & 31, part = tid >> 5; unsigned tot = 0u, pre = 0u;
          for (int c = part * 16; c < part * 16 + 16; ++c) { const unsigned hv = wg_hist[c * 32 + e]; tot += hv; if (c < ch) pre += hv; }
          rtot[part * 32 + e] = tot; rpre[part * 32 + e] = pre; }
        __syncthreads();
        if (tid < 32) { unsigned tot = 0u, pre = 0u;
            for (int p = 0; p < 16; ++p) { tot += rtot[p * 32 + tid]; pre += rpre[p * 32 + tid]; }
            cnt[tid] = tot; base[tid] = pre; }
        __syncthreads();
        if (tid == 0) { unsigned acc = 0u; for (int e = 0; e < 32; ++e) { pstart[e] = acc; acc += (cnt[e] + 255u) & ~255u; } pstart[32] = acc; }
        __syncthreads();
        if (tid < 256) { const int t = ch * 256 + tid;
            const int4 e4 = *(const int4*)(tok_e + (size_t)t * 4), r4 = *(const int4*)(tok_r + (size_t)t * 4); const f32x4 g4 = *(const f32x4*)(tok_g + (size_t)t * 4);
            const int es[4] = {e4.x, e4.y, e4.z, e4.w}, rs[4] = {r4.x, r4.y, r4.z, r4.w}; int so[4];
#pragma unroll
            for (int k = 0; k < 4; ++k) { so[k] = (int)(pstart[es[k]] + base[es[k]]) + rs[k]; slot_g[so[k]] = g4[k]; slot_t[so[k]] = t; }
            *(int4*)(tok_s + (size_t)t * 4) = make_int4(so[0], so[1], so[2], so[3]); }
        __syncthreads();
        if (ch == (int)blockIdx.x) {
            for (int e = blockIdx.x; e < NE; e += gridDim.x) {
                const int p0 = (int)(pstart[e] + cnt[e]), p1 = (int)pstart[e + 1];
                for (int s = p0 + tid; s < p1; s += NTHR) { slot_g[s] = 0.f; slot_t[s] = 0; }
                for (int tl = (int)(pstart[e] >> 8) + tid; tl < (int)(pstart[e + 1] >> 8); tl += NTHR) tiletab[16 + tl] = e;
            }
            if (blockIdx.x == 0 && tid == 0) tiletab[0] = (int)(pstart[32] >> 8);
        }
    }
}

__global__ void __launch_bounds__(NTHR, 2) fwd_kernel(Args args) {
    extern __shared__ __attribute__((aligned(16))) unsigned char lds_raw[];
    LAS unsigned char* lds = (LAS unsigned char*)lds_raw;
    volatile LAS unsigned* MISC = (volatile LAS unsigned*)(lds + MISC_OFF);
    const int tid = threadIdx.x, lane = tid & 63, wave = __builtin_amdgcn_readfirstlane(tid >> 6);
    const int G = gridDim.x;
    unsigned char* ws = args.ws;
    unsigned* ctl = (unsigned*)(ws + WS_CTL);
    if (tid < 32) MISC[tid] = 0u;
    __syncthreads();
    XcdBarrier bar; bar.bar = ctl + CW_BAR; bar.x = 0; bar.st = nullptr;
#if !MK_PER_PHASE
    bar = xcd_barrier_post(ctl + CW_BAR, MISC + 8);
#endif
    const int lo = args.ph_lo, hi = args.ph_hi;
#ifndef PH_MASK
#define PH_MASK 0xFFFFFFFFu
#endif
#ifndef PH_TWICE
#define PH_TWICE 0u
#endif
#define TW(k) ((((unsigned)PH_TWICE >> (k)) & 1u) != 0u)
#define IN(k) (((PH_MASK >> (k)) & 1u) && lo <= (k) && (k) < hi)
#if MK_PER_PHASE
#define SEAM(k) do { } while (0)
#else
#define SEAM(k) do { if (IN(k) && IN((k) + 1)) xcd_barrier(bar); } while (0)
#endif
    bf16_t* const R1 = (bf16_t*)(ws + WS_R1); bf16_t* const R2 = (bf16_t*)(ws + WS_R2);
    bf16_t* const PROJ = (bf16_t*)(ws + WS_PROJ); bf16_t* const CAT = (bf16_t*)(ws + WS_CAT); bf16_t* const MIX = (bf16_t*)(ws + WS_MIX); bf16_t* const DBUF = (bf16_t*)(ws + WS_DBUF);
    bf16_t* const KF = (bf16_t*)(ws + WS_KF); bf16_t* const VF = (bf16_t*)(ws + WS_VF);
    bf16_t* const ACT = (bf16_t*)(ws + WS_ACT); bf16_t* const YB = (bf16_t*)(ws + WS_Y);
    unsigned char* const MEMB = ws + WS_MEMB; bf16_t* const KVMEM = (bf16_t*)(ws + WS_KVMEM);
    float* const LOGITS = (float*)(ws + WS_LOGITS); float* const GLOG = (float*)(ws + WS_GLOG);
    int* const TOKE = (int*)(ws + WS_TOKE); float* const TOKG = (float*)(ws + WS_TOKG); int* const TOKR = (int*)(ws + WS_TOKR); int* const TOKS = (int*)(ws + WS_TOKS);
    float* const SLOTG = (float*)(ws + WS_SLOTG); int* const SLOTT = (int*)(ws + WS_SLOTT);
    unsigned* const WGH = (unsigned*)(ws + WS_WGHIST); int* const TILETAB = (int*)(ws + WS_TILETAB);

    if (IN(0)) { p0_prologue(args, lds, wave, lane); } if (TW(0) && IN(0)) { p0_prologue(args, lds, wave, lane); }
    SEAM(0);
    if (IN(1)) {
        { pg8::Gemm g{R1, ws + WS_WINA, T, 1024, 2048}; pg8::StaticOrder So; So.init(T, 1024, G, (int)blockIdx.x);
          pg8::EpiBf16 E{PROJ, 1024, nullptr, 0, 0, 1.0f}; pg8::gemm_phase(lds, g, So, E); }
        { pg8::Gemm g{MEMB, ws + WS_WMKV, NB * MEMT, 1024, 1024}; pg8::StaticOrder So; So.init(NB * MEMT, 1024, G, (int)((blockIdx.x + 128) % G));
          pg8::EpiBf16 E{KVMEM, 1024, nullptr, 0, 0, 1.0f / pg8::W8_SCALE}; pg8::gemm_phase<pg8::EpiBf16, pg8::StaticOrder, true>(lds, g, So, E); }
    }
    SEAM(1);
    if (IN(2)) { pool_d_phase(PROJ, CAT); memattn_mfma(PROJ, KVMEM, 0, CAT, lds); } if (TW(2) && IN(2)) { pool_d_phase(PROJ, CAT); memattn_mfma(PROJ, KVMEM, 0, CAT, lds); }
    SEAM(2);
    if (IN(4)) { pg8::Gemm g{CAT, ws + WS_WOUTA, T, 1024, 2048}; pg8::StaticOrder So; So.init(T, 1024, G, (int)blockIdx.x);
        pg8::EpiBf16 E{MIX, 1024, nullptr, 0, 0, 1.0f}; pg8::gemm_phase(lds, g, So, E); }
    SEAM(4);
    if (IN(5)) ln_phase<false, false, false>(R1, MIX, nullptr, args.in[2], args.in[3], R1, nullptr, nullptr, nullptr, nullptr, lds, ws + WS_H1Q); if (TW(5) && IN(5)) ln_phase<false, false, false>(R1, MIX, nullptr, args.in[2], args.in[3], R1, nullptr, nullptr, nullptr, nullptr, lds, ws + WS_H1Q);
    SEAM(5);
#define MOE_BLOCK(P, L, HIN) \
    if (IN(P)) { pg8::Gemm g{HIN, ws + WS_WR + (size_t)(L) * 256 * 2048, T, 256, 2048}; pg8::StaticOrder So; So.init(T, 256, G, (int)blockIdx.x); \
        if (G == 256) { pg8::EpiRouter E{args.in[17] + (L) * 32, TOKE, TOKG, TOKR, WGH}; pg8::gemm_phase(lds, g, So, E); } \
        else { pg8::EpiLogits E{LOGITS}; pg8::gemm_phase(lds, g, So, E); } } \
    if (G != 256) SEAM(P); \
    if (G != 256 && IN((P) + 1)) top4_phase(LOGITS, args.in[17] + (L) * 32, TOKE, TOKG, TOKR, WGH, lds); \
    SEAM((P) + 1); \
    if (IN((P) + 2)) assign_phase(WGH, TOKE, TOKG, TOKR, TOKS, SLOTG, SLOTT, TILETAB, lds); if (TW((P) + 2) && IN((P) + 2)) assign_phase(WGH, TOKE, TOKG, TOKR, TOKS, SLOTG, SLOTT, TILETAB, lds); \
    SEAM((P) + 2); \
    if (IN((P) + 3)) { LAS int* tab = (LAS int*)(lds + TAB_OFF); const int ntl = (int)__hip_atomic_load((unsigned*)TILETAB, RLX_AGENT); \
        for (int i = tid; i < NTILE_MAX; i += NTHR) tab[i] = (i < ntl) ? TILETAB[16 + i] : 0; __syncthreads(); \
        pg8::Gemm g{ws + WS_H1Q, ws + WS_W1 + (size_t)(L) * 32 * 2048 * 1024, NSLOT_MAX, 2048, 1024}; pg8::MoeOrder Mo{ntl, 8, G, (int)blockIdx.x, tab}; \
        pg8::EpiSwiglu E{(unsigned char*)ACT, (const float*)(ws + WS_B1P) + (size_t)(L) * 32 * 2048}; pg8::gemm_phase<pg8::EpiSwiglu, pg8::MoeOrder, true, true>(lds, g, Mo, E, SLOTT); } \
    SEAM((P) + 3); \
    if (IN((P) + 4)) { LAS int* tab = (LAS int*)(lds + TAB_OFF); const int ntl = (int)__hip_atomic_load((unsigned*)TILETAB, RLX_AGENT); \
        for (int i = tid; i < NTILE_MAX; i += NTHR) tab[i] = (i < ntl) ? TILETAB[16 + i] : 0; __syncthreads(); \
        pg8::Gemm g{ACT, ws + WS_W2 + (size_t)(L) * 32 * 1024 * 1024, NSLOT_MAX, 1024, 1024}; pg8::MoeOrder Mo{ntl, 4, G, (int)blockIdx.x, tab}; \
        pg8::EpiMoe2 E{(unsigned char*)YB, args.in[21] + (size_t)(L) * 32 * 1024, SLOTG, Y8_SCALE}; pg8::gemm_phase<pg8::EpiMoe2, pg8::MoeOrder, true>(lds, g, Mo, E); } \
    SEAM((P) + 4);
    MOE_BLOCK(6, 0, R1)
    if (IN(11)) ln_phase<false, true, true>(R1, YB, TOKS, args.in[4], args.in[5], R2, nullptr, (const float*)(ws + WS_GWT), args.in[12], GLOG, lds, ws + WS_H1Q); if (TW(11) && IN(11)) ln_phase<false, true, true>(R1, YB, TOKS, args.in[4], args.in[5], R2, nullptr, (const float*)(ws + WS_GWT), args.in[12], GLOG, lds, ws + WS_H1Q);
    SEAM(11);
    if (IN(12)) {
        { pg8::Gemm g{ws + WS_H1Q, ws + WS_WKV, T, 1536, 1024}; pg8::StaticOrder So; So.init(T, 1536, G, (int)blockIdx.x);
          pg8::EpiMixed8 E{ws + WS_KF, 768, 1.0f / pg8::W8_SCALE, 3, VF, 768, 1, 1.0f / pg8::W8_SCALE}; pg8::gemm_phase<pg8::EpiMixed8, pg8::StaticOrder, true>(lds, g, So, E); }
        { pg8::Gemm g{ws + WS_H1Q, ws + WS_WINB, T, 1024, 1024}; pg8::StaticOrder So; So.init(T, 1024, G, (int)blockIdx.x);
          pg8::EpiMixed8 E{ws + WS_Q8, 768, ATT_C2 * ATT_S8 / pg8::W8_SCALE, 3, PROJ, 1024, 0, 1.0f / pg8::W8_SCALE}; pg8::gemm_phase<pg8::EpiMixed8, pg8::StaticOrder, true>(lds, g, So, E); }
    }
    SEAM(12);
    if (IN(13)) { fox_mfma(ws + WS_Q8, ws + WS_KF, VF, GLOG, CAT, lds); memattn_mfma(PROJ, KVMEM, 512, CAT, lds); } if (TW(13) && IN(13)) { fox_mfma(ws + WS_Q8, ws + WS_KF, VF, GLOG, CAT, lds); memattn_mfma(PROJ, KVMEM, 512, CAT, lds); }
    SEAM(13);
    if (IN(14)) { pg8::Gemm g{CAT, ws + WS_WOUTB, T, 1024, 2048}; pg8::StaticOrder So; So.init(T, 1024, G, (int)blockIdx.x);
        pg8::EpiBf16 E{MIX, 1024, nullptr, 0, 0, 1.0f}; pg8::gemm_phase(lds, g, So, E); }
    SEAM(14);
    if (IN(15)) ln_phase<false, false, false>(R2, MIX, nullptr, args.in[2] + 1024, args.in[3] + 1024, R1, nullptr, nullptr, nullptr, nullptr, lds, ws + WS_H1Q); if (TW(15) && IN(15)) ln_phase<false, false, false>(R2, MIX, nullptr, args.in[2] + 1024, args.in[3] + 1024, R1, nullptr, nullptr, nullptr, nullptr, lds, ws + WS_H1Q);
    SEAM(15);
    MOE_BLOCK(16, 1, R1)
    if (IN(21)) ln_phase<false, true, false>(R1, YB, TOKS, args.in[4] + 1024, args.in[5] + 1024, nullptr, args.out, nullptr, nullptr, nullptr, lds); if (TW(21) && IN(21)) ln_phase<false, true, false>(R1, YB, TOKS, args.in[4] + 1024, args.in[5] + 1024, nullptr, args.out, nullptr, nullptr, nullptr, lds);
#undef IN
#undef SEAM
}

extern "C" void kernel_launch(void* const* d_in, const int* in_sizes, int n_in, void* d_out, int out_size, void* d_ws, size_t ws_size, hipStream_t stream) {
    static int grid = 0;
    if (grid == 0) {
        if (n_in != 22 || out_size != T * D || ws_size < WS_END) { fprintf(stderr, "kernel_launch: unexpected problem (n_in %d out %d ws %zu)\n", n_in, out_size, ws_size); grid = -1; return; }
        int dev = 0, cus = 0;
        if (hipGetDevice(&dev) != hipSuccess || hipDeviceGetAttribute(&cus, hipDeviceAttributeMultiprocessorCount, dev) != hipSuccess) { grid = -1; return; }
        if (hipFuncSetAttribute((const void*)fwd_kernel, hipFuncAttributeMaxDynamicSharedMemorySize, LDS_BYTES) != hipSuccess) { fprintf(stderr, "kernel_launch: hipFuncSetAttribute failed\n"); grid = -1; return; }
        int per_cu = 0;
        if (hipOccupancyMaxActiveBlocksPerMultiprocessor(&per_cu, (const void*)fwd_kernel, NTHR, LDS_BYTES) != hipSuccess || per_cu < 1) fprintf(stderr, "kernel_launch: occupancy query says %d\n", per_cu);
        (void)hipGetLastError();
        grid = cus;
    }
    if (grid < 0) return;
    if (hipMemsetAsync((char*)d_ws + WS_CTL, 0, CTL_ZERO_BYTES, stream) != hipSuccess) return;
    Args a{};
    for (int i = 0; i < 22; ++i) a.in[i] = (const float*)d_in[i];
    a.out = (float*)d_out; a.ws = (unsigned char*)d_ws;
#if MK_PER_PHASE
    for (int p = 0; p < NPH; ++p) { a.ph_lo = p; a.ph_hi = p + 1; hipLaunchKernelGGL(fwd_kernel, dim3(grid), dim3(NTHR), LDS_BYTES, stream, a); }
#else
    a.ph_lo = 0; a.ph_hi = NPH; hipLaunchKernelGGL(fwd_kernel, dim3(grid), dim3(NTHR), LDS_BYTES, stream, a);
#endif
}
```

```cpp
#include <hip/hip_runtime.h>
#include <cstdio>
#include <cstdint>

#ifndef MK_PER_PHASE
#define MK_PER_PHASE 0
#endif

#define LAS __attribute__((address_space(3)))
#define GAS __attribute__((address_space(1)))
typedef unsigned short bf16_t;
typedef short bf16x8 __attribute__((ext_vector_type(8)));
typedef float f32x4 __attribute__((ext_vector_type(4)));
typedef float f32x2 __attribute__((ext_vector_type(2)));
typedef unsigned u32x4 __attribute__((ext_vector_type(4)));
typedef unsigned u32x2 __attribute__((ext_vector_type(2)));

__device__ __forceinline__ unsigned cvt_pk_bf16(float lo, float hi) { unsigned r; asm volatile("v_cvt_pk_bf16_f32 %0, %1, %2" : "=v"(r) : "v"(lo), "v"(hi)); return r; }
__device__ __forceinline__ float bf_lo(unsigned w) { return __uint_as_float(w << 16); }
__device__ __forceinline__ float bf_hi(unsigned w) { return __uint_as_float(w & 0xffff0000u); }

namespace pg8 {
constexpr int BM = 256, BK = 64, HALF = 128, HTB = HALF * BK * 2, STAGE_BYTES = 8 * HTB, NXCD = 8, WGM = 8;
__host__ __device__ __forceinline__ int lds_byte(int r, int c) { const int st = (r >> 4) * 2 + (c >> 5), rr = r & 15, cc = c & 31, ob = rr * 64 + cc * 2; return st * 1024 + (ob ^ (((ob >> 9) & 1) << 5)); }
__host__ __device__ __forceinline__ void stage_rc(int b, int& R, int& C) { const int st = b / 1024, sb = b % 1024, swz = sb ^ (((sb >> 9) & 1) << 5); R = (st >> 1) * 16 + swz / 64; C = (st & 1) * 32 + (swz % 64) / 2; }
__host__ __device__ __forceinline__ int perm32(int rho) { const int n = rho >> 4, i = rho & 15; return 8 * (i >> 2) + 4 * n + (i & 3); }

struct Unit { int pm, pn, e; };
struct Gemm { const void* A; const void* Bt; int M, N, Kb; };

struct StaticOrder {
    int nM, nN, nwg, G, c;
    __device__ void init(int M, int N, int G_, int c_) { nM = M / BM; nN = N / BM; nwg = nM * nN; G = G_; c = c_; }
    __device__ bool next(int i, Unit& u) const {
        const long L = (long)i * G + c; if (L >= nwg) return false;
        int wgid = (int)L; { const int q = nwg / NXCD, r = nwg % NXCD, xcd = wgid % NXCD, off = wgid / NXCD; wgid = (xcd < r ? xcd * (q + 1) : r * (q + 1) + (xcd - r) * q) + off; }
        const int nig = WGM * nN, gid = wgid / nig, fm = gid * WGM, gsz = (nM - fm) < WGM ? (nM - fm) : WGM;
        u.pm = fm + ((wgid % nig) % gsz); u.pn = (wgid % nig) / gsz; u.e = 0; return true;
    }
};
struct MoeOrder {
    int n_tiles, nN, G, c; const LAS int* tab;
    __device__ bool next(int i, Unit& u) const {
        int rt, pn;
        if (G == 256) { const int x = c & 7, r = c >> 3, rpi = 32 / nN, tpx = (n_tiles + 7) >> 3, lt = rpi * i + r / nN;
            if (lt >= tpx) return false; rt = x * tpx + lt; pn = r % nN; }

        else { const long L = (long)i * G + c; rt = (int)(L / nN); pn = (int)(L % nN); }
        if (rt >= n_tiles) return false;
        u.pm = rt; u.pn = pn; u.e = __builtin_amdgcn_readfirstlane(tab[rt]); return true;
    }
};

struct EpiBf16 {
    static constexpr bool PERM = true, AFTER = false, ALIGN = false; static constexpr bool SKIP_B1 = false;
    struct Pre {}; __device__ __forceinline__ Pre preload(const Unit&, int, int, int, int) const { return Pre{}; } static constexpr int NPRE = 0; static constexpr bool HOISTOK = false; static __device__ __forceinline__ void touch(Pre&) {}
    __device__ __forceinline__ const float* stash_ptr(const Unit&, int) const { return nullptr; } __device__ __forceinline__ Pre from_stash(const LAS float*, int, int, int, int) const { return Pre{}; }
    bf16_t* O; int ldc; const float* colscale; int split_cols; size_t split_stride; float scale;
    __device__ __forceinline__ void operator()(const f32x4 (&acc)[2][2][4][2], const Unit& u, int wr, int wc, int fr, int fq, const Pre&) const {
        const int row0 = u.pm * BM + wr * 64 + fr; int colt = u.pn * BM; bf16_t* base = O;
        if (split_cols) { const int t = colt / split_cols; base += (size_t)t * split_stride; colt -= t * split_cols; }
        const int col0 = colt + wc * 32 + 8 * fq, scol0 = u.pn * BM + wc * 32 + 8 * fq;
        f32x4 sv[2][2];
#pragma unroll
        for (int bj = 0; bj < 2; ++bj)
#pragma unroll
            for (int n = 0; n < 2; ++n) sv[bj][n] = colscale ? *(const f32x4*)(colscale + scol0 + bj * HALF + 4 * n) * scale : (f32x4){scale, scale, scale, scale};
#pragma unroll
        for (int ai = 0; ai < 2; ++ai)
#pragma unroll
            for (int m = 0; m < 4; ++m) { bf16_t* rowp = base + (size_t)(row0 + ai * HALF + m * 16) * ldc + col0;
#pragma unroll
                for (int bj = 0; bj < 2; ++bj) { const f32x4 v0 = acc[ai][bj][m][0] * sv[bj][0], v1 = acc[ai][bj][m][1] * sv[bj][1];
                    u32x4 w; w.x = cvt_pk_bf16(v0[0], v0[1]); w.y = cvt_pk_bf16(v0[2], v0[3]); w.z = cvt_pk_bf16(v1[0], v1[1]); w.w = cvt_pk_bf16(v1[2], v1[3]);
                    *(u32x4*)(rowp + bj * HALF) = w; } }
    }
};
__device__ __forceinline__ unsigned pk_fp8x4(float a, float b, float c, float d) { int w = 0; w = __builtin_amdgcn_cvt_pk_fp8_f32(a, b, w, false); w = __builtin_amdgcn_cvt_pk_fp8_f32(c, d, w, true); return (unsigned)w; }
__device__ __forceinline__ u32x4 widen16(u32x2 a, u32x2 b) {
    const auto x = __builtin_amdgcn_permlane16_swap(a.x, b.x, false, false), y = __builtin_amdgcn_permlane16_swap(a.y, b.y, false, false);
    return (u32x4){x[0], y[0], x[1], y[1]};
}
constexpr float W8_SCALE = 64.0f, ACT8_SCALE = 4.0f;
struct EpiMixed8 {
    static constexpr bool PERM = true, AFTER = false, ALIGN = false; static constexpr bool SKIP_B1 = false;
    struct Pre {}; __device__ __forceinline__ Pre preload(const Unit&, int, int, int, int) const { return Pre{}; } static constexpr int NPRE = 0; static constexpr bool HOISTOK = false; static __device__ __forceinline__ void touch(Pre&) {}
    __device__ __forceinline__ const float* stash_ptr(const Unit&, int) const { return nullptr; } __device__ __forceinline__ Pre from_stash(const LAS float*, int, int, int, int) const { return Pre{}; }
    unsigned char* O8; int ld8; float scale8; int ncut8; bf16_t* O16; int ld16; int rebase16; float scale16;
    __device__ __forceinline__ void operator()(const f32x4 (&acc)[2][2][4][2], const Unit& u, int wr, int wc, int fr, int fq, const Pre&) const {
        const int row0 = u.pm * BM + wr * 64 + fr;
        if (u.pn < ncut8) {
            const int roww = row0 + 16 * (fq & 1), colw = u.pn * BM + wc * 32 + 16 * (fq >> 1);
            u32x2 wprev[2] = {{0u, 0u}, {0u, 0u}};
#pragma unroll
            for (int ai = 0; ai < 2; ++ai)
#pragma unroll
                for (int m = 0; m < 4; ++m) {
#pragma unroll
                    for (int bj = 0; bj < 2; ++bj) { const f32x4 v0 = acc[ai][bj][m][0] * scale8, v1 = acc[ai][bj][m][1] * scale8;
                        u32x2 w; w.x = pk_fp8x4(v0[0], v0[1], v0[2], v0[3]); w.y = pk_fp8x4(v1[0], v1[1], v1[2], v1[3]);
                        if (m & 1) *(u32x4*)(O8 + (size_t)(roww + ai * HALF + (m - 1) * 16) * ld8 + colw + bj * HALF) = widen16(wprev[bj], w); else wprev[bj] = w; } }
        } else {
            const int col0 = (u.pn - (rebase16 ? ncut8 : 0)) * BM + wc * 32 + 8 * fq;
#pragma unroll
            for (int ai = 0; ai < 2; ++ai)
#pragma unroll
                for (int m = 0; m < 4; ++m) { bf16_t* rowp = O16 + (size_t)(row0 + ai * HALF + m * 16) * ld16 + col0;
#pragma unroll
                    for (int bj = 0; bj < 2; ++bj) { const f32x4 v0 = acc[ai][bj][m][0] * scale16, v1 = acc[ai][bj][m][1] * scale16;
                        u32x4 w; w.x = cvt_pk_bf16(v0[0], v0[1]); w.y = cvt_pk_bf16(v0[2], v0[3]); w.z = cvt_pk_bf16(v1[0], v1[1]); w.w = cvt_pk_bf16(v1[2], v1[3]); *(u32x4*)(rowp + bj * HALF) = w; } }
        }
    }
};
struct EpiLogits {
    static constexpr bool PERM = false, AFTER = false, ALIGN = true; static constexpr bool SKIP_B1 = true;
    struct Pre {}; __device__ __forceinline__ Pre preload(const Unit&, int, int, int, int) const { return Pre{}; } static constexpr int NPRE = 0; static constexpr bool HOISTOK = false; static __device__ __forceinline__ void touch(Pre&) {}
    __device__ __forceinline__ const float* stash_ptr(const Unit&, int) const { return nullptr; } __device__ __forceinline__ Pre from_stash(const LAS float*, int, int, int, int) const { return Pre{}; }
    float* L;
    __device__ __forceinline__ void operator()(const f32x4 (&acc)[2][2][4][2], const Unit& u, int wr, int wc, int fr, int fq, const Pre&) const {
        if (wc > 1) return;
        const int row0 = u.pm * BM + wr * 64 + fr;
#pragma unroll
        for (int ai = 0; ai < 2; ++ai)
#pragma unroll
            for (int m = 0; m < 4; ++m) { float* rowp = L + (size_t)wc * 65536 * 32 + (size_t)(row0 + ai * HALF + m * 16) * 32 + 4 * fq;
#pragma unroll
                for (int n = 0; n < 2; ++n) *(f32x4*)(rowp + n * 16) = acc[ai][0][m][n]; }
    }
};
struct EpiRouter {
    static constexpr bool PERM = false, AFTER = true, ALIGN = true; static constexpr bool SKIP_B1 = true;
    struct Pre {}; __device__ __forceinline__ Pre preload(const Unit&, int, int, int, int) const { return Pre{}; } static constexpr int NPRE = 0; static constexpr bool HOISTOK = false; static __device__ __forceinline__ void touch(Pre&) {}
    __device__ __forceinline__ const float* stash_ptr(const Unit&, int) const { return nullptr; } __device__ __forceinline__ Pre from_stash(const LAS float*, int, int, int, int) const { return Pre{}; }
    const float* rb; int* tok_e; float* tok_g; int* tok_r; unsigned* wg_hist;
    __device__ __forceinline__ void operator()(const f32x4 (&)[2][2][4][2], const Unit&, int, int, int, int, const Pre&) const {}
    __device__ __forceinline__ void after(const f32x4 (&acc)[2][2][4][2], const Unit& u, int wr, int wc, int fr, int fq, LAS unsigned char* lds) const {
        LAS float* Lg = (LAS float*)lds;
        LAS unsigned* hist = (LAS unsigned*)(lds + 2 * 256 * 33 * 4);
        const int tid = threadIdx.x;
        if (wc < 2) {
#pragma unroll
            for (int ai = 0; ai < 2; ++ai)
#pragma unroll
                for (int m = 0; m < 4; ++m) { LAS float* rowp = Lg + wc * (256 * 33) + (ai * HALF + wr * 64 + m * 16 + fr) * 33 + 4 * fq;
#pragma unroll
                    for (int n = 0; n < 2; ++n) { const f32x4 v = acc[ai][0][m][n]; rowp[n * 16 + 0] = v[0]; rowp[n * 16 + 1] = v[1]; rowp[n * 16 + 2] = v[2]; rowp[n * 16 + 3] = v[3]; } }
        }
        if (tid < 32) hist[tid] = 0u;
        __syncthreads();
        if (tid < 256) {
            const int t = u.pm * BM + tid; const LAS float* lp = Lg + tid * 33;
            float lg[32];
#pragma unroll
            for (int e = 0; e < 32; ++e) lg[e] = (lp[e] + lp[256 * 33 + e]) + rb[e];
            unsigned used = 0u; int sel[4]; float val[4];
#pragma unroll
            for (int k = 0; k < 4; ++k) { float best = -INFINITY; int bi = 0;
#pragma unroll
                for (int e = 0; e < 32; ++e) { const float c = ((used >> e) & 1u) ? -INFINITY : lg[e]; if (c > best) { best = c; bi = e; } }
                sel[k] = bi; val[k] = best; used |= 1u << bi; }
            const float e1 = __expf(val[1] - val[0]), e2 = __expf(val[2] - val[0]), e3 = __expf(val[3] - val[0]); const float inv = 1.0f / (1.0f + e1 + e2 + e3);
            int rk[4];
#pragma unroll
            for (int k = 0; k < 4; ++k) rk[k] = (int)atomicAdd((unsigned*)(hist + sel[k]), 1u);
            *(int4*)(tok_e + (size_t)t * 4) = make_int4(sel[0], sel[1], sel[2], sel[3]);
            *(f32x4*)(tok_g + (size_t)t * 4) = (f32x4){inv, e1 * inv, e2 * inv, e3 * inv};
            *(int4*)(tok_r + (size_t)t * 4) = make_int4(rk[0], rk[1], rk[2], rk[3]);
        }
        __syncthreads();
        if (tid < 32) wg_hist[u.pm * 32 + tid] = hist[tid];
    }
};
struct EpiSwiglu {
    static constexpr bool PERM = true, AFTER = false, ALIGN = true; static constexpr bool SKIP_B1 = false;
    unsigned char* O; const float* b1p;
    struct Pre { f32x4 bg[2], bl[2]; }; static constexpr bool HOISTOK = true; static constexpr int NPRE = 4;
    __device__ __forceinline__ const float* stash_ptr(const Unit& u, int tid) const { return b1p + (size_t)u.e * 2048 + u.pn * BM + (tid & 255); }
    __device__ __forceinline__ Pre from_stash(const LAS float* st, int wr, int wc, int fr, int fq) const { Pre p; const LAS float* bp = st + wc * 32 + 8 * fq;
        p.bg[0] = *(const LAS f32x4*)bp; p.bg[1] = *(const LAS f32x4*)(bp + 4); p.bl[0] = *(const LAS f32x4*)(bp + HALF); p.bl[1] = *(const LAS f32x4*)(bp + HALF + 4); return p; }
    static __device__ __forceinline__ void touch(Pre& p) { asm volatile("" : "+v"(p.bg[0]), "+v"(p.bg[1]), "+v"(p.bl[0]), "+v"(p.bl[1])); }
    __device__ __forceinline__ Pre preload(const Unit& u, int wr, int wc, int fr, int fq) const {
        Pre p; const float* bp = b1p + (size_t)u.e * 2048 + u.pn * BM + wc * 32 + 8 * fq;
#pragma unroll
        for (int n = 0; n < 2; ++n) { p.bg[n] = *(const f32x4*)(bp + 4 * n); p.bl[n] = *(const f32x4*)(bp + HALF + 4 * n); }
        return p; }
    __device__ __forceinline__ void operator()(const f32x4 (&acc)[2][2][4][2], const Unit& u, int wr, int wc, int fr, int fq, const Pre& pre) const {
        const int roww = u.pm * BM + wr * 64 + fr + 16 * (fq & 1), ocolw = u.pn * HALF + wc * 32 + 16 * (fq >> 1);
        u32x2 wprev = {0u, 0u};
#pragma unroll
        for (int ai = 0; ai < 2; ++ai)
#pragma unroll
            for (int m = 0; m < 4; ++m) { float r[8];
#pragma unroll
                for (int n = 0; n < 2; ++n) { const f32x4 g = acc[ai][0][m][n] * (1.0f / W8_SCALE) + pre.bg[n], l = acc[ai][1][m][n] * (1.0f / W8_SCALE) + pre.bl[n];
#pragma unroll
                    for (int j = 0; j < 4; j += 2) {
                        const f32x2 xg = {fminf(g[j], 7.0f), fminf(g[j + 1], 7.0f)}, xl = {__builtin_amdgcn_fmed3f(l[j], -7.0f, 7.0f), __builtin_amdgcn_fmed3f(l[j + 1], -7.0f, 7.0f)};
                        const f32x2 t = xg * (-1.702f * 1.4426950408889634f);
                        const f32x2 d = (f32x2){__builtin_amdgcn_exp2f(t[0]), __builtin_amdgcn_exp2f(t[1])} + 1.0f;
                        const f32x2 sg = {__builtin_amdgcn_rcpf(d[0]), __builtin_amdgcn_rcpf(d[1])};
                        const f32x2 o = (xg * sg) * (xl * ACT8_SCALE + ACT8_SCALE);
                        r[4 * n + j] = o[0]; r[4 * n + j + 1] = o[1]; } }
                u32x2 w; w.x = pk_fp8x4(r[0], r[1], r[2], r[3]); w.y = pk_fp8x4(r[4], r[5], r[6], r[7]);
                if (m & 1) *(u32x4*)(O + (size_t)(roww + ai * HALF + (m - 1) * 16) * 1024 + ocolw) = widen16(wprev, w); else wprev = w; }
    }
};
struct EpiMoe2 {
    static constexpr bool PERM = true, AFTER = false, ALIGN = true; static constexpr bool SKIP_B1 = false;
    unsigned char* O; const float* b2; const float* gate; float yscale;
    struct Pre { f32x4 bv[2][2]; float gts[2][4]; }; static constexpr bool HOISTOK = true; static constexpr int NPRE = 12;
    __device__ __forceinline__ const float* stash_ptr(const Unit& u, int tid) const { return tid < 256 ? gate + u.pm * BM + tid : b2 + (size_t)u.e * 1024 + u.pn * BM + (tid - 256); }
    __device__ __forceinline__ Pre from_stash(const LAS float* st, int wr, int wc, int fr, int fq) const { Pre p; const LAS float* bp = st + 256 + wc * 32 + 8 * fq;
#pragma unroll
        for (int bj = 0; bj < 2; ++bj) { p.bv[bj][0] = *(const LAS f32x4*)(bp + bj * HALF); p.bv[bj][1] = *(const LAS f32x4*)(bp + bj * HALF + 4); }
#pragma unroll
        for (int ai = 0; ai < 2; ++ai)
#pragma unroll
            for (int m = 0; m < 4; ++m) p.gts[ai][m] = st[ai * HALF + wr * 64 + m * 16 + fr];
        return p; }

    static __device__ __forceinline__ void touch(Pre& p) { asm volatile("" : "+v"(p.bv[0][0]), "+v"(p.bv[0][1]), "+v"(p.bv[1][0]), "+v"(p.bv[1][1]));
        asm volatile("" : "+v"(p.gts[0][0]), "+v"(p.gts[0][1]), "+v"(p.gts[0][2]), "+v"(p.gts[0][3]), "+v"(p.gts[1][0]), "+v"(p.gts[1][1]), "+v"(p.gts[1][2]), "+v"(p.gts[1][3])); }
    __device__ __forceinline__ Pre preload(const Unit& u, int wr, int wc, int fr, int fq) const {
        Pre p; const int row0 = u.pm * BM + wr * 64 + fr; const float* bp = b2 + (size_t)u.e * 1024 + u.pn * BM + wc * 32 + 8 * fq;
#pragma unroll
        for (int bj = 0; bj < 2; ++bj)
#pragma unroll
            for (int n = 0; n < 2; ++n) p.bv[bj][n] = *(const f32x4*)(bp + bj * HALF + 4 * n);
#pragma unroll
        for (int ai = 0; ai < 2; ++ai)
#pragma unroll
            for (int m = 0; m < 4; ++m) p.gts[ai][m] = gate[row0 + ai * HALF + m * 16];
        return p; }
    __device__ __forceinline__ void operator()(const f32x4 (&acc)[2][2][4][2], const Unit& u, int wr, int wc, int fr, int fq, const Pre& pre) const {
        const int row0 = u.pm * BM + wr * 64 + fr, roww = row0 + 16 * (fq & 1), colw = u.pn * BM + wc * 32 + 16 * (fq >> 1);
        u32x2 wprev[2] = {{0u, 0u}, {0u, 0u}};
#pragma unroll
        for (int ai = 0; ai < 2; ++ai)
#pragma unroll
            for (int m = 0; m < 4; ++m) { const float gt = pre.gts[ai][m] * yscale;
#pragma unroll
                for (int bj = 0; bj < 2; ++bj) { const f32x4 v0 = (acc[ai][bj][m][0] * (1.0f / (W8_SCALE * ACT8_SCALE)) + pre.bv[bj][0]) * gt, v1 = (acc[ai][bj][m][1] * (1.0f / (W8_SCALE * ACT8_SCALE)) + pre.bv[bj][1]) * gt;
#define Y8C(x) __builtin_amdgcn_fmed3f((x), -448.0f, 448.0f)
                    u32x2 w; w.x = pk_fp8x4(Y8C(v0[0]), Y8C(v0[1]), Y8C(v0[2]), Y8C(v0[3])); w.y = pk_fp8x4(Y8C(v1[0]), Y8C(v1[1]), Y8C(v1[2]), Y8C(v1[3]));
#undef Y8C
                    if (m & 1) *(u32x4*)(O + (size_t)(roww + ai * HALF + (m - 1) * 16) * 1024 + colw + bj * HALF) = widen16(wprev[bj], w); else wprev[bj] = w; } }
    }
};

#ifndef F8_SCALE
#define F8_SCALE 0
#endif
constexpr int STASH_OFF = 8 * HTB + 4608 + 128;
typedef int i32x8 __attribute__((ext_vector_type(8)));
typedef int i32x4 __attribute__((ext_vector_type(4)));
__device__ __forceinline__ i32x8 cat8(bf16x8 a, bf16x8 b) { const i32x4 x = __builtin_bit_cast(i32x4, a), y = __builtin_bit_cast(i32x4, b); return __builtin_shufflevector(x, y, 0, 1, 2, 3, 4, 5, 6, 7); }
template <class Epi, class Sched, bool F8 = false, bool GATHER = false>
__device__ __forceinline__ void gemm_phase(LAS unsigned char* lds, const Gemm g, const Sched& S, const Epi& E, const int* rowidx = nullptr) {
    const int tid = threadIdx.x, wid = __builtin_amdgcn_readfirstlane(tid >> 6), lane = tid & 63, wr = wid >> 2, wc = wid & 3, fr = lane & 15, fq = lane >> 4;
    const int Kb = g.Kb, nt = Kb / (BK * 2);
    int Ri[2], Ci2[2]; unsigned voffB[2];
#pragma unroll
    for (int i = 0; i < 2; ++i) { int R, C; stage_rc(tid * 16 + i * 8192, R, C); const int Rb = Epi::PERM ? ((R & ~31) + perm32(R & 31)) : R;
        Ri[i] = R; Ci2[i] = C * 2; voffB[i] = (unsigned)(Rb * Kb + C * 2); }
    const size_t kstep = (size_t)(BK * 2);
    const size_t hstep = (size_t)HALF * Kb;
    const size_t tstep = 2 * hstep;
    const size_t estep = (size_t)g.N * Kb;
    const unsigned ldsw = (unsigned)wid * 1024u;
    const int aoff = lds_byte(wr * 64 + fr, fq * 8), boff = lds_byte(wc * 32 + fr, fq * 8);
#define PG8_SA(b, h) (((b) * 2 + (h)) * HTB)
#define PG8_SB(b, h) ((4 + (b) * 2 + (h)) * HTB)
#define PG8_STAGE(bufoff, gbase, voff) do { _Pragma("unroll") for (int _i = 0; _i < 2; ++_i) \
        __builtin_amdgcn_global_load_lds((const unsigned*)((const char*)(gbase) + (voff)[_i]), (LAS unsigned*)(lds + (bufoff) + ldsw + _i * 8192), 16, 0, 0); } while (0)
#define PG8_LDA(dst, b, h) do { _Pragma("unroll") for (int m = 0; m < 4; ++m) _Pragma("unroll") for (int k = 0; k < 2; ++k) dst[m][k] = *(const LAS bf16x8*)(lds + PG8_SA(b, h) + aoff + m * 2048 + k * 1024); } while (0)
#define PG8_LDB(dst, b, h) do { _Pragma("unroll") for (int n = 0; n < 2; ++n) _Pragma("unroll") for (int k = 0; k < 2; ++k) dst[n][k] = *(const LAS bf16x8*)(lds + PG8_SB(b, h) + boff + n * 2048 + k * 1024); } while (0)
#define PG8_MMA(ai, bj, At, Bt) do { __builtin_amdgcn_s_setprio(1); _Pragma("unroll") for (int m = 0; m < 4; ++m) _Pragma("unroll") for (int n = 0; n < 2; ++n) { \
        if constexpr (F8) { const i32x8 b8_ = cat8(Bt[n][0], Bt[n][1]), a8_ = cat8(At[m][0], At[m][1]); \
            asm volatile("v_mfma_f32_16x16x128_f8f6f4 %0, %1, %2, %0" : "+v"(acc[ai][bj][m][n]) : "v"(b8_), "v"(a8_)); }   \
        else { _Pragma("unroll") for (int k = 0; k < 2; ++k) acc[ai][bj][m][n] = __builtin_amdgcn_mfma_f32_16x16x32_bf16(Bt[n][k], At[m][k], acc[ai][bj][m][n], 0, 0, 0); } } \
        __builtin_amdgcn_s_setprio(0); } while (0)
#define PG8_WAIT_V_(n) asm volatile("s_waitcnt vmcnt(" #n ")" ::: "memory")
#define PG8_WAIT_V(n) PG8_WAIT_V_(n)
#define PG8_WAIT_L(n) asm volatile("s_waitcnt lgkmcnt(" #n ")" ::: "memory")
#define PG8_BAR __builtin_amdgcn_s_barrier()
#define PG8_SCHED __builtin_amdgcn_sched_barrier(0)
#define PG8_AOFF(dst, u) do { _Pragma("unroll") for (int h_ = 0; h_ < 2; ++h_) _Pragma("unroll") for (int i_ = 0; i_ < 2; ++i_) { const int r_ = (u).pm * BM + h_ * HALF + Ri[i_]; \
        dst[h_][i_] = (unsigned)(GATHER ? rowidx[r_] : r_) * (unsigned)Kb + (unsigned)Ci2[i_]; } } while (0)
    Unit cur, nxt, nn; int ui = 0; bool has_nn = false;
    typename Epi::Pre pre{}; unsigned offNN[2][2] = {{0u, 0u}, {0u, 0u}}; float stash_v = 0.f;
    if (!S.next(0, cur)) return;
    bool has_next = S.next(1, nxt);
    unsigned offC[2][2], offN[2][2];
    PG8_AOFF(offC, cur);
    if (has_next) PG8_AOFF(offN, nxt); else PG8_AOFF(offN, cur);
    f32x4 acc[2][2][4][2];
#pragma unroll
    for (int a = 0; a < 2; ++a)
#pragma unroll
        for (int b = 0; b < 2; ++b)
#pragma unroll
            for (int m = 0; m < 4; ++m)
#pragma unroll
                for (int n = 0; n < 2; ++n) acc[a][b][m][n] = (f32x4){0.f, 0.f, 0.f, 0.f};
    bf16x8 At[4][2], B0[2][2], B1[2][2];
    const char* const gA = (const char*)g.A;
    const char* cB = (const char*)g.Bt + (size_t)cur.e * estep + (size_t)cur.pn * tstep;
    PG8_STAGE(PG8_SB(0, 0), cB, voffB); PG8_STAGE(PG8_SB(0, 1), cB + hstep, voffB); PG8_STAGE(PG8_SA(0, 0), gA, offC[0]); PG8_STAGE(PG8_SA(0, 1), gA, offC[1]);
    if (wr == 1) PG8_BAR;
    PG8_WAIT_V(2); PG8_BAR;
    PG8_STAGE(PG8_SB(1, 0), cB + kstep, voffB); PG8_STAGE(PG8_SA(1, 0), gA + kstep, offC[0]); PG8_STAGE(PG8_SB(1, 1), cB + hstep + kstep, voffB);
    PG8_WAIT_V(6); PG8_BAR;
    for (;;) {
        const char* nB = has_next ? (const char*)g.Bt + (size_t)nxt.e * estep + (size_t)nxt.pn * tstep : cB;
#pragma nounroll
        for (int t = 0; t < nt; t += 2) {
            const bool last = (t == nt - 2);
            const char* a1 = gA + (size_t)(t + 1) * kstep;
            const char* a2 = last ? gA : gA + (size_t)(t + 2) * kstep; const char* b2 = last ? nB : cB + (size_t)(t + 2) * kstep;
            const char* a3 = a2 + kstep; const char* b3 = b2 + kstep;
            unsigned o2[2][2];
#pragma unroll
            for (int h = 0; h < 2; ++h)
#pragma unroll
                for (int i = 0; i < 2; ++i) o2[h][i] = last ? offN[h][i] : offC[h][i];
            constexpr int HOIST = Epi::HOISTOK ? 1 + (GATHER ? 4 : 0) : 0;
#define PG8_WAIT_H() do { if (HOIST > 0 && last) { if constexpr (HOIST == 5) PG8_WAIT_V(13); else if constexpr (HOIST == 1) PG8_WAIT_V(9); else PG8_WAIT_V(8); } else PG8_WAIT_V(8); } while (0)
            static_assert(HOIST == 0 || HOIST == 1 || HOIST == 5, "add the matching wait count");
            PG8_LDB(B0, 0, 0); if constexpr (!Epi::SKIP_B1) PG8_LDB(B1, 0, 1); PG8_SCHED; PG8_LDA(At, 0, 0); PG8_STAGE(PG8_SA(1, 1), a1, offC[1]);
            if (HOIST > 0 && last) { PG8_SCHED;
                { const float* sp_ = E.stash_ptr(cur, tid); asm volatile("global_load_dword %0, %1, off" : "=v"(stash_v) : "v"(sp_) : "memory"); }
                has_nn = has_next && S.next(ui + 2, nn);
                if constexpr (GATHER) { const int pmn = has_nn ? nn.pm : cur.pm;
#pragma unroll
                    for (int h_ = 0; h_ < 2; ++h_)
#pragma unroll
                        for (int i_ = 0; i_ < 2; ++i_) { const int* ip_ = rowidx + (pmn * BM + h_ * HALF + Ri[i_]); asm volatile("global_load_dword %0, %1, off" : "=v"(offNN[h_][i_]) : "v"(ip_) : "memory"); } }
                else { if (has_nn) PG8_AOFF(offNN, nn); else PG8_AOFF(offNN, cur); }
                PG8_SCHED; }
            PG8_WAIT_H(); PG8_WAIT_L(0); PG8_BAR; PG8_MMA(0, 0, At, B0); if constexpr (!Epi::SKIP_B1) PG8_MMA(0, 1, At, B1); PG8_BAR; PG8_SCHED;
            PG8_LDA(At, 0, 1); PG8_STAGE(PG8_SB(0, 0), b2, voffB); PG8_STAGE(PG8_SB(0, 1), b2 + hstep, voffB); PG8_STAGE(PG8_SA(0, 0), a2, o2[0]);
            PG8_WAIT_H(); PG8_WAIT_L(0); PG8_BAR; PG8_MMA(1, 0, At, B0); if constexpr (!Epi::SKIP_B1) PG8_MMA(1, 1, At, B1); PG8_BAR; PG8_SCHED;
            PG8_LDB(B0, 1, 0); if constexpr (!Epi::SKIP_B1) PG8_LDB(B1, 1, 1); PG8_SCHED; PG8_LDA(At, 1, 0); PG8_STAGE(PG8_SA(0, 1), a2, o2[1]);
            PG8_WAIT_V(8);
            if (HOIST > 0 && last) { ((LAS float*)(lds + STASH_OFF))[tid] = stash_v;
                if constexpr (GATHER) {
#pragma unroll
                    for (int h_ = 0; h_ < 2; ++h_)
#pragma unroll
                        for (int i_ = 0; i_ < 2; ++i_) offNN[h_][i_] = offNN[h_][i_] * (unsigned)Kb + (unsigned)Ci2[i_]; } }
            PG8_WAIT_L(0); PG8_BAR; PG8_MMA(0, 0, At, B0); if constexpr (!Epi::SKIP_B1) PG8_MMA(0, 1, At, B1); PG8_BAR; PG8_SCHED;
            PG8_LDA(At, 1, 1); PG8_STAGE(PG8_SB(1, 0), b3, voffB); PG8_STAGE(PG8_SB(1, 1), b3 + hstep, voffB); PG8_STAGE(PG8_SA(1, 0), a3, o2[0]);
            PG8_WAIT_V(8); PG8_WAIT_L(0); PG8_BAR; PG8_MMA(1, 0, At, B0); if constexpr (!Epi::SKIP_B1) PG8_MMA(1, 1, At, B1); PG8_BAR; PG8_SCHED;
#undef PG8_WAIT_H
        }
        if constexpr (Epi::ALIGN) { if (wr == 0) PG8_BAR; }
        if constexpr (F8) asm volatile("s_nop 7\n\ts_nop 7\n\ts_nop 7" ::: "memory");
        if constexpr (!Epi::HOISTOK) {
            has_nn = has_next && S.next(ui + 2, nn);
            pre = E.preload(cur, wr, wc, fr, fq);
            if (has_nn) PG8_AOFF(offNN, nn); else PG8_AOFF(offNN, cur);
            if constexpr (GATHER) asm volatile("" : "+v"(offNN[0][0]), "+v"(offNN[0][1]), "+v"(offNN[1][0]), "+v"(offNN[1][1])); }
        if constexpr (Epi::HOISTOK) pre = E.from_stash((const LAS float*)(lds + STASH_OFF), wr, wc, fr, fq);
        E(acc, cur, wr, wc, fr, fq, pre);
        if (!has_next) break;
#pragma unroll
        for (int a = 0; a < 2; ++a)
#pragma unroll
            for (int b = 0; b < 2; ++b)
#pragma unroll
                for (int m = 0; m < 4; ++m)
#pragma unroll
                    for (int n = 0; n < 2; ++n) acc[a][b][m][n] = (f32x4){0.f, 0.f, 0.f, 0.f};
#pragma unroll
        for (int h = 0; h < 2; ++h)
#pragma unroll
            for (int i = 0; i < 2; ++i) { offC[h][i] = offN[h][i]; if (has_nn) offN[h][i] = offNN[h][i]; }
        cur = nxt; cB = nB; nxt = nn; has_next = has_nn; ++ui;
        if constexpr (Epi::ALIGN) { if (wr == 1) PG8_BAR; }
    }
    PG8_WAIT_V(0);
    if constexpr (!Epi::ALIGN) { if (wr == 0) PG8_BAR; }
    PG8_BAR;
    if constexpr (Epi::AFTER) E.after(acc, cur, wr, wc, fr, fq, lds);
#undef PG8_SA
#undef PG8_SB
#undef PG8_STAGE
#undef PG8_LDA
#undef PG8_LDB
#undef PG8_MMA
#undef PG8_WAIT_V
#undef PG8_WAIT_V_
#undef PG8_WAIT_L
#undef PG8_BAR
#undef PG8_SCHED
#undef PG8_AOFF
}
}

constexpr int NWAVES = 8, NTHR = 512;
constexpr int T = 65536, D = 1024, NB = 32, S = 2048, MEMT = 256;
constexpr int NE = 32, TOPK = 4;
constexpr int NSLOT_MAX = T * TOPK + NE * 256;
constexpr int NTILE_MAX = NSLOT_MAX / 256;
constexpr int NCHUNK = T / 256;
constexpr float LN_EPS = 1e-5f;
constexpr float DN_ALPHA = 1.4142135623730951f;
constexpr int NPH = 22;

constexpr size_t MiB = 1u << 20;
constexpr size_t WS_CTL = 0, CTL_ZERO_BYTES = 1 * MiB;
constexpr size_t WS_WGHIST = 1 * MiB;
constexpr size_t WS_TILETAB = 1 * MiB + 256 * 1024;
constexpr size_t WS_B1P = 1 * MiB + 512 * 1024;
constexpr size_t WS_GWT = 2 * MiB;
constexpr size_t WS_TOKE = 3 * MiB, WS_TOKG = 4 * MiB, WS_TOKR = 5 * MiB, WS_TOKS = 6 * MiB;
constexpr size_t WS_SLOTG = 7 * MiB, WS_SLOTT = 9 * MiB;
constexpr size_t WS_GLOG = 11 * MiB;
constexpr size_t WS_LOGITS = 16 * MiB;
constexpr size_t WS_WINA = 32 * MiB, WS_WOUTA = 34 * MiB, WS_WINB = 36 * MiB, WS_WOUTB = 38 * MiB, WS_WMKV = 40 * MiB, WS_WKV = 42 * MiB, WS_WPOOL = 45 * MiB, WS_WR = 47 * MiB;
constexpr size_t WS_MEMB = 48 * MiB, WS_KVMEM = 64 * MiB;
constexpr size_t WS_W1 = 80 * MiB, WS_W2 = 336 * MiB;
constexpr size_t WS_R1 = 464 * MiB, WS_R2 = 592 * MiB;
constexpr size_t WS_ACT = 720 * MiB, WS_Y = 1248 * MiB, WS_H1Q = 1776 * MiB, WS_END = 1840 * MiB;
constexpr size_t WS_PROJ = 720 * MiB, WS_CAT = 848 * MiB, WS_MIX = 976 * MiB, WS_DBUF = 1104 * MiB, WS_KF = 1200 * MiB  , WS_Q8 = 1248 * MiB  , WS_VF = 1296 * MiB;
static_assert(WS_ACT + (size_t)NSLOT_MAX * 2048 <= WS_Y && WS_Y + (size_t)NSLOT_MAX * 2048 <= WS_END, "ws map");
constexpr int CW_BAR = 4096;

constexpr int RING_BYTES = 131072;
constexpr int TAB_OFF = RING_BYTES;
constexpr int MISC_OFF = TAB_OFF + 4608;
constexpr int LDS_BYTES = 147456;
static_assert(MISC_OFF + 128 == pg8::STASH_OFF && pg8::STASH_OFF + 2048 <= LDS_BYTES, "LDS map");

#define RLX_AGENT __ATOMIC_RELAXED, __HIP_MEMORY_SCOPE_AGENT
#define LDS_WAIT() asm volatile("s_waitcnt lgkmcnt(0)" ::: "memory")
#define VM_WAIT() asm volatile("s_waitcnt vmcnt(0)" ::: "memory")

#define XB_TMO      128
#define XB_XCNT(j)  (256  + 64 * (j))
#define XB_XSUB(j)  (1280 + 64 * (j))
#define XB_XGEN(j)  (2304 + 64 * (j))
#define XB_TOP      3328
#define XB_TOPGEN   3392
#define XCD_BAR_WORDS 3456
#define XB_SPIN_CAP (1u << 18)
__device__ __forceinline__ unsigned xb_ld(unsigned* p)              { return __hip_atomic_load(p, __ATOMIC_RELAXED, __HIP_MEMORY_SCOPE_AGENT); }
__device__ __forceinline__ unsigned xb_add(unsigned* p, unsigned v) { return __hip_atomic_fetch_add(p, v, __ATOMIC_RELAXED, __HIP_MEMORY_SCOPE_AGENT); }
__device__ __forceinline__ unsigned xb_xcc_id() { return (unsigned)__builtin_amdgcn_s_getreg((3 << 11) | 20) & 0xFu; }
#define XB_SPIN(cond, bar) do { unsigned _sp = 0; while (cond) { __builtin_amdgcn_s_sleep(1); \
    if ((++_sp & 255u) == 0u) { if (xb_ld(&(bar)[XB_TMO])) break; if (_sp > XB_SPIN_CAP) { atomicAdd(&(bar)[XB_TMO], 1u); break; } } } } while (0)
struct XcdBarrier { unsigned* bar; unsigned x; volatile LAS unsigned* st; };
__device__ __forceinline__ XcdBarrier xcd_barrier_post(unsigned* bar, volatile LAS unsigned* st) {
    XcdBarrier b; b.bar = bar; b.x = xb_xcc_id(); b.st = st;
    if (threadIdx.x == 0) (void)xb_add(&bar[XB_XCNT(b.x)], 1u);
    return b;
}
__device__ __forceinline__ void xcd_barrier_complete(unsigned* bar, unsigned x, unsigned& nloc, unsigned& nx) {
    const unsigned G = gridDim.x * gridDim.y * gridDim.z;
    unsigned sum, cnt, mine, sp = 0u;
    for (;;) {
        sum = 0u; cnt = 0u; mine = 0u;
#pragma unroll
        for (unsigned j = 0; j < 16; ++j) { const unsigned c = xb_ld(&bar[XB_XCNT(j)]); sum += c; cnt += (c > 0u) ? 1u : 0u; mine = (j == x) ? c : mine; }
        if (sum == G) break;
        __builtin_amdgcn_s_sleep(1);
        if ((++sp & 255u) == 0u) { if (xb_ld(&bar[XB_TMO])) break; if (sp > XB_SPIN_CAP) { atomicAdd(&bar[XB_TMO], 1u); break; } }
    }
    nloc = mine > 0u ? mine : 1u; nx = cnt > 0u ? cnt : 1u;
}
__device__ __forceinline__ void xcd_barrier(const XcdBarrier& b) {
    asm volatile("s_waitcnt vmcnt(0)" ::: "memory");
    __syncthreads();
    if (threadIdx.x == 0) {
        unsigned* bar = b.bar;
        __builtin_amdgcn_s_waitcnt(0);
        unsigned nloc = b.st[0], nx = b.st[1];
        if (nloc == 0u) { xcd_barrier_complete(bar, b.x, nloc, nx); b.st[0] = nloc; b.st[1] = nx; }
        const unsigned old = xb_add(&bar[XB_XSUB(b.x)], 1u);
        const unsigned gen = old / nloc;
        if (old + 1u == (gen + 1u) * nloc) {
            __builtin_amdgcn_fence(__ATOMIC_RELEASE, "agent");
            asm volatile("s_waitcnt vmcnt(0)" ::: "memory");
            const unsigned og = xb_add(&bar[XB_TOP], 1u);
            const unsigned tg = og / nx;
            if (og + 1u == (tg + 1u) * nx) xb_add(&bar[XB_TOPGEN], 1u);
            else XB_SPIN(xb_ld(&bar[XB_TOPGEN]) == tg, bar);
            __builtin_amdgcn_fence(__ATOMIC_ACQUIRE, "agent");
            xb_add(&bar[XB_XGEN(b.x)], 1u);
            asm volatile("s_waitcnt vmcnt(0)" ::: "memory");
        } else {
            XB_SPIN(xb_ld(&bar[XB_XGEN(b.x)]) == gen, bar);
            __builtin_amdgcn_fence(__ATOMIC_ACQUIRE, "agent");
            asm volatile("s_waitcnt vmcnt(0)" ::: "memory");
        }
    }
    __syncthreads();
}

__device__ __forceinline__ float wave_max(float v) {
#define WM_DPP(x, ctrl) __int_as_float(__builtin_amdgcn_update_dpp(0, __float_as_int(x), (ctrl), 0xf, 0xf, false))
    v = fmaxf(v, WM_DPP(v, 0x128)); v = fmaxf(v, WM_DPP(v, 0x124)); v = fmaxf(v, WM_DPP(v, 0x122)); v = fmaxf(v, WM_DPP(v, 0x121));
#undef WM_DPP
    { const auto rr = __builtin_amdgcn_permlane16_swap(__float_as_uint(v), __float_as_uint(v), false, false); v = fmaxf(__uint_as_float(rr[0]), __uint_as_float(rr[1])); }
    { const auto rr = __builtin_amdgcn_permlane32_swap(__float_as_uint(v), __float_as_uint(v), false, false); v = fmaxf(__uint_as_float(rr[0]), __uint_as_float(rr[1])); }
    return v;
}
typedef int i32x4n __attribute__((ext_vector_type(4)));
__device__ __forceinline__ float sumsq_fp8x16(i32x4n w) {
    float a = 0.f;
#pragma unroll
    for (int e = 0; e < 4; ++e) { const f32x2 lo = __builtin_amdgcn_cvt_pk_f32_fp8(w[e], false), hi = __builtin_amdgcn_cvt_pk_f32_fp8(w[e], true); a += lo[0] * lo[0] + lo[1] * lo[1] + hi[0] * hi[0] + hi[1] * hi[1]; }
    return a;
}
__device__ __forceinline__ float wave_sum(float v) {
#define WS_DPP(x, ctrl) __int_as_float(__builtin_amdgcn_update_dpp(0, __float_as_int(x), (ctrl), 0xf, 0xf, false))
    v += WS_DPP(v, 0x128); v += WS_DPP(v, 0x124); v += WS_DPP(v, 0x122); v += WS_DPP(v, 0x121);
#undef WS_DPP
    { const auto rr = __builtin_amdgcn_permlane16_swap(__float_as_uint(v), __float_as_uint(v), false, false); v = __uint_as_float(rr[0]) + __uint_as_float(rr[1]); }
    { const auto rr = __builtin_amdgcn_permlane32_swap(__float_as_uint(v), __float_as_uint(v), false, false); v = __uint_as_float(rr[0]) + __uint_as_float(rr[1]); }
    return v;
}

template <int MODE>
__device__ __forceinline__ void tr_item(const float* W, int ldn, bf16_t* WT, int dld, int row_off, int col_off, LAS float* scr, int k0, int n0, int lane) {
    {
        f32x4 t[8];
#pragma unroll
        for (int i = 0; i < 8; ++i) t[i] = *(const f32x4*)(W + (size_t)(k0 + 8 * i + (lane >> 3)) * ldn + n0 + 4 * (lane & 7));
#pragma unroll
        for (int i = 0; i < 8; ++i) { LAS float* d = scr + (8 * i + (lane >> 3)) * 33 + 4 * (lane & 7); d[0] = t[i][0]; d[1] = t[i][1]; d[2] = t[i][2]; d[3] = t[i][3]; }
    }
    LDS_WAIT(); asm volatile("" ::: "memory");
    const int c = lane & 7;
#pragma unroll
    for (int j = 0; j < 4; ++j) { const int n = (lane >> 3) + 8 * j; const LAS float* s = scr + (8 * c) * 33 + n;
        float f[8];
#pragma unroll
        for (int q = 0; q < 8; ++q) f[q] = s[q * 33];
        u32x4 o; o.x = cvt_pk_bf16(f[0], f[1]); o.y = cvt_pk_bf16(f[2], f[3]); o.z = cvt_pk_bf16(f[4], f[5]); o.w = cvt_pk_bf16(f[6], f[7]);
        const int nn = n0 + n;
        const int drow = (MODE == 1) ? ((nn & ~255) + 128 * (nn & 1) + ((nn & 255) >> 1)) : (row_off + nn);
        *(u32x4*)(WT + (size_t)drow * dld + col_off + k0 + 8 * c) = o;
        if (MODE == 2) {
            u32x4 l; l.x = cvt_pk_bf16(f[0] - bf_lo(o.x), f[1] - bf_hi(o.x)); l.y = cvt_pk_bf16(f[2] - bf_lo(o.y), f[3] - bf_hi(o.y));
            l.z = cvt_pk_bf16(f[4] - bf_lo(o.z), f[5] - bf_hi(o.z)); l.w = cvt_pk_bf16(f[6] - bf_lo(o.w), f[7] - bf_hi(o.w));
            *(u32x4*)(WT + (size_t)(drow + 32) * dld + col_off + k0 + 8 * c) = l;
        }
    }
    LDS_WAIT(); asm volatile("" ::: "memory");
}

template <bool PERMW>
__device__ __forceinline__ void tr_item8(const float* W, int ldn, unsigned char* WT, int dld, LAS float* scr, int k0, int n0, int lane) {
    {
        f32x4 t[8];
#pragma unroll
        for (int i = 0; i < 8; ++i) t[i] = *(const f32x4*)(W + (size_t)(k0 + 8 * i + (lane >> 3)) * ldn + n0 + 4 * (lane & 7));
#pragma unroll
        for (int i = 0; i < 8; ++i) { LAS float* d = scr + (8 * i + (lane >> 3)) * 33 + 4 * (lane & 7); d[0] = t[i][0]; d[1] = t[i][1]; d[2] = t[i][2]; d[3] = t[i][3]; }
    }
    LDS_WAIT(); asm volatile("" ::: "memory");
    const int c = lane & 3;
#pragma unroll
    for (int j = 0; j < 2; ++j) { const int n = (lane >> 2) + 16 * j; const LAS float* s = scr + (16 * c) * 33 + n;
        float f[16];
#pragma unroll
        for (int q = 0; q < 16; ++q) f[q] = s[q * 33] * pg8::W8_SCALE;
        u32x4 o; o.x = pg8::pk_fp8x4(f[0], f[1], f[2], f[3]); o.y = pg8::pk_fp8x4(f[4], f[5], f[6], f[7]); o.z = pg8::pk_fp8x4(f[8], f[9], f[10], f[11]); o.w = pg8::pk_fp8x4(f[12], f[13], f[14], f[15]);
        const int nn = n0 + n;
        const int drow = PERMW ? ((nn & ~255) + 128 * (nn & 1) + ((nn & 255) >> 1)) : nn;
        *(u32x4*)(WT + (size_t)drow * dld + k0 + 16 * c) = o;
    }
    LDS_WAIT(); asm volatile("" ::: "memory");
}

struct Args {
    const float* in[22]; float* out; unsigned char* ws; int ph_lo, ph_hi;
};

__device__ __forceinline__ void f32_to_bf16_rows(const float* __restrict__ src, bf16_t* __restrict__ dst, size_t n4, size_t gt, size_t ngt) {
    size_t i = gt;
    for (; i + 7 * ngt < n4; i += 8 * ngt) { f32x4 a[8];
#pragma unroll
        for (int u = 0; u < 8; ++u) a[u] = *(const f32x4*)(src + (i + u * ngt) * 4);
#pragma unroll
        for (int u = 0; u < 8; ++u) { u32x2 o; o.x = cvt_pk_bf16(a[u][0], a[u][1]); o.y = cvt_pk_bf16(a[u][2], a[u][3]); *(u32x2*)(dst + (i + u * ngt) * 4) = o; } }
    for (; i < n4; i += ngt) { const f32x4 a = *(const f32x4*)(src + i * 4); u32x2 o; o.x = cvt_pk_bf16(a[0], a[1]); o.y = cvt_pk_bf16(a[2], a[3]); *(u32x2*)(dst + i * 4) = o; }
}

__device__ __forceinline__ void p0_prologue(const Args& a, LAS unsigned char* lds, int wave, int lane) {
    unsigned char* ws = a.ws;
    LAS float* scr = (LAS float*)(lds + wave * 16384);
    const int G = gridDim.x, gw = blockIdx.x * NWAVES + wave, NGW = G * NWAVES;
    const size_t gt = (size_t)blockIdx.x * NTHR + threadIdx.x, ngt = (size_t)G * NTHR;
    constexpr int I_SQ = 16 * 32, I_MKV = 16 * 16, I_KV = 16 * 48, I_R = 16, I_POOL = 3 * 6, I_W1 = 16 * 64, I_W2 = 16 * 32;
    constexpr int NIT = 4 * I_SQ + 2 * I_MKV + I_KV + 2 * I_R + 4 * I_POOL + 64 * I_W1 + 64 * I_W2;
    for (int it = gw; it < NIT; it += NGW) {
        int r = it;
        if (r < 4 * I_SQ) { const int w = r / I_SQ; r -= w * I_SQ; const float* src = a.in[w == 0 ? 6 : (w == 1 ? 10 : (w == 2 ? 13 : 15))];
            bf16_t* dst = (bf16_t*)(ws + (w == 0 ? WS_WINA : (w == 1 ? WS_WOUTA : (w == 2 ? WS_WINB : WS_WOUTB))));
            if (w == 1 && r < 12 * 32) continue;
            if (w == 2) { tr_item8<false>(src, 1024, (unsigned char*)dst, 1024, scr, 64 * (r / 32), 32 * (r % 32), lane); continue; }
            tr_item<0>(src, 1024, dst, 1024, 0, 0, scr, 64 * (r / 32), 32 * (r % 32), lane); continue; }
        r -= 4 * I_SQ;
        if (r < 2 * I_MKV) { const int w = r / I_MKV; r -= w * I_MKV;
            tr_item8<false>(a.in[w == 0 ? 9 : 14], 512, ws + WS_WMKV + (size_t)512 * w * 1024, 1024, scr, 64 * (r / 16), 32 * (r % 16), lane); continue; }
        r -= 2 * I_MKV;
        if (r < I_KV) { tr_item8<false>(a.in[11], 1548, ws + WS_WKV, 1024, scr, 64 * (r / 48), 32 * (r % 48), lane); continue; }
        r -= I_KV;
        if (r < 2 * I_R) { const int l = r / I_R; r -= l * I_R;
            tr_item<2>(a.in[16] + (size_t)l * 1024 * 32, 32, (bf16_t*)(ws + WS_WR) + (size_t)l * 256 * 1024, 1024, 0, 0, scr, 64 * r, 0, lane); continue; }
        r -= 2 * I_R;
        if (r < 4 * I_POOL) continue;
        r -= 4 * I_POOL;
        if (r < 64 * I_W1) { const int le = r / I_W1; r -= le * I_W1;
            tr_item8<true>(a.in[18] + (size_t)le * 1024 * 2048, 2048, ws + WS_W1 + (size_t)le * 2048 * 1024, 1024, scr, 64 * (r / 64), 32 * (r % 64), lane); continue; }
        r -= 64 * I_W1;
        { const int le = r / I_W2; r -= le * I_W2;
            tr_item8<false>(a.in[20] + (size_t)le * 1024 * 1024, 1024, ws + WS_W2 + (size_t)le * 1024 * 1024, 1024, scr, 64 * (r / 32), 32 * (r % 32), lane); }
    }
    f32_to_bf16_rows(a.in[0], (bf16_t*)(ws + WS_R1), (size_t)T * D / 4, gt, ngt);
    for (size_t i = gt; i < (size_t)NB * MEMT * D / 4; i += ngt) { const f32x4 v = *(const f32x4*)(a.in[1] + i * 4); *(unsigned*)(ws + WS_MEMB + i * 4) = pg8::pk_fp8x4(v[0], v[1], v[2], v[3]); }
    {
      bf16_t* wo = (bf16_t*)(ws + WS_WOUTA); const float* pw = a.in[7]; const float* psc = a.in[8]; const float* wout = a.in[10];
      for (size_t i = gt; i < (size_t)4 * 96 * 256; i += ngt) { const int n4 = (int)(i & 255), kk = (int)(i >> 8), g = kk / 96, c2 = kk % 96;
          const float* p0 = pw + ((size_t)g * 192 + 2 * c2) * 192; const float* p1 = p0 + 192; const float* sr = psc + g * 192; const float* wc = wout + (size_t)g * 192 * 1024 + 4 * n4;
          f32x4 a0 = {0.f, 0.f, 0.f, 0.f}, a1 = {0.f, 0.f, 0.f, 0.f};
#pragma unroll 4
          for (int j = 0; j < 192; j += 4) { const f32x4 q0 = *(const f32x4*)(p0 + j), q1 = *(const f32x4*)(p1 + j), sv = *(const f32x4*)(sr + j);
#pragma unroll
              for (int r = 0; r < 4; ++r) { const f32x4 w = *(const f32x4*)(wc + (size_t)(j + r) * 1024); a0 += w * (q0[r] * sv[r]); a1 += w * (q1[r] * sv[r]); } }
          const int k = g * 192 + 2 * c2;
#pragma unroll
          for (int r = 0; r < 4; ++r) *(unsigned*)(wo + (size_t)(4 * n4 + r) * 1024 + k) = cvt_pk_bf16(a0[r], a1[r]); }
      bf16_t* wr = (bf16_t*)(ws + WS_WR);
      for (size_t i = gt; i < (size_t)2 * 64 * 128; i += ngt) { const int l = (int)(i / (64 * 128)), rr = (int)((i / 128) % 64), ch = (int)(i % 128);
          const int row = 64 + rr;
          *(u32x4*)(wr + ((size_t)l * 256 + row) * 1024 + ch * 8) = (u32x4){0u, 0u, 0u, 0u}; } }
    { float* b1p = (float*)(ws + WS_B1P); const float* b1 = a.in[19];
      for (size_t i = gt; i < (size_t)2 * 32 * 2048; i += ngt) { const int np = (int)(i & 2047); const size_t le = i >> 11;
          const int orig = 2 * (128 * (np >> 8) + (np & 127)) + ((np >> 7) & 1); b1p[i] = b1[le * 2048 + orig]; }
      float* gwt = (float*)(ws + WS_GWT); const float* kvw = a.in[11];
      for (size_t i = gt; i < (size_t)12 * 1024; i += ngt) { const int j = (int)(i / 1024), k = (int)(i % 1024); gwt[i] = kvw[(size_t)k * 1548 + 1536 + j]; } }
}

__device__ __forceinline__ void pool_d_phase(const bf16_t* proj, bf16_t* dbuf) {
    const size_t gt = (size_t)blockIdx.x * NTHR + threadIdx.x, ngt = (size_t)gridDim.x * NTHR;
    for (size_t id = gt; id < (size_t)1024 * 96; id += ngt) {
        const int cc = (int)(id % 96), seg = (int)(id / 96), b = seg >> 5, s0 = (seg & 31) * 64, g = cc / 24, w = 2 << g;
        const bf16_t* up = proj + (size_t)b * S * 1024 + cc * 8; bf16_t* dp = dbuf + (size_t)b * S * 1024 + cc * 8;
        float sum[8];
#pragma unroll
        for (int q = 0; q < 8; ++q) sum[q] = 0.f;
        {
            u32x4 pre[16];
#pragma unroll
            for (int k = 0; k < 16; ++k) { const int r = s0 - 16 + k; const bool ok = (r >= s0 - w) && (r >= 0); pre[k] = *(const u32x4*)(up + (size_t)(ok ? r : 0) * 1024); }
#pragma unroll
            for (int k = 0; k < 16; ++k) { const int r = s0 - 16 + k; if ((r >= s0 - w) && (r >= 0)) { const u32x4 v = pre[k];
                sum[0] += bf_lo(v.x); sum[1] += bf_hi(v.x); sum[2] += bf_lo(v.y); sum[3] += bf_hi(v.y); sum[4] += bf_lo(v.z); sum[5] += bf_hi(v.z); sum[6] += bf_lo(v.w); sum[7] += bf_hi(v.w); } }
        }
        for (int t0 = s0; t0 < s0 + 64; t0 += 8) {
            u32x4 vt[8], vo[8];
#pragma unroll
            for (int k = 0; k < 8; ++k) vt[k] = *(const u32x4*)(up + (size_t)(t0 + k) * 1024);
#pragma unroll
            for (int k = 0; k < 8; ++k) { const int to = t0 + k - w; vo[k] = *(const u32x4*)(up + (size_t)(to >= 0 ? to : 0) * 1024); }
#pragma unroll
            for (int k = 0; k < 8; ++k) { const int t = t0 + k; const u32x4 v = vt[k];
                float ut[8] = {bf_lo(v.x), bf_hi(v.x), bf_lo(v.y), bf_hi(v.y), bf_lo(v.z), bf_hi(v.z), bf_lo(v.w), bf_hi(v.w)};
#pragma unroll
                for (int q = 0; q < 8; ++q) sum[q] += ut[q];
                if (t - w >= 0) { const u32x4 o = vo[k];
                    sum[0] -= bf_lo(o.x); sum[1] -= bf_hi(o.x); sum[2] -= bf_lo(o.y); sum[3] -= bf_hi(o.y); sum[4] -= bf_lo(o.z); sum[5] -= bf_hi(o.z); sum[6] -= bf_lo(o.w); sum[7] -= bf_hi(o.w); }
                const float inv = 1.0f / (float)((t + 1) < w ? (t + 1) : w);
                float d[8];
#pragma unroll
                for (int q = 0; q < 8; ++q) d[q] = sum[q] * inv - ut[q];
                u32x4 o; o.x = cvt_pk_bf16(d[0], d[1]); o.y = cvt_pk_bf16(d[2], d[3]); o.z = cvt_pk_bf16(d[4], d[5]); o.w = cvt_pk_bf16(d[6], d[7]);
                *(u32x4*)(dp + (size_t)t * 1024) = o; }
        }
    }
}

typedef float f32x16 __attribute__((ext_vector_type(16)));
typedef short v4i16_t __attribute__((ext_vector_type(4)));
constexpr int ATT_SLOT = 16384, ATT_NSLOT = 4, ATT_C_OFF = ATT_NSLOT * ATT_SLOT  , ATT_W_OFF = ATT_C_OFF + 8192  , ATT_LDS = ATT_W_OFF + 128;
static_assert(ATT_LDS <= RING_BYTES, "attention LDS map");
constexpr float ATT_L2E = 1.4426950408889634f, ATT_C2 = 0.125f * 1.4426950408889634f, ATT_THR = 8.0f;

template <bool FOX>
__device__ __forceinline__ void att_tile(const LAS unsigned char* sb, f32x16& s0, f32x16& s1, const bf16x8 (&qf)[4], f32x16& O0, f32x16& O1, float& m, float& l,
                                         int kt, int qrow, bool diag, int h2, int kfo, int vfo) {
    __builtin_amdgcn_sched_barrier(0);
#pragma unroll
    for (int ks = 0; ks < 4; ++ks) {
        const bf16x8 k0 = *(const LAS bf16x8*)(sb + kfo + ks * 2048), k1 = *(const LAS bf16x8*)(sb + kfo + ks * 2048 + 512);
        s0 = __builtin_amdgcn_mfma_f32_32x32x16_bf16(k0, qf[ks], s0, 0, 0, 0); s1 = __builtin_amdgcn_mfma_f32_32x32x16_bf16(k1, qf[ks], s1, 0, 0, 0); }
    __builtin_amdgcn_sched_barrier(0);
    const unsigned va_ = (unsigned)(unsigned long)(sb + vfo);
    v4i16_t tv[2][4][2];
#define ATT_TR(dst, off) asm volatile("ds_read_b64_tr_b16 %0, %1 offset:%2" : "=v"(dst) : "v"(va_), "i"(off) : "memory")
    ATT_TR(tv[0][0][0], 0 * 4096 + 0 * 1024);    ATT_TR(tv[0][0][1], 0 * 4096 + 0 * 1024 + 512);
    ATT_TR(tv[0][1][0], 0 * 4096 + 1 * 1024);    ATT_TR(tv[0][1][1], 0 * 4096 + 1 * 1024 + 512);
    ATT_TR(tv[0][2][0], 0 * 4096 + 2 * 1024);    ATT_TR(tv[0][2][1], 0 * 4096 + 2 * 1024 + 512);
    ATT_TR(tv[0][3][0], 0 * 4096 + 3 * 1024);    ATT_TR(tv[0][3][1], 0 * 4096 + 3 * 1024 + 512);
    ATT_TR(tv[1][0][0], 1 * 4096 + 0 * 1024);    ATT_TR(tv[1][0][1], 1 * 4096 + 0 * 1024 + 512);
    ATT_TR(tv[1][1][0], 1 * 4096 + 1 * 1024);    ATT_TR(tv[1][1][1], 1 * 4096 + 1 * 1024 + 512);
    ATT_TR(tv[1][2][0], 1 * 4096 + 2 * 1024);    ATT_TR(tv[1][2][1], 1 * 4096 + 2 * 1024 + 512);
    ATT_TR(tv[1][3][0], 1 * 4096 + 3 * 1024);    ATT_TR(tv[1][3][1], 1 * 4096 + 3 * 1024 + 512);
#undef ATT_TR
    if (FOX && diag) {
#pragma unroll
        for (int r = 0; r < 16; ++r) { const int key = kt * 64 + (r & 3) + 8 * (r >> 2) + 4 * h2;
            s0[r] = (key > qrow) ? -INFINITY : s0[r]; s1[r] = (key + 32 > qrow) ? -INFINITY : s1[r]; }
    }
    float ta = fmaxf(fmaxf(s0[0], s0[1]), s1[0]), tb = fmaxf(fmaxf(s0[2], s0[3]), s1[1]); ta = fmaxf(fmaxf(ta, s1[2]), s1[3]);
#pragma unroll
    for (int r = 4; r < 16; r += 4) { ta = fmaxf(fmaxf(ta, s0[r]), s0[r + 1]); tb = fmaxf(fmaxf(tb, s0[r + 2]), s0[r + 3]); ta = fmaxf(fmaxf(ta, s1[r]), s1[r + 1]); tb = fmaxf(fmaxf(tb, s1[r + 2]), s1[r + 3]); }
    float tmax = fmaxf(ta, tb);
    { const auto rr = __builtin_amdgcn_permlane32_swap(__float_as_uint(tmax), __float_as_uint(tmax), false, false); tmax = fmaxf(__uint_as_float(rr[0]), __uint_as_float(rr[1])); }
    if (__any(tmax > m + ATT_THR)) {
        const float mn = fmaxf(m, tmax), alpha = __builtin_amdgcn_exp2f(m - mn); m = mn; l *= alpha;
#pragma unroll
        for (int r = 0; r < 16; ++r) { O0[r] *= alpha; O1[r] *= alpha; }
    }
    float ps = 0.f;
#pragma unroll
    for (int r = 0; r < 16; ++r) { s0[r] = __builtin_amdgcn_exp2f(s0[r] - m); s1[r] = __builtin_amdgcn_exp2f(s1[r] - m); ps += s0[r] + s1[r]; }
    l += ps;
    bf16x8 pf[2][2];
#pragma unroll
    for (int sp = 0; sp < 2; ++sp) { u32x4 a, b;
        a.x = cvt_pk_bf16(s0[8 * sp + 0], s0[8 * sp + 1]); a.y = cvt_pk_bf16(s0[8 * sp + 2], s0[8 * sp + 3]); a.z = cvt_pk_bf16(s0[8 * sp + 4], s0[8 * sp + 5]); a.w = cvt_pk_bf16(s0[8 * sp + 6], s0[8 * sp + 7]);
        b.x = cvt_pk_bf16(s1[8 * sp + 0], s1[8 * sp + 1]); b.y = cvt_pk_bf16(s1[8 * sp + 2], s1[8 * sp + 3]); b.z = cvt_pk_bf16(s1[8 * sp + 4], s1[8 * sp + 5]); b.w = cvt_pk_bf16(s1[8 * sp + 6], s1[8 * sp + 7]);
        pf[0][sp] = __builtin_bit_cast(bf16x8, a); pf[1][sp] = __builtin_bit_cast(bf16x8, b); }
    __builtin_amdgcn_sched_barrier(0);
    asm volatile("s_waitcnt lgkmcnt(0)" ::: "memory");
    __builtin_amdgcn_sched_barrier(0);
#pragma unroll
    for (int kb = 0; kb < 2; ++kb)
#pragma unroll
        for (int sp = 0; sp < 2; ++sp) { const int ki = 2 * kb + sp;
            const v4i16_t a0 = tv[0][ki][0], a1 = tv[0][ki][1], b0 = tv[1][ki][0], b1 = tv[1][ki][1];
            const bf16x8 va = (bf16x8){a0[0], a0[1], a0[2], a0[3], a1[0], a1[1], a1[2], a1[3]}, vb = (bf16x8){b0[0], b0[1], b0[2], b0[3], b1[0], b1[1], b1[2], b1[3]};
            O0 = __builtin_amdgcn_mfma_f32_32x32x16_bf16(va, pf[kb][sp], O0, 0, 0, 0); O1 = __builtin_amdgcn_mfma_f32_32x32x16_bf16(vb, pf[kb][sp], O1, 0, 0, 0); }
    __builtin_amdgcn_sched_barrier(0);
}
__device__ __forceinline__ void att_load_q(bf16x8 (&qf)[4], const bf16_t* Qrow, int h2) {
    u32x4 qraw[4];
#pragma unroll
    for (int ks = 0; ks < 4; ++ks) qraw[ks] = *(const u32x4*)(Qrow + 16 * ks + 8 * h2);
#pragma unroll
    for (int ks = 0; ks < 4; ++ks) { const u32x4 w = qraw[ks];
        u32x4 o; o.x = cvt_pk_bf16(ATT_C2 * bf_lo(w.x), ATT_C2 * bf_hi(w.x)); o.y = cvt_pk_bf16(ATT_C2 * bf_lo(w.y), ATT_C2 * bf_hi(w.y));
        o.z = cvt_pk_bf16(ATT_C2 * bf_lo(w.z), ATT_C2 * bf_hi(w.z)); o.w = cvt_pk_bf16(ATT_C2 * bf_lo(w.w), ATT_C2 * bf_hi(w.w)); qf[ks] = __builtin_bit_cast(bf16x8, o); }
}
__device__ __forceinline__ void att_store_o(bf16_t* op, const f32x16& O0, const f32x16& O1, float l) {
    { const auto rr = __builtin_amdgcn_permlane32_swap(__float_as_uint(l), __float_as_uint(l), false, false); l = __uint_as_float(rr[0]) + __uint_as_float(rr[1]); }
    const float il = 1.0f / l;
#pragma unroll
    for (int g = 0; g < 4; ++g) { u32x2 w0, w1;
        w0.x = cvt_pk_bf16(O0[4 * g + 0] * il, O0[4 * g + 1] * il); w0.y = cvt_pk_bf16(O0[4 * g + 2] * il, O0[4 * g + 3] * il);
        w1.x = cvt_pk_bf16(O1[4 * g + 0] * il, O1[4 * g + 1] * il); w1.y = cvt_pk_bf16(O1[4 * g + 2] * il, O1[4 * g + 3] * il);
        *(u32x2*)(op + 8 * g) = w0; *(u32x2*)(op + 32 + 8 * g) = w1; }
}
constexpr float ATT_S8 = 16.0f;
typedef int i32x8a __attribute__((ext_vector_type(8)));
typedef int i32x4a __attribute__((ext_vector_type(4)));
__device__ __forceinline__ void att_tile8(const LAS unsigned char* sb, f32x16& s0, f32x16& s1, const i32x8a qf8, f32x16& O0, f32x16& O1, float& m, float& l,
                                          int kt, int qrow, bool diag, int h2, int ql, int vfo) {
    __builtin_amdgcn_sched_barrier(0);
    {   const int sw = (ql >> 2) & 3;
        const LAS unsigned char* k0p = sb + ql * 64; const LAS unsigned char* k1p = k0p + 32 * 64;
        const int c0 = ((2 * h2) ^ sw) * 16, c1 = ((2 * h2 + 1) ^ sw) * 16;
        const i32x4a a00 = *(const LAS i32x4a*)(k0p + c0), a01 = *(const LAS i32x4a*)(k0p + c1), a10 = *(const LAS i32x4a*)(k1p + c0), a11 = *(const LAS i32x4a*)(k1p + c1);
        const i32x8a ka = __builtin_shufflevector(a00, a01, 0, 1, 2, 3, 4, 5, 6, 7), kb = __builtin_shufflevector(a10, a11, 0, 1, 2, 3, 4, 5, 6, 7);
        s0 = __builtin_amdgcn_mfma_scale_f32_32x32x64_f8f6f4(ka, qf8, s0, 0, 0, 0, 0, 0, 0);
        s1 = __builtin_amdgcn_mfma_scale_f32_32x32x64_f8f6f4(kb, qf8, s1, 0, 0, 0, 0, 0, 0); }
    __builtin_amdgcn_sched_barrier(0);
    if (diag) {
#pragma unroll
        for (int r = 0; r < 16; ++r) { const int key = kt * 64 + (r & 3) + 8 * (r >> 2) + 4 * h2;
            s0[r] = (key > qrow) ? -INFINITY : s0[r]; s1[r] = (key + 32 > qrow) ? -INFINITY : s1[r]; }
    }
    float ta = fmaxf(fmaxf(s0[0], s0[1]), s1[0]), tb = fmaxf(fmaxf(s0[2], s0[3]), s1[1]); ta = fmaxf(fmaxf(ta, s1[2]), s1[3]);
#pragma unroll
    for (int r = 4; r < 16; r += 4) { ta = fmaxf(fmaxf(ta, s0[r]), s0[r + 1]); tb = fmaxf(fmaxf(tb, s0[r + 2]), s0[r + 3]); ta = fmaxf(fmaxf(ta, s1[r]), s1[r + 1]); tb = fmaxf(fmaxf(tb, s1[r + 2]), s1[r + 3]); }
    float tmax = fmaxf(ta, tb);
    { const auto rr = __builtin_amdgcn_permlane32_swap(__float_as_uint(tmax), __float_as_uint(tmax), false, false); tmax = fmaxf(__uint_as_float(rr[0]), __uint_as_float(rr[1])); }
    if (__all(tmax <= m - 40.0f * ATT_S8)) return;
    const unsigned va_ = (unsigned)(unsigned long)(sb + vfo);
    v4i16_t tv[2][4][2];
#define ATT_TR(dst, off) asm volatile("ds_read_b64_tr_b16 %0, %1 offset:%2" : "=v"(dst) : "v"(va_), "i"(off) : "memory")
    ATT_TR(tv[0][0][0], 0 * 4096 + 0 * 1024);    ATT_TR(tv[0][0][1], 0 * 4096 + 0 * 1024 + 512);
    ATT_TR(tv[0][1][0], 0 * 4096 + 1 * 1024);    ATT_TR(tv[0][1][1], 0 * 4096 + 1 * 1024 + 512);
    ATT_TR(tv[0][2][0], 0 * 4096 + 2 * 1024);    ATT_TR(tv[0][2][1], 0 * 4096 + 2 * 1024 + 512);
    ATT_TR(tv[0][3][0], 0 * 4096 + 3 * 1024);    ATT_TR(tv[0][3][1], 0 * 4096 + 3 * 1024 + 512);
    ATT_TR(tv[1][0][0], 1 * 4096 + 0 * 1024);    ATT_TR(tv[1][0][1], 1 * 4096 + 0 * 1024 + 512);
    ATT_TR(tv[1][1][0], 1 * 4096 + 1 * 1024);    ATT_TR(tv[1][1][1], 1 * 4096 + 1 * 1024 + 512);
    ATT_TR(tv[1][2][0], 1 * 4096 + 2 * 1024);    ATT_TR(tv[1][2][1], 1 * 4096 + 2 * 1024 + 512);
    ATT_TR(tv[1][3][0], 1 * 4096 + 3 * 1024);    ATT_TR(tv[1][3][1], 1 * 4096 + 3 * 1024 + 512);
#undef ATT_TR
    if (__any(tmax > m + 2.0f * ATT_S8)) {
        const float mn = fmaxf(m, tmax), alpha = __builtin_amdgcn_exp2f((m - mn) * (1.0f / ATT_S8)); m = mn; l *= alpha;
#pragma unroll
        for (int r = 0; r < 16; ++r) { O0[r] *= alpha; O1[r] *= alpha; }
    }
    const float nm = -m * (1.0f / ATT_S8);
    float ps = 0.f;
#pragma unroll
    for (int r = 0; r < 16; ++r) { s0[r] = __builtin_amdgcn_exp2f(fmaf(s0[r], 1.0f / ATT_S8, nm)); s1[r] = __builtin_amdgcn_exp2f(fmaf(s1[r], 1.0f / ATT_S8, nm)); ps += s0[r] + s1[r]; }
    l += ps;
    bf16x8 pf[2][2];
#pragma unroll
    for (int sp = 0; sp < 2; ++sp) { u32x4 a, b;
        a.x = cvt_pk_bf16(s0[8 * sp + 0], s0[8 * sp + 1]); a.y = cvt_pk_bf16(s0[8 * sp + 2], s0[8 * sp + 3]); a.z = cvt_pk_bf16(s0[8 * sp + 4], s0[8 * sp + 5]); a.w = cvt_pk_bf16(s0[8 * sp + 6], s0[8 * sp + 7]);
        b.x = cvt_pk_bf16(s1[8 * sp + 0], s1[8 * sp + 1]); b.y = cvt_pk_bf16(s1[8 * sp + 2], s1[8 * sp + 3]); b.z = cvt_pk_bf16(s1[8 * sp + 4], s1[8 * sp + 5]); b.w = cvt_pk_bf16(s1[8 * sp + 6], s1[8 * sp + 7]);
        pf[0][sp] = __builtin_bit_cast(bf16x8, a); pf[1][sp] = __builtin_bit_cast(bf16x8, b); }
    __builtin_amdgcn_sched_barrier(0);
    asm volatile("s_waitcnt lgkmcnt(0)" ::: "memory");
    __builtin_amdgcn_sched_barrier(0);
#pragma unroll
    for (int kb = 0; kb < 2; ++kb)
#pragma unroll
        for (int sp = 0; sp < 2; ++sp) { const int ki = 2 * kb + sp;
            const v4i16_t a0 = tv[0][ki][0], a1 = tv[0][ki][1], b0 = tv[1][ki][0], b1 = tv[1][ki][1];
            const bf16x8 va = (bf16x8){a0[0], a0[1], a0[2], a0[3], a1[0], a1[1], a1[2], a1[3]}, vb = (bf16x8){b0[0], b0[1], b0[2], b0[3], b1[0], b1[1], b1[2], b1[3]};
            O0 = __builtin_amdgcn_mfma_f32_32x32x16_bf16(va, pf[kb][sp], O0, 0, 0, 0); O1 = __builtin_amdgcn_mfma_f32_32x32x16_bf16(vb, pf[kb][sp], O1, 0, 0, 0); }
    __builtin_amdgcn_sched_barrier(0);
}
__device__ __forceinline__ void attn_unit_fox2(const unsigned char* Q8, const unsigned char* K8, const bf16_t* Vp, bf16_t* Op, int qA, int qB, LAS unsigned char* lds) {
    int tid = threadIdx.x; asm volatile("" : "+v"(tid));
    const int lane = tid & 63, wave = __builtin_amdgcn_readfirstlane(tid >> 6), ql = lane & 31, h2 = lane >> 5;
    const LAS float* ncl = (const LAS float*)(lds + ATT_C_OFF);
    const int q0A = 256 * qA, q0B = 256 * qB, nkt = 4 * qA + 4, nktB = 4 * qB + 4;
    const int qrowA = q0A + 32 * wave + ql, qrowB = q0B + 32 * wave + ql;
    const int kkey = 16 * (wave & 3) + (lane >> 2);
    const unsigned char* ksrc = K8 + (size_t)kkey * 768 + 16 * ((lane & 3) ^ ((kkey >> 2) & 3));
    const bf16_t* vsrc = Vp + (size_t)(16 * (wave & 3) + (lane >> 2)) * 768 + 32 * (wave >> 2) + 8 * (lane & 3);
    const bool kwave = wave < 4;
#define ATT_DMA(t, slot) do { if (kwave) __builtin_amdgcn_global_load_lds((const unsigned*)(ksrc + (size_t)(t) * 64 * 768), (LAS unsigned*)(lds + (slot) * ATT_SLOT + wave * 1024), 16, 0, 0); \
                              __builtin_amdgcn_global_load_lds((const unsigned*)(vsrc + (size_t)(t) * 64 * 768), (LAS unsigned*)(lds + (slot) * ATT_SLOT + 8192 + wave * 1024), 16, 0, 0); } while (0)
    i32x8a qfA, qfB;
    { const i32x4a a0 = *(const i32x4a*)(Q8 + (size_t)qrowA * 768 + 32 * h2), a1 = *(const i32x4a*)(Q8 + (size_t)qrowA * 768 + 32 * h2 + 16);
      const i32x4a b0 = *(const i32x4a*)(Q8 + (size_t)qrowB * 768 + 32 * h2), b1 = *(const i32x4a*)(Q8 + (size_t)qrowB * 768 + 32 * h2 + 16);
      qfA = __builtin_shufflevector(a0, a1, 0, 1, 2, 3, 4, 5, 6, 7); qfB = __builtin_shufflevector(b0, b1, 0, 1, 2, 3, 4, 5, 6, 7);
      float nA = sumsq_fp8x16(a0) + sumsq_fp8x16(a1), nB = sumsq_fp8x16(b0) + sumsq_fp8x16(b1);
      { const auto rr = __builtin_amdgcn_permlane32_swap(__float_as_uint(nA), __float_as_uint(nA), false, false); nA = __uint_as_float(rr[0]) + __uint_as_float(rr[1]); }
      { const auto rr = __builtin_amdgcn_permlane32_swap(__float_as_uint(nB), __float_as_uint(nB), false, false); nB = __uint_as_float(rr[0]) + __uint_as_float(rr[1]); }
      const float qn = wave_max(fmaxf(nA, nB)); if (lane == 0) ((LAS float*)(lds + ATT_W_OFF))[16 + wave] = qn; }
    asm volatile("s_waitcnt lgkmcnt(0)" ::: "memory"); __builtin_amdgcn_s_barrier(); asm volatile("" ::: "memory");
    int kA, kB;
    {   const LAS float* wt = (const LAS float*)(lds + ATT_W_OFF); float k2 = wt[8], q2 = wt[16];
#pragma unroll
        for (int w = 1; w < 8; ++w) { k2 = fmaxf(k2, wt[8 + w]); q2 = fmaxf(q2, wt[16 + w]); }
        const float bnd = 2.02f * sqrtf(k2 * q2);
        const float thrA = ncl[q0A] - bnd - 40.0f * ATT_S8, thrB = ncl[q0B] - bnd - 40.0f * ATT_S8;
        const bool cA = (lane < 4 * qA) && (ncl[64 * (lane & 31) + 63] <= thrA), cB = (lane < 4 * qB) && (ncl[64 * (lane & 31) + 63] <= thrB);
        kA = __builtin_amdgcn_readfirstlane((int)__builtin_ctzll(~__ballot(cA))); kB = __builtin_amdgcn_readfirstlane((int)__builtin_ctzll(~__ballot(cB))); }
    const int kstart = kB & ~1;
    ATT_DMA(nkt - 2, 0);
    ATT_DMA(nkt - 1, 1);
    f32x16 OA0, OA1, OB0, OB1;
#pragma unroll
    for (int r = 0; r < 16; ++r) { OA0[r] = 0.f; OA1[r] = 0.f; OB0[r] = 0.f; OB1[r] = 0.f; }
    float mA = -1e30f, lA = 0.f, mB = -1e30f, lB = 0.f;
    const int vfo = 8192 + (4 * h2 + ((lane & 15) >> 2)) * 64 + ((lane >> 4) & 1) * 32 + (lane & 3) * 8;
    const int lastA = (q0A + 32 * wave + 31) >> 6, lastB = (q0B + 32 * wave + 31) >> 6;
    int pair = 0;
    const int kgap = ((kA & ~1) > nktB) ? (kA & ~1) : nktB;
    for (int kt0 = nkt - 2; kt0 >= kstart; ) {
        const int knext = (kt0 == kgap) ? nktB - 2 : kt0 - 2;
        asm volatile("s_waitcnt vmcnt(0)" ::: "memory");
        __builtin_amdgcn_s_barrier();
        asm volatile("" ::: "memory");
        if (knext >= kstart) { ATT_DMA(knext, 2 * (pair ^ 1)); ATT_DMA(knext + 1, 2 * (pair ^ 1) + 1); }
#pragma unroll 1
        for (int sub = 1; sub >= 0; --sub) { const int kt = kt0 + sub; const LAS unsigned char* sb = lds + (2 * pair + sub) * ATT_SLOT;
            if (kt <= lastA && kt >= kA) { f32x16 s0, s1;
#pragma unroll
                for (int g = 0; g < 4; ++g) { const f32x4 c0 = *(const LAS f32x4*)(ncl + kt * 64 + 8 * g + 4 * h2), c1 = *(const LAS f32x4*)(ncl + kt * 64 + 32 + 8 * g + 4 * h2);
#pragma unroll
                    for (int j = 0; j < 4; ++j) { s0[4 * g + j] = c0[j]; s1[4 * g + j] = c1[j]; } }
                att_tile8(sb, s0, s1, qfA, OA0, OA1, mA, lA, kt, qrowA, kt * 64 + 63 > q0A + 32 * wave, h2, ql, vfo); }
            if (kt < nktB && kt <= lastB && kt >= kB) { f32x16 s0, s1;
#pragma unroll
                for (int g = 0; g < 4; ++g) { const f32x4 c0 = *(const LAS f32x4*)(ncl + kt * 64 + 8 * g + 4 * h2), c1 = *(const LAS f32x4*)(ncl + kt * 64 + 32 + 8 * g + 4 * h2);
#pragma unroll
                    for (int j = 0; j < 4; ++j) { s0[4 * g + j] = c0[j]; s1[4 * g + j] = c1[j]; } }
                att_tile8(sb, s0, s1, qfB, OB0, OB1, mB, lB, kt, qrowB, kt * 64 + 63 > q0B + 32 * wave, h2, ql, vfo); }
        }
        pair ^= 1; kt0 = knext;
    }
#undef ATT_DMA
    att_store_o(Op + (size_t)qrowA * 1024 + 4 * h2, OA0, OA1, lA);
    att_store_o(Op + (size_t)qrowB * 1024 + 4 * h2, OB0, OB1, lB);
    asm volatile("s_waitcnt lgkmcnt(0)" ::: "memory"); __builtin_amdgcn_s_barrier(); asm volatile("" ::: "memory");
}
__device__ __forceinline__ void memattn_mfma(const bf16_t* proj, const bf16_t* kvmem, int koff, bf16_t* cat, LAS unsigned char* lds) {
    const int tid = threadIdx.x, lane = tid & 63, wave = __builtin_amdgcn_readfirstlane(tid >> 6), ql = lane & 31, h2 = lane >> 5;
    const int kfo = h2 * 1024 + ql * 16, vfo = 8192 + (4 * h2 + ((lane & 15) >> 2)) * 64 + ((lane >> 4) & 1) * 32 + (lane & 3) * 8;
    for (int u = blockIdx.x; u < NB * 4 * 2; u += gridDim.x) {
        const int half = u & 1, h = (u >> 1) & 3, b = u >> 3;
        const bf16_t* Kp = kvmem + (size_t)b * MEMT * 1024 + koff + 64 * h; const bf16_t* Vp = Kp + 256;
        const bf16_t* ksrc = Kp + (size_t)lane * 1024 + 8 * wave;
        const bf16_t* vsrc = Vp + (size_t)(16 * (wave & 3) + (lane >> 2)) * 1024 + 32 * (wave >> 2) + 8 * (lane & 3);
        __syncthreads();
#pragma unroll
        for (int t = 0; t < 4; ++t) { __builtin_amdgcn_global_load_lds((const unsigned*)(ksrc + (size_t)t * 64 * 1024), (LAS unsigned*)(lds + t * ATT_SLOT + wave * 1024), 16, 0, 0);
                                       __builtin_amdgcn_global_load_lds((const unsigned*)(vsrc + (size_t)t * 64 * 1024), (LAS unsigned*)(lds + t * ATT_SLOT + 8192 + wave * 1024), 16, 0, 0); }
        const bf16_t* Qb = proj + (size_t)b * S * 1024 + 768 + 64 * h; bf16_t* Ob = cat + (size_t)b * S * 1024 + 768 + 64 * h;
        bf16x8 qf[4];
        att_load_q(qf, Qb + (size_t)(half * 1024 + 32 * wave + ql) * 1024, h2);
        asm volatile("s_waitcnt vmcnt(0)" ::: "memory");
        __builtin_amdgcn_s_barrier();
        asm volatile("" ::: "memory");
        for (int qb = 0; qb < 4; ++qb) {
            const int qrow = half * 1024 + qb * 256 + 32 * wave + ql;
            f32x16 O0, O1;
#pragma unroll
            for (int r = 0; r < 16; ++r) { O0[r] = 0.f; O1[r] = 0.f; }
            float m = -1e30f, l = 0.f;
            bf16x8 qn[4];
            if (qb + 1 < 4) att_load_q(qn, Qb + (size_t)(qrow + 256) * 1024, h2);
#pragma unroll 1
            for (int kt = 0; kt < 4; ++kt) { f32x16 s0, s1;
#pragma unroll
                for (int r = 0; r < 16; ++r) { s0[r] = 0.f; s1[r] = 0.f; }
                att_tile<false>(lds + kt * ATT_SLOT, s0, s1, qf, O0, O1, m, l, kt, qrow, false, h2, kfo, vfo); }
            att_store_o(Ob + (size_t)qrow * 1024 + 4 * h2, O0, O1, l);
            if (qb + 1 < 4) {
#pragma unroll
                for (int ks = 0; ks < 4; ++ks) qf[ks] = qn[ks]; }
        }
    }
}
__device__ __forceinline__ void fox_mfma(const unsigned char* Q8, const unsigned char* K8, const bf16_t* Vf, const float* glog, bf16_t* cat, LAS unsigned char* lds, const float* fgb) {
    const int tid = threadIdx.x, lane = tid & 63, wave = tid >> 6;
    LAS float* cl = (LAS float*)(lds + ATT_C_OFF); LAS float* wtot = (LAS float*)(lds + ATT_W_OFF);
    const int G = gridDim.x, vcu = (G % 8 == 0) ? ((int)(blockIdx.x % 8) * (G / 8) + (int)(blockIdx.x / 8)) : (int)blockIdx.x;
    const int npair = NB * 12 * 4, npp = (npair + G - 1) / G; int last_bh = -1;
    int rk[12];
    {   float fb[12];
#pragma unroll
        for (int x = 0; x < 12; ++x) fb[x] = fgb[x];
#pragma unroll
        for (int x = 0; x < 12; ++x) { int c = 0;
#pragma unroll
            for (int y = 0; y < 12; ++y) c += (fb[y] < fb[x] || (fb[y] == fb[x] && y < x)) ? 1 : 0;
            rk[x] = c; } }
    for (int ip = 0; ip < npp; ++ip) {
        int p = vcu * npp + ip;
        if (G == 256) { const int r = vcu & 7, hi = ip >> 1, jj = ip & 1;
            const int g4 = r >> 1, want = 4 * hi + ((hi & 1) ? 3 - g4 : g4); int hsel = 0;
#pragma unroll
            for (int x = 0; x < 12; ++x) hsel = (rk[x] == want) ? x : hsel;
            p = (((vcu >> 3) * 12 + hsel) << 2) | ((r & 1) ? 1 + jj : 3 * jj); }
        if (p >= npair) break;
        const int bh = p >> 2, j = p & 3, b = bh / 12, h = bh % 12;
        if (bh != last_bh) {
            last_bh = bh;
            float v[4];
#pragma unroll
            for (int k = 0; k < 4; ++k) v[k] = glog[((size_t)b * S + 4 * tid + k) * 16 + h];
            v[1] += v[0]; v[2] += v[1]; v[3] += v[2];
            float inc = v[3];
#pragma unroll
            for (int off = 1; off < 64; off <<= 1) { const float n = __shfl_up(inc, off); if (lane >= off) inc += n; }
            {
                const unsigned char* kp = K8 + ((size_t)b * S + 4 * tid) * 768 + 64 * h; float kn = 0.f;
#pragma unroll
                for (int k = 0; k < 4; ++k) { float n2 = 0.f;
#pragma unroll
                    for (int c4 = 0; c4 < 4; ++c4) n2 += sumsq_fp8x16(*(const i32x4n*)(kp + (size_t)k * 768 + 16 * c4));
                    kn = fmaxf(kn, n2); }
                kn = wave_max(kn); if (lane == 63) wtot[8 + wave] = kn; }
            if (lane == 63) wtot[wave] = inc;
            __syncthreads();
            float base = inc - v[3];
            for (int w = 0; w < wave; ++w) base += wtot[w];
#pragma unroll
            for (int k = 0; k < 4; ++k) cl[4 * tid + k] = -(base + v[k]) * (ATT_L2E * ATT_S8);
            __syncthreads();
        }
        attn_unit_fox2(Q8 + (size_t)b * S * 768 + 64 * h, K8 + (size_t)b * S * 768 + 64 * h, Vf + (size_t)b * S * 768 + 64 * h,
                       cat + (size_t)b * S * 1024 + 64 * h, 7 - j, j, lds);
    }
}

constexpr float Y8_SCALE = 32.0f;
__device__ __forceinline__ void add_fp8x16(float (&v)[16], const u32x4 w, float sc) {
    const unsigned ww[4] = {w.x, w.y, w.z, w.w};
#pragma unroll
    for (int q = 0; q < 4; ++q) { const f32x2 lo = __builtin_amdgcn_cvt_pk_f32_fp8((int)ww[q], false), hi = __builtin_amdgcn_cvt_pk_f32_fp8((int)ww[q], true);
        v[4 * q + 0] += sc * lo[0]; v[4 * q + 1] += sc * lo[1]; v[4 * q + 2] += sc * hi[0]; v[4 * q + 3] += sc * hi[1]; }
}
__device__ __forceinline__ void unpack_bf16x8(float* v, const u32x4 x, float sc) {
    v[0] = sc * bf_lo(x.x); v[1] = sc * bf_hi(x.x); v[2] = sc * bf_lo(x.y); v[3] = sc * bf_hi(x.y); v[4] = sc * bf_lo(x.z); v[5] = sc * bf_hi(x.z); v[6] = sc * bf_lo(x.w); v[7] = sc * bf_hi(x.w);
}
template <bool HP32, bool COMBINE, bool GATES>
__device__ __forceinline__ void ln_phase(const void* hprev, const void* add, const int* tok_slot, const float* gam, const float* bet, bf16_t* hout, float* fout,
                                         const float* gwt, const float* fgate_b, float* glog, LAS unsigned char* lds, unsigned char* qout = nullptr) {
    static_assert(!(HP32 && (COMBINE || GATES)), "the f32-input form is the plain LN1 of layer 0");
    constexpr int NCH = HP32 ? 4 : 2, CW = 16 / NCH, CS = 1024 / NCH;
    const int tid = threadIdx.x, lane = tid & 63, wave = tid >> 6;
    const int gw = blockIdx.x * NWAVES + wave, NGW = gridDim.x * NWAVES;
    LAS float* gl = (LAS float*)lds;
    if (GATES) { for (int i = tid; i < 12 * 1024; i += NTHR) gl[i] = gwt[i]; __syncthreads(); }
    float g[16], bb[16];
#pragma unroll
    for (int ch = 0; ch < NCH; ++ch)
#pragma unroll
        for (int q = 0; q < CW / 4; ++q) { const f32x4 gv = *(const f32x4*)(gam + CS * ch + CW * lane + 4 * q), bv = *(const f32x4*)(bet + CS * ch + CW * lane + 4 * q);
#pragma unroll
            for (int j = 0; j < 4; ++j) { g[ch * CW + q * 4 + j] = gv[j]; bb[ch * CW + q * 4 + j] = bv[j]; } }
    for (int rp = gw; rp < T / 2; rp += NGW) {
        const int row0 = 2 * rp;
        float v[2][16];
        f32x4 xf[2][4]; u32x4 xh[2][2], am[2][2]; u32x2 am2[2][4], ay[2][4][2];
        int myslot = 0;
        if (COMBINE) myslot = tok_slot[(size_t)row0 * 4 + (lane & 7)];
#pragma unroll
        for (int r = 0; r < 2; ++r) {
            if (HP32) { const float* hp = (const float*)hprev + (size_t)(row0 + r) * 1024 + 4 * lane; const bf16_t* ap = (const bf16_t*)add + (size_t)(row0 + r) * 1024 + 4 * lane;
#pragma unroll
                for (int ch = 0; ch < 4; ++ch) { xf[r][ch] = *(const f32x4*)(hp + 256 * ch); am2[r][ch] = *(const u32x2*)(ap + 256 * ch); }
            } else { const bf16_t* hp = (const bf16_t*)hprev + (size_t)(row0 + r) * 1024 + 8 * lane; xh[r][0] = *(const u32x4*)hp; xh[r][1] = *(const u32x4*)(hp + 512);
                if (!COMBINE) { const bf16_t* ap = (const bf16_t*)add + (size_t)(row0 + r) * 1024 + 8 * lane; am[r][0] = *(const u32x4*)ap; am[r][1] = *(const u32x4*)(ap + 512); } }
        }
        if (COMBINE) {
#pragma unroll
            for (int r = 0; r < 2; ++r)
#pragma unroll
                for (int k = 0; k < 4; ++k) { const int sl = __builtin_amdgcn_readlane(myslot, 4 * r + k); const unsigned char* yp = (const unsigned char*)add + (size_t)sl * 1024 + 8 * lane;
                    ay[r][k][0] = *(const u32x2*)yp; ay[r][k][1] = *(const u32x2*)(yp + 512); }
        }
#pragma unroll
        for (int r = 0; r < 2; ++r) {
            if (HP32) {
#pragma unroll
                for (int ch = 0; ch < 4; ++ch) { const u32x2 mw = am2[r][ch];
                    v[r][4 * ch + 0] = DN_ALPHA * xf[r][ch][0] + bf_lo(mw.x); v[r][4 * ch + 1] = DN_ALPHA * xf[r][ch][1] + bf_hi(mw.x);
                    v[r][4 * ch + 2] = DN_ALPHA * xf[r][ch][2] + bf_lo(mw.y); v[r][4 * ch + 3] = DN_ALPHA * xf[r][ch][3] + bf_hi(mw.y); }
            } else {
                unpack_bf16x8(&v[r][0], xh[r][0], DN_ALPHA); unpack_bf16x8(&v[r][8], xh[r][1], DN_ALPHA);
                if (COMBINE) {
                    float acc[16];
#pragma unroll
                    for (int i = 0; i < 16; ++i) acc[i] = 0.f;
#pragma unroll
                    for (int k = 0; k < 4; ++k)
#pragma unroll
                        for (int ch = 0; ch < 2; ++ch) { const unsigned ww[2] = {ay[r][k][ch].x, ay[r][k][ch].y};
#pragma unroll
                            for (int q = 0; q < 2; ++q) { const f32x2 lo = __builtin_amdgcn_cvt_pk_f32_fp8((int)ww[q], false), hi = __builtin_amdgcn_cvt_pk_f32_fp8((int)ww[q], true);
                                acc[8 * ch + 4 * q + 0] += lo[0]; acc[8 * ch + 4 * q + 1] += lo[1]; acc[8 * ch + 4 * q + 2] += hi[0]; acc[8 * ch + 4 * q + 3] += hi[1]; } }
#pragma unroll
                    for (int i = 0; i < 16; ++i) v[r][i] += acc[i] * (1.0f / Y8_SCALE);
                } else { float t[16]; unpack_bf16x8(&t[0], am[r][0], 1.0f); unpack_bf16x8(&t[8], am[r][1], 1.0f);
#pragma unroll
                    for (int i = 0; i < 16; ++i) v[r][i] += t[i]; }
            }
        }
        float s[2] = {0.f, 0.f};
#pragma unroll
        for (int r = 0; r < 2; ++r)
#pragma unroll
            for (int i = 0; i < 16; ++i) s[r] += v[r][i];
        float mean[2], s2[2] = {0.f, 0.f};
#pragma unroll
        for (int r = 0; r < 2; ++r) { mean[r] = wave_sum(s[r]) * (1.0f / 1024.0f);
#pragma unroll
            for (int i = 0; i < 16; ++i) { v[r][i] -= mean[r]; s2[r] += v[r][i] * v[r][i]; } }
#pragma unroll
        for (int r = 0; r < 2; ++r) { const float rstd = 1.0f / sqrtf(wave_sum(s2[r]) * (1.0f / 1024.0f) + LN_EPS);
#pragma unroll
            for (int i = 0; i < 16; ++i) v[r][i] = v[r][i] * rstd * g[i] + bb[i]; }
#pragma unroll
        for (int r = 0; r < 2; ++r) {
            if (hout) { bf16_t* op = hout + (size_t)(row0 + r) * 1024 + CW * lane;
                if (HP32) {
#pragma unroll
                    for (int ch = 0; ch < 4; ++ch) { u32x2 w; w.x = cvt_pk_bf16(v[r][4 * ch + 0], v[r][4 * ch + 1]); w.y = cvt_pk_bf16(v[r][4 * ch + 2], v[r][4 * ch + 3]); *(u32x2*)(op + 256 * ch) = w; }
                } else {
#pragma unroll
                    for (int ch = 0; ch < 2; ++ch) { u32x4 w; w.x = cvt_pk_bf16(v[r][ch * 8 + 0], v[r][ch * 8 + 1]); w.y = cvt_pk_bf16(v[r][ch * 8 + 2], v[r][ch * 8 + 3]);
                        w.z = cvt_pk_bf16(v[r][ch * 8 + 4], v[r][ch * 8 + 5]); w.w = cvt_pk_bf16(v[r][ch * 8 + 6], v[r][ch * 8 + 7]); *(u32x4*)(op + 512 * ch) = w; } } }
            if (qout) { unsigned char* qp = qout + (size_t)(row0 + r) * 1024 + CW * lane;
                if (HP32) {
#pragma unroll
                    for (int ch = 0; ch < 4; ++ch) *(unsigned*)(qp + 256 * ch) = pg8::pk_fp8x4(v[r][4 * ch + 0], v[r][4 * ch + 1], v[r][4 * ch + 2], v[r][4 * ch + 3]);
                } else {
#pragma unroll
                    for (int ch = 0; ch < 2; ++ch) { u32x2 w; w.x = pg8::pk_fp8x4(v[r][8 * ch + 0], v[r][8 * ch + 1], v[r][8 * ch + 2], v[r][8 * ch + 3]);
                        w.y = pg8::pk_fp8x4(v[r][8 * ch + 4], v[r][8 * ch + 5], v[r][8 * ch + 6], v[r][8 * ch + 7]); *(u32x2*)(qp + 512 * ch) = w; } } }
            if (!HP32 && fout) { float* op = fout + (size_t)(row0 + r) * 1024 + 8 * lane;
#pragma unroll
                for (int ch = 0; ch < 2; ++ch)
#pragma unroll
                    for (int q = 0; q < 2; ++q) *(f32x4*)(op + 512 * ch + 4 * q) = (f32x4){v[r][ch * 8 + q * 4 + 0], v[r][ch * 8 + q * 4 + 1], v[r][ch * 8 + q * 4 + 2], v[r][ch * 8 + q * 4 + 3]}; }
        }
        if (GATES) {
            f32x2 P[12];
#pragma unroll
            for (int j = 0; j < 12; ++j) { f32x2 p = {0.f, 0.f};
#pragma unroll
                for (int ch = 0; ch < 2; ++ch)
#pragma unroll
                    for (int q = 0; q < 2; ++q) { const f32x4 w = *(const LAS f32x4*)(gl + j * 1024 + 512 * ch + 8 * lane + 4 * q);
#pragma unroll
                        for (int e = 0; e < 4; ++e) p += (f32x2){v[0][ch * 8 + q * 4 + e], v[1][ch * 8 + q * 4 + e]} * w[e]; }
                P[j] = p; }
            float Q[12];
#pragma unroll
            for (int j = 0; j < 12; ++j) { const auto rr = __builtin_amdgcn_permlane32_swap(__float_as_uint(P[j][0]), __float_as_uint(P[j][1]), false, false); Q[j] = __uint_as_float(rr[0]) + __uint_as_float(rr[1]); }
            float R[6];
#pragma unroll
            for (int j = 0; j < 6; ++j) { const auto rr = __builtin_amdgcn_permlane16_swap(__float_as_uint(Q[j]), __float_as_uint(Q[j + 6]), false, false); R[j] = __uint_as_float(rr[0]) + __uint_as_float(rr[1]); }
#define LN_DPP(x, ctrl) __int_as_float(__builtin_amdgcn_update_dpp(0, __float_as_int(x), (ctrl), 0xf, 0xf, false))
#pragma unroll
            for (int j = 0; j < 6; ++j) { float t = R[j]; t += LN_DPP(t, 0x128); t += LN_DPP(t, 0x124); t += LN_DPP(t, 0x122); t += LN_DPP(t, 0x121); R[j] = t; }
#undef LN_DPP
            const int l16 = lane & 15, jj = l16 + 6 * ((lane >> 4) & 1), rr_ = lane >> 5;
            float mine = R[0];
#pragma unroll
            for (int j = 1; j < 6; ++j) mine = (l16 == j) ? R[j] : mine;
            if (l16 < 6) { const float z = mine + fgate_b[jj]; const float ls = fminf(z, 0.f) - log1pf(expf(-fabsf(z))); glog[(size_t)(row0 + rr_) * 16 + jj] = ls; }
        }
    }
}

__device__ __forceinline__ void top4_phase(const float* logits, const float* rb, int* tok_e, float* tok_g, int* tok_r, unsigned* wg_hist, LAS unsigned char* lds) {
    const int tid = threadIdx.x;
    LAS unsigned* hist = (LAS unsigned*)lds;
    for (int ch = blockIdx.x; ch < NCHUNK; ch += gridDim.x) {
        __syncthreads();
        if (tid < 32) hist[tid] = 0u;
        __syncthreads();
        if (tid < 256) {
            const int t = ch * 256 + tid; const float* lp = logits + (size_t)t * 32;
            float lg[32];
#pragma unroll
            for (int q = 0; q < 8; ++q) { const f32x4 hv = *(const f32x4*)(lp + 4 * q) + *(const f32x4*)(lp + (size_t)T * 32 + 4 * q), bv = *(const f32x4*)(rb + 4 * q);
#pragma unroll
                for (int j = 0; j < 4; ++j) lg[4 * q + j] = hv[j] + bv[j]; }
            unsigned used = 0u; int sel[4]; float val[4];
#pragma unroll
            for (int k = 0; k < 4; ++k) { float best = -INFINITY; int bi = 0;
#pragma unroll
                for (int e = 0; e < 32; ++e) { const float c = ((used >> e) & 1u) ? -INFINITY : lg[e]; if (c > best) { best = c; bi = e; } }
                sel[k] = bi; val[k] = best; used |= 1u << bi; }
            const float e1 = __expf(val[1] - val[0]), e2 = __expf(val[2] - val[0]), e3 = __expf(val[3] - val[0]); const float inv = 1.0f / (1.0f + e1 + e2 + e3);
            const float gt[4] = {inv, e1 * inv, e2 * inv, e3 * inv};
            int rk[4];
#pragma unroll
            for (int k = 0; k < 4; ++k) rk[k] = (int)atomicAdd((unsigned*)(hist + sel[k]), 1u);
            *(int4*)(tok_e + (size_t)t * 4) = make_int4(sel[0], sel[1], sel[2], sel[3]);
            *(f32x4*)(tok_g + (size_t)t * 4) = (f32x4){gt[0], gt[1], gt[2], gt[3]};
            *(int4*)(tok_r + (size_t)t * 4) = make_int4(rk[0], rk[1], rk[2], rk[3]);
        }
        __syncthreads();
        if (tid < 32) wg_hist[ch * 32 + tid] = hist[tid];
    }
}

__device__ __forceinline__ void assign_phase(const unsigned* wg_hist, const int* tok_e, const float* tok_g, const int* tok_r, int* tok_s, float* slot_g, int* slot_t,
                                             int* tiletab, LAS unsigned char* lds) {
    const int tid = threadIdx.x, lane = tid & 63, wave = tid >> 6;
    LAS unsigned* rtot = (LAS unsigned*)lds;
    LAS unsigned* rpre = rtot + 512;
    LAS unsigned* cnt = rpre + 512;
    LAS unsigned* pstart = cnt + 32;
    LAS unsigned* base = pstart + 40;
    LAS int* sl = (LAS int*)(base + 32);
    for (int ch = blockIdx.x; ch < NCHUNK; ch += gridDim.x) {
        __syncthreads();
        { const int e = tid & 31, part = tid >> 5; unsigned tot = 0u, pre = 0u;
          for (int c = part * 16; c < part * 16 + 16; ++c) { const unsigned hv = wg_hist[c * 32 + e]; tot += hv; if (c < ch) pre += hv; }
          rtot[part * 32 + e] = tot; rpre[part * 32 + e] = pre; }
        __syncthreads();
        if (tid < 32) { unsigned tot = 0u, pre = 0u;
            for (int p = 0; p < 16; ++p) { tot += rtot[p * 32 + tid]; pre += rpre[p * 32 + tid]; }
            cnt[tid] = tot; base[tid] = pre; }
        __syncthreads();
        if (tid == 0) { unsigned acc = 0u; for (int e = 0; e < 32; ++e) { pstart[e] = acc; acc += (cnt[e] + 255u) & ~255u; } pstart[32] = acc; }
        __syncthreads();
        if (tid < 256) { const int t = ch * 256 + tid;
            const int4 e4 = *(const int4*)(tok_e + (size_t)t * 4), r4 = *(const int4*)(tok_r + (size_t)t * 4); const f32x4 g4 = *(const f32x4*)(tok_g + (size_t)t * 4);
            const int es[4] = {e4.x, e4.y, e4.z, e4.w}, rs[4] = {r4.x, r4.y, r4.z, r4.w}; int so[4];
#pragma unroll
            for (int k = 0; k < 4; ++k) { so[k] = (int)(pstart[es[k]] + base[es[k]]) + rs[k]; slot_g[so[k]] = g4[k]; slot_t[so[k]] = t; }
            *(int4*)(tok_s + (size_t)t * 4) = make_int4(so[0], so[1], so[2], so[3]); }
        __syncthreads();
        if (ch == (int)blockIdx.x) {
            for (int e = blockIdx.x; e < NE; e += gridDim.x) {
                const int p0 = (int)(pstart[e] + cnt[e]), p1 = (int)pstart[e + 1];
                for (int s = p0 + tid; s < p1; s += NTHR) { slot_g[s] = 0.f; slot_t[s] = 0; }
                for (int tl = (int)(pstart[e] >> 8) + tid; tl < (int)(pstart[e + 1] >> 8); tl += NTHR) tiletab[16 + tl] = e;
            }
            if (blockIdx.x == 0 && tid == 0) tiletab[0] = (int)(pstart[32] >> 8);
        }
    }
}

__global__ void __launch_bounds__(NTHR, 2) fwd_kernel(Args args) {
    extern __shared__ __attribute__((aligned(16))) unsigned char lds_raw[];
    LAS unsigned char* lds = (LAS unsigned char*)lds_raw;
    volatile LAS unsigned* MISC = (volatile LAS unsigned*)(lds + MISC_OFF);
    const int tid = threadIdx.x, lane = tid & 63, wave = __builtin_amdgcn_readfirstlane(tid >> 6);
    const int G = gridDim.x;
    unsigned char* ws = args.ws;
    unsigned* ctl = (unsigned*)(ws + WS_CTL);
    if (tid < 32) MISC[tid] = 0u;
    __syncthreads();
    XcdBarrier bar; bar.bar = ctl + CW_BAR; bar.x = 0; bar.st = nullptr;
#if !MK_PER_PHASE
    bar = xcd_barrier_post(ctl + CW_BAR, MISC + 8);
#endif
    const int lo = args.ph_lo, hi = args.ph_hi;
#ifndef PH_MASK
#define PH_MASK 0xFFFFFFFFu
#endif
#ifndef PH_TWICE
#define PH_TWICE 0u
#endif
#define TW(k) ((((unsigned)PH_TWICE >> (k)) & 1u) != 0u)
#define IN(k) (((PH_MASK >> (k)) & 1u) && lo <= (k) && (k) < hi)
#if MK_PER_PHASE
#define SEAM(k) do { } while (0)
#else
#define SEAM(k) do { if (IN(k) && IN((k) + 1)) xcd_barrier(bar); } while (0)
#endif
    bf16_t* const R1 = (bf16_t*)(ws + WS_R1); bf16_t* const R2 = (bf16_t*)(ws + WS_R2);
    bf16_t* const PROJ = (bf16_t*)(ws + WS_PROJ); bf16_t* const CAT = (bf16_t*)(ws + WS_CAT); bf16_t* const MIX = (bf16_t*)(ws + WS_MIX); bf16_t* const DBUF = (bf16_t*)(ws + WS_DBUF);
    bf16_t* const KF = (bf16_t*)(ws + WS_KF); bf16_t* const VF = (bf16_t*)(ws + WS_VF);
    bf16_t* const ACT = (bf16_t*)(ws + WS_ACT); bf16_t* const YB = (bf16_t*)(ws + WS_Y);
    unsigned char* const MEMB = ws + WS_MEMB; bf16_t* const KVMEM = (bf16_t*)(ws + WS_KVMEM);
    float* const LOGITS = (float*)(ws + WS_LOGITS); float* const GLOG = (float*)(ws + WS_GLOG);
    int* const TOKE = (int*)(ws + WS_TOKE); float* const TOKG = (float*)(ws + WS_TOKG); int* const TOKR = (int*)(ws + WS_TOKR); int* const TOKS = (int*)(ws + WS_TOKS);
    float* const SLOTG = (float*)(ws + WS_SLOTG); int* const SLOTT = (int*)(ws + WS_SLOTT);
    unsigned* const WGH = (unsigned*)(ws + WS_WGHIST); int* const TILETAB = (int*)(ws + WS_TILETAB);

    if (IN(0)) { p0_prologue(args, lds, wave, lane); } if (TW(0) && IN(0)) { p0_prologue(args, lds, wave, lane); }
    SEAM(0);
    if (IN(1)) {
        { pg8::Gemm g{R1, ws + WS_WINA, T, 1024, 2048}; pg8::StaticOrder So; So.init(T, 1024, G, (int)blockIdx.x);
          pg8::EpiBf16 E{PROJ, 1024, nullptr, 0, 0, 1.0f}; pg8::gemm_phase(lds, g, So, E); }
        { pg8::Gemm g{MEMB, ws + WS_WMKV, NB * MEMT, 1024, 1024}; pg8::StaticOrder So; So.init(NB * MEMT, 1024, G, (int)((blockIdx.x + 128) % G));
          pg8::EpiBf16 E{KVMEM, 1024, nullptr, 0, 0, 1.0f / pg8::W8_SCALE}; pg8::gemm_phase<pg8::EpiBf16, pg8::StaticOrder, true>(lds, g, So, E); }
    }
    SEAM(1);
    if (IN(2)) { pool_d_phase(PROJ, CAT); memattn_mfma(PROJ, KVMEM, 0, CAT, lds); } if (TW(2) && IN(2)) { pool_d_phase(PROJ, CAT); memattn_mfma(PROJ, KVMEM, 0, CAT, lds); }
    SEAM(2);
    if (IN(4)) { pg8::Gemm g{CAT, ws + WS_WOUTA, T, 1024, 2048}; pg8::StaticOrder So; So.init(T, 1024, G, (int)blockIdx.x);
        pg8::EpiBf16 E{MIX, 1024, nullptr, 0, 0, 1.0f}; pg8::gemm_phase(lds, g, So, E); }
    SEAM(4);
    if (IN(5)) ln_phase<false, false, false>(R1, MIX, nullptr, args.in[2], args.in[3], R1, nullptr, nullptr, nullptr, nullptr, lds, ws + WS_H1Q); if (TW(5) && IN(5)) ln_phase<false, false, false>(R1, MIX, nullptr, args.in[2], args.in[3], R1, nullptr, nullptr, nullptr, nullptr, lds, ws + WS_H1Q);
    SEAM(5);
#define MOE_BLOCK(P, L, HIN) \
    if (IN(P)) { pg8::Gemm g{HIN, ws + WS_WR + (size_t)(L) * 256 * 2048, T, 256, 2048}; pg8::StaticOrder So; So.init(T, 256, G, (int)blockIdx.x); \
        if (G == 256) { pg8::EpiRouter E{args.in[17] + (L) * 32, TOKE, TOKG, TOKR, WGH}; pg8::gemm_phase(lds, g, So, E); } \
        else { pg8::EpiLogits E{LOGITS}; pg8::gemm_phase(lds, g, So, E); } } \
    if (G != 256) SEAM(P); \
    if (G != 256 && IN((P) + 1)) top4_phase(LOGITS, args.in[17] + (L) * 32, TOKE, TOKG, TOKR, WGH, lds); \
    SEAM((P) + 1); \
    if (IN((P) + 2)) assign_phase(WGH, TOKE, TOKG, TOKR, TOKS, SLOTG, SLOTT, TILETAB, lds); if (TW((P) + 2) && IN((P) + 2)) assign_phase(WGH, TOKE, TOKG, TOKR, TOKS, SLOTG, SLOTT, TILETAB, lds); \
    SEAM((P) + 2); \
    if (IN((P) + 3)) { LAS int* tab = (LAS int*)(lds + TAB_OFF); const int ntl = (int)__hip_atomic_load((unsigned*)TILETAB, RLX_AGENT); \
        for (int i = tid; i < NTILE_MAX; i += NTHR) tab[i] = (i < ntl) ? TILETAB[16 + i] : 0; __syncthreads(); \
        pg8::Gemm g{ws + WS_H1Q, ws + WS_W1 + (size_t)(L) * 32 * 2048 * 1024, NSLOT_MAX, 2048, 1024}; pg8::MoeOrder Mo{ntl, 8, G, (int)blockIdx.x, tab}; \
        pg8::EpiSwiglu E{(unsigned char*)ACT, (const float*)(ws + WS_B1P) + (size_t)(L) * 32 * 2048}; pg8::gemm_phase<pg8::EpiSwiglu, pg8::MoeOrder, true, true>(lds, g, Mo, E, SLOTT); } \
    SEAM((P) + 3); \
    if (IN((P) + 4)) { LAS int* tab = (LAS int*)(lds + TAB_OFF); const int ntl = (int)__hip_atomic_load((unsigned*)TILETAB, RLX_AGENT); \
        for (int i = tid; i < NTILE_MAX; i += NTHR) tab[i] = (i < ntl) ? TILETAB[16 + i] : 0; __syncthreads(); \
        pg8::Gemm g{ACT, ws + WS_W2 + (size_t)(L) * 32 * 1024 * 1024, NSLOT_MAX, 1024, 1024}; pg8::MoeOrder Mo{ntl, 4, G, (int)blockIdx.x, tab}; \
        pg8::EpiMoe2 E{(unsigned char*)YB, args.in[21] + (size_t)(L) * 32 * 1024, SLOTG, Y8_SCALE}; pg8::gemm_phase<pg8::EpiMoe2, pg8::MoeOrder, true>(lds, g, Mo, E); } \
    SEAM((P) + 4);
    MOE_BLOCK(6, 0, R1)
    if (IN(11)) ln_phase<false, true, true>(R1, YB, TOKS, args.in[4], args.in[5], R2, nullptr, (const float*)(ws + WS_GWT), args.in[12], GLOG, lds, ws + WS_H1Q); if (TW(11) && IN(11)) ln_phase<false, true, true>(R1, YB, TOKS, args.in[4], args.in[5], R2, nullptr, (const float*)(ws + WS_GWT), args.in[12], GLOG, lds, ws + WS_H1Q);
    SEAM(11);
    if (IN(12)) {
        { pg8::Gemm g{ws + WS_H1Q, ws + WS_WKV, T, 1536, 1024}; pg8::StaticOrder So; So.init(T, 1536, G, (int)blockIdx.x);
          pg8::EpiMixed8 E{ws + WS_KF, 768, 1.0f / pg8::W8_SCALE, 3, VF, 768, 1, 1.0f / pg8::W8_SCALE}; pg8::gemm_phase<pg8::EpiMixed8, pg8::StaticOrder, true>(lds, g, So, E); }
        { pg8::Gemm g{ws + WS_H1Q, ws + WS_WINB, T, 1024, 1024}; pg8::StaticOrder So; So.init(T, 1024, G, (int)blockIdx.x);
          pg8::EpiMixed8 E{ws + WS_Q8, 768, ATT_C2 * ATT_S8 / pg8::W8_SCALE, 3, PROJ, 1024, 0, 1.0f / pg8::W8_SCALE}; pg8::gemm_phase<pg8::EpiMixed8, pg8::StaticOrder, true>(lds, g, So, E); }
    }
    SEAM(12);
    if (IN(13)) { fox_mfma(ws + WS_Q8, ws + WS_KF, VF, GLOG, CAT, lds, args.in[12]); memattn_mfma(PROJ, KVMEM, 512, CAT, lds); } if (TW(13) && IN(13)) { fox_mfma(ws + WS_Q8, ws + WS_KF, VF, GLOG, CAT, lds, args.in[12]); memattn_mfma(PROJ, KVMEM, 512, CAT, lds); }
    SEAM(13);
    if (IN(14)) { pg8::Gemm g{CAT, ws + WS_WOUTB, T, 1024, 2048}; pg8::StaticOrder So; So.init(T, 1024, G, (int)blockIdx.x);
        pg8::EpiBf16 E{MIX, 1024, nullptr, 0, 0, 1.0f}; pg8::gemm_phase(lds, g, So, E); }
    SEAM(14);
    if (IN(15)) ln_phase<false, false, false>(R2, MIX, nullptr, args.in[2] + 1024, args.in[3] + 1024, R1, nullptr, nullptr, nullptr, nullptr, lds, ws + WS_H1Q); if (TW(15) && IN(15)) ln_phase<false, false, false>(R2, MIX, nullptr, args.in[2] + 1024, args.in[3] + 1024, R1, nullptr, nullptr, nullptr, nullptr, lds, ws + WS_H1Q);
    SEAM(15);
    MOE_BLOCK(16, 1, R1)
    if (IN(21)) ln_phase<false, true, false>(R1, YB, TOKS, args.in[4] + 1024, args.in[5] + 1024, nullptr, args.out, nullptr, nullptr, nullptr, lds); if (TW(21) && IN(21)) ln_phase<false, true, false>(R1, YB, TOKS, args.in[4] + 1024, args.in[5] + 1024, nullptr, args.out, nullptr, nullptr, nullptr, lds);
#undef IN
#undef SEAM
}

extern "C" void kernel_launch(void* const* d_in, const int* in_sizes, int n_in, void* d_out, int out_size, void* d_ws, size_t ws_size, hipStream_t stream) {
    static int grid = 0;
    if (grid == 0) {
        if (n_in != 22 || out_size != T * D || ws_size < WS_END) { fprintf(stderr, "kernel_launch: unexpected problem (n_in %d out %d ws %zu)\n", n_in, out_size, ws_size); grid = -1; return; }
        int dev = 0, cus = 0;
        if (hipGetDevice(&dev) != hipSuccess || hipDeviceGetAttribute(&cus, hipDeviceAttributeMultiprocessorCount, dev) != hipSuccess) { grid = -1; return; }
        if (hipFuncSetAttribute((const void*)fwd_kernel, hipFuncAttributeMaxDynamicSharedMemorySize, LDS_BYTES) != hipSuccess) { fprintf(stderr, "kernel_launch: hipFuncSetAttribute failed\n"); grid = -1; return; }
        int per_cu = 0;
        if (hipOccupancyMaxActiveBlocksPerMultiprocessor(&per_cu, (const void*)fwd_kernel, NTHR, LDS_BYTES) != hipSuccess || per_cu < 1) fprintf(stderr, "kernel_launch: occupancy query says %d\n", per_cu);
        (void)hipGetLastError();
        grid = cus;
    }
    if (grid < 0) return;
    if (hipMemsetAsync((char*)d_ws + WS_CTL, 0, CTL_ZERO_BYTES, stream) != hipSuccess) return;
    Args a{};
    for (int i = 0; i < 22; ++i) a.in[i] = (const float*)d_in[i];
    a.out = (float*)d_out; a.ws = (unsigned char*)d_ws;
#if MK_PER_PHASE
    for (int p = 0; p < NPH; ++p) { a.ph_lo = p; a.ph_hi = p + 1; hipLaunchKernelGGL(fwd_kernel, dim3(grid), dim3(NTHR), LDS_BYTES, stream, a); }
#else
    a.ph_lo = 0; a.ph_hi = NPH; hipLaunchKernelGGL(fwd_kernel, dim3(grid), dim3(NTHR), LDS_BYTES, stream, a);
#endif
}
```
